# Optimizing an MI355X kernel written in HIP

```python
import jax, jax.numpy as jnp
from jax import lax
import numpy as np

D_MODEL = 1024
BATCH = 8
SEQ = 4096
DEPTH = 1

CONV_CH = 512
CONV_WIDTH = 31
N_HEADS = 8
N_KV_HEADS = 2
HEAD_DIM = 64
WINDOW = 128
ATTN_BLOCK = 128
N_GROUPS = 4
EXPERTS_PER_GROUP = 8
N_EXPERTS = N_GROUPS * EXPERTS_PER_GROUP
EXPERT_TOP_K = 2
D_FF_EXPERT = 512
MOE_BLOCK = 128
NORM_EPS = 1e-6

Q_DIM = N_HEADS * HEAD_DIM
KV_DIM = N_KV_HEADS * HEAD_DIM
IN_COLS = 2 * CONV_CH + Q_DIM + 2 * KV_DIM + 2 * D_MODEL

kernel_name = "hybrid_conv_swa_sink_alibi_hiermoe"


def rms_norm(x, g):
    xf = x.astype(jnp.float32)
    y = xf * lax.rsqrt(jnp.mean(xf * xf, axis=-1, keepdims=True) + NORM_EPS)
    return (y * g.astype(jnp.float32)).astype(x.dtype)


def layer_norm(x, g, b):
    xf = x.astype(jnp.float32)
    mu = jnp.mean(xf, axis=-1, keepdims=True)
    var = jnp.mean(jnp.square(xf - mu), axis=-1, keepdims=True)
    y = (xf - mu) * lax.rsqrt(var + NORM_EPS)
    return (y * g.astype(jnp.float32) + b.astype(jnp.float32)).astype(x.dtype)


def alibi_slopes():
    return jnp.asarray(np.array([2.0 ** (-8.0 * (h + 1) / N_HEADS) for h in range(N_HEADS)], np.float32))


def conformer_conv(u, w_dw, b_dw, ln_g, ln_b):
    a, gate = jnp.split(u, 2, axis=-1)
    v = a * jax.nn.sigmoid(gate)
    y = lax.conv_general_dilated(
        v, w_dw, window_strides=(1,), padding=[(CONV_WIDTH - 1, 0)],
        dimension_numbers=("NWC", "WIO", "NWC"), feature_group_count=CONV_CH)
    y = y + b_dw
    return jax.nn.silu(layer_norm(y, ln_g, ln_b))


def sliding_window_attention(q, k, v, sinks):
    b, s = q.shape[0], q.shape[1]
    nb = s // ATTN_BLOCK
    grp = N_HEADS // N_KV_HEADS
    qb = q.reshape(b, nb, ATTN_BLOCK, N_KV_HEADS, grp, HEAD_DIM)
    kb = k.reshape(b, nb, ATTN_BLOCK, N_KV_HEADS, HEAD_DIM)
    vb = v.reshape(b, nb, ATTN_BLOCK, N_KV_HEADS, HEAD_DIM)

    def with_prev(t):
        prev = jnp.pad(t[:, :-1], ((0, 0), (1, 0), (0, 0), (0, 0), (0, 0)))
        return jnp.concatenate([prev, t], axis=2)

    kk, vv = with_prev(kb), with_prev(vb)
    scores = jnp.einsum("bnqhgd,bnkhd->bnhgqk", qb, kk,
                        preferred_element_type=jnp.float32) * (HEAD_DIM ** -0.5)
    qi = jnp.arange(ATTN_BLOCK)[:, None]
    kj = jnp.arange(2 * ATTN_BLOCK)[None, :]
    rel = ATTN_BLOCK + qi - kj
    in_window = (rel >= 0) & (rel < WINDOW)
    key_exists = (jnp.arange(nb)[:, None, None] * ATTN_BLOCK + kj[None] - ATTN_BLOCK) >= 0
    mask = in_window[None] & key_exists
    slopes = alibi_slopes().reshape(N_KV_HEADS, grp)
    scores = scores - slopes[:, :, None, None] * rel.astype(jnp.float32)
    scores = jnp.where(mask[None, :, None, None], scores, -jnp.inf)
    sink = sinks.astype(jnp.float32).reshape(N_KV_HEADS, grp)[None, None, :, :, None, None]
    m = jnp.maximum(jnp.max(scores, axis=-1, keepdims=True), sink)
    p = jnp.exp(scores - m)
    p = p / (jnp.sum(p, axis=-1, keepdims=True) + jnp.exp(sink - m))
    out = jnp.einsum("bnhgqk,bnkhd->bnqhgd", p.astype(v.dtype), vv)
    return out.reshape(b, s, Q_DIM)


def hierarchical_moe(xn, w_group, b_group, w_expert, b_expert, w_gate, w_up, w_down):
    b, s, d = xn.shape
    t = b * s
    xt = xn.reshape(t, d)
    g_logits = (xt @ w_group).astype(jnp.float32) + b_group.astype(jnp.float32)
    g_prob = jax.nn.softmax(g_logits, axis=-1)
    g_sel = jnp.argmax(g_logits, axis=-1).astype(jnp.int32)
    p_group = jnp.take_along_axis(g_prob, g_sel[:, None], axis=-1)[:, 0]
    e_logits = ((xt @ w_expert).astype(jnp.float32) + b_expert.astype(jnp.float32)).reshape(t, N_GROUPS, EXPERTS_PER_GROUP)
    e_in = jnp.take_along_axis(e_logits, g_sel[:, None, None], axis=1)[:, 0]
    top_val, top_idx = lax.top_k(e_in, EXPERT_TOP_K)
    weights = p_group[:, None] * jax.nn.softmax(top_val, axis=-1)
    expert_id = (g_sel[:, None] * EXPERTS_PER_GROUP + top_idx.astype(jnp.int32)).reshape(-1)
    token_id = jnp.repeat(jnp.arange(t, dtype=jnp.int32), EXPERT_TOP_K)
    w_flat = weights.reshape(-1)
    n_assign = t * EXPERT_TOP_K
    n_blocks = -(-(n_assign + N_EXPERTS * (MOE_BLOCK - 1)) // MOE_BLOCK)
    order = jnp.argsort(expert_id, stable=True)
    sorted_e = expert_id[order]
    counts = jnp.zeros((N_EXPERTS,), jnp.int32).at[expert_id].add(1)
    padded = ((counts + MOE_BLOCK - 1) // MOE_BLOCK) * MOE_BLOCK
    padded_ends = jnp.cumsum(padded)
    padded_starts = padded_ends - padded
    starts = jnp.cumsum(counts) - counts
    rank = jnp.arange(n_assign, dtype=jnp.int32) - starts[sorted_e]
    dest = padded_starts[sorted_e] + rank
    slot_token = jnp.zeros((n_blocks * MOE_BLOCK,), jnp.int32).at[dest].set(token_id[order])
    slot_w = jnp.zeros((n_blocks * MOE_BLOCK,), jnp.float32).at[dest].set(w_flat[order])
    block_start = jnp.arange(n_blocks, dtype=jnp.int32) * MOE_BLOCK
    block_expert = jnp.clip(jnp.searchsorted(padded_ends, block_start, side="right"), 0, N_EXPERTS - 1).astype(jnp.int32)

    def run_block(args):
        tok, wt, e = args
        xb = xt[tok]
        hmid = jax.nn.silu(xb @ w_gate[e]) * (xb @ w_up[e])
        return (hmid @ w_down[e]) * wt[:, None].astype(xb.dtype)

    ys = lax.map(run_block, (slot_token.reshape(n_blocks, MOE_BLOCK),
                             slot_w.reshape(n_blocks, MOE_BLOCK), block_expert))
    out = jnp.zeros((t, d), xn.dtype).at[slot_token].add(ys.reshape(-1, d))
    return out.reshape(b, s, d)


def setup_inputs(seed: int = 0) -> dict:
    key = jax.random.key(seed)
    ks = jax.random.split(key, 24)
    f32 = jnp.float32

    def nrm(k, shape, scale):
        return jax.random.normal(k, shape, f32) * scale

    L = DEPTH
    return {
        "x": jax.random.normal(ks[0], (BATCH, SEQ, D_MODEL), f32),
        "g_mix": 1.0 + nrm(ks[1], (L, D_MODEL), 0.02),
        "w_in": nrm(ks[2], (L, D_MODEL, IN_COLS), D_MODEL ** -0.5),
        "w_dw": nrm(ks[3], (L, CONV_WIDTH, 1, CONV_CH), CONV_WIDTH ** -0.5),
        "b_dw": nrm(ks[4], (L, CONV_CH), 0.02),
        "ln_conv_g": 1.0 + nrm(ks[5], (L, CONV_CH), 0.02),
        "ln_conv_b": nrm(ks[6], (L, CONV_CH), 0.02),
        "sinks": nrm(ks[7], (L, N_HEADS), 0.5),
        "w_conv_out": nrm(ks[8], (L, CONV_CH, D_MODEL), CONV_CH ** -0.5),
        "w_attn_out": nrm(ks[9], (L, Q_DIM, D_MODEL), Q_DIM ** -0.5),
        "w_out": nrm(ks[10], (L, D_MODEL, D_MODEL), D_MODEL ** -0.5),
        "g_ffn": 1.0 + nrm(ks[11], (L, D_MODEL), 0.02),
        "w_group": nrm(ks[12], (L, D_MODEL, N_GROUPS), D_MODEL ** -0.5),
        "b_group": nrm(ks[13], (L, N_GROUPS), 0.01),
        "w_expert": nrm(ks[14], (L, D_MODEL, N_EXPERTS), D_MODEL ** -0.5),
        "b_expert": nrm(ks[15], (L, N_EXPERTS), 0.01),
        "w_gate": nrm(ks[16], (L, N_EXPERTS, D_MODEL, D_FF_EXPERT), D_MODEL ** -0.5),
        "w_up": nrm(ks[17], (L, N_EXPERTS, D_MODEL, D_FF_EXPERT), D_MODEL ** -0.5),
        "w_down": nrm(ks[18], (L, N_EXPERTS, D_FF_EXPERT, D_MODEL), D_FF_EXPERT ** -0.5),
        "g_final": 1.0 + nrm(ks[19], (D_MODEL,), 0.02),
    }


def reference(x, g_mix, w_in, w_dw, b_dw, ln_conv_g, ln_conv_b, sinks, w_conv_out, w_attn_out,
              w_out, g_ffn, w_group, b_group, w_expert, b_expert, w_gate, w_up, w_down, g_final):
    b, s, _ = x.shape
    cuts = list(np.cumsum([2 * CONV_CH, Q_DIM, KV_DIM, KV_DIM, D_MODEL]))
    h = x
    for l in range(DEPTH):
        xn = rms_norm(h, g_mix[l])
        proj = xn @ w_in[l]
        u_conv, q, k, v, gate_conv, gate_attn = jnp.split(proj, cuts, axis=-1)
        conv_o = conformer_conv(u_conv, w_dw[l], b_dw[l], ln_conv_g[l], ln_conv_b[l]) @ w_conv_out[l]
        attn = sliding_window_attention(q.reshape(b, s, N_HEADS, HEAD_DIM),
                                        k.reshape(b, s, N_KV_HEADS, HEAD_DIM),
                                        v.reshape(b, s, N_KV_HEADS, HEAD_DIM), sinks[l])
        attn_o = attn @ w_attn_out[l]
        merged = jax.nn.sigmoid(gate_conv) * conv_o + jax.nn.sigmoid(gate_attn) * attn_o
        h = h + merged @ w_out[l]
        h = h + hierarchical_moe(rms_norm(h, g_ffn[l]), w_group[l], b_group[l], w_expert[l],
                                 b_expert[l], w_gate[l], w_up[l], w_down[l])
    return rms_norm(h, g_final)
```

```cpp
#include <hip/hip_runtime.h>
#include <cstdio>
#include <cstdint>

#ifndef SINGLE_LAUNCH
#define SINGLE_LAUNCH 1
#endif

constexpr int T = 32768, D = 1024, SEQ = 4096;
constexpr int CC = 512, CW = 31, NH = 8, HD = 64, QD = 512, KVD = 128, INC = 3840;
constexpr int NE = 32, NG = 4, EPG = 8, DFF = 512, MBLK = 128;
constexpr int NBLK_MAX = 544, NSLOT_MAX = NBLK_MAX * MBLK;
constexpr float EPS = 1e-6f;
constexpr int NT = 512;

constexpr size_t MiB = 1u << 20;
constexpr size_t WS_R0 = 0;
constexpr size_t WS_R1 = 128 * MiB;
constexpr size_t WS_R2 = 256 * MiB;
constexpr size_t WS_CTL = 400 * MiB;
constexpr size_t CTL_BYTES = 1 * MiB;
constexpr size_t WS_TOKE = 402 * MiB;
constexpr size_t WS_TOKW = 403 * MiB;
constexpr size_t WS_SLOTT = 404 * MiB;
constexpr size_t WS_SLOTW = 405 * MiB;
constexpr size_t WS_END = 406 * MiB;
constexpr int CW_BAR = 4096;
constexpr int CW_CNT = 16384;
constexpr int CW_CUR = 16384 + 64;

#define XB_TMO      128
#define XB_XCNT(j)  (256  + 64 * (j))
#define XB_XSUB(j)  (1280 + 64 * (j))
#define XB_XGEN(j)  (2304 + 64 * (j))
#define XB_TOP      3328
#define XB_TOPGEN   3392
#define XCD_BAR_WORDS 3456
#define XB_SPIN_CAP (1u << 18)
#define LAS __attribute__((address_space(3)))

__device__ __forceinline__ unsigned xb_ld(unsigned* p)              { return __hip_atomic_load(p, __ATOMIC_RELAXED, __HIP_MEMORY_SCOPE_AGENT); }
__device__ __forceinline__ unsigned xb_add(unsigned* p, unsigned v) { return __hip_atomic_fetch_add(p, v, __ATOMIC_RELAXED, __HIP_MEMORY_SCOPE_AGENT); }
__device__ __forceinline__ unsigned xb_xcc_id() { return (unsigned)__builtin_amdgcn_s_getreg((3 << 11) | 20) & 0xFu; }
#define XB_SPIN(cond, bar) do { unsigned _sp = 0; while (cond) { __builtin_amdgcn_s_sleep(1); \
    if ((++_sp & 255u) == 0u) { if (xb_ld(&(bar)[XB_TMO])) break; if (_sp > XB_SPIN_CAP) { atomicAdd(&(bar)[XB_TMO], 1u); break; } } } } while (0)

struct XcdBarrier { unsigned* bar; unsigned x; volatile LAS unsigned* st; };

__device__ __forceinline__ XcdBarrier xcd_barrier_post(unsigned* bar, volatile LAS unsigned* st) {
    XcdBarrier b; b.bar = bar; b.x = xb_xcc_id(); b.st = st;
    if (threadIdx.x == 0) (void)xb_add(&bar[XB_XCNT(b.x)], 1u);
    return b;
}
__device__ __forceinline__ void xcd_barrier_complete(unsigned* bar, unsigned x, unsigned& nloc, unsigned& nx) {
    const unsigned G = gridDim.x * gridDim.y * gridDim.z;
    unsigned sum, cnt, mine, sp = 0u;
    for (;;) {
        sum = 0u; cnt = 0u; mine = 0u;
#pragma unroll
        for (unsigned j = 0; j < 16; ++j) { const unsigned c = xb_ld(&bar[XB_XCNT(j)]); sum += c; cnt += (c > 0u) ? 1u : 0u; mine = (j == x) ? c : mine; }
        if (sum == G) break;
        __builtin_amdgcn_s_sleep(1);
        if ((++sp & 255u) == 0u) { if (xb_ld(&bar[XB_TMO])) break; if (sp > XB_SPIN_CAP) { atomicAdd(&bar[XB_TMO], 1u); break; } }
    }
    nloc = mine > 0u ? mine : 1u; nx = cnt > 0u ? cnt : 1u;
}
__device__ __forceinline__ void xcd_barrier(const XcdBarrier& b) {
    asm volatile("s_waitcnt vmcnt(0)" ::: "memory");
    __syncthreads();
    if (threadIdx.x == 0) {
        unsigned* bar = b.bar;
        __builtin_amdgcn_s_waitcnt(0);
        unsigned nloc = b.st[0], nx = b.st[1];
        if (nloc == 0u) { xcd_barrier_complete(bar, b.x, nloc, nx); b.st[0] = nloc; b.st[1] = nx; }
        const unsigned old = xb_add(&bar[XB_XSUB(b.x)], 1u);
        const unsigned gen = old / nloc;
        if (old + 1u == (gen + 1u) * nloc) {
            __builtin_amdgcn_fence(__ATOMIC_RELEASE, "agent");
            asm volatile("s_waitcnt vmcnt(0)" ::: "memory");
            const unsigned og = xb_add(&bar[XB_TOP], 1u);
            const unsigned tg = og / nx;
            if (og + 1u == (tg + 1u) * nx) xb_add(&bar[XB_TOPGEN], 1u);
            else XB_SPIN(xb_ld(&bar[XB_TOPGEN]) == tg, bar);
            __builtin_amdgcn_fence(__ATOMIC_ACQUIRE, "agent");
            xb_add(&bar[XB_XGEN(b.x)], 1u);
            asm volatile("s_waitcnt vmcnt(0)" ::: "memory");
        } else {
            XB_SPIN(xb_ld(&bar[XB_XGEN(b.x)]) == gen, bar);
            __builtin_amdgcn_fence(__ATOMIC_ACQUIRE, "agent");
            asm volatile("s_waitcnt vmcnt(0)" ::: "memory");
        }
    }
    __syncthreads();
}

struct Params {
    const float *x, *g_mix, *w_in, *w_dw, *b_dw, *ln_g, *ln_b, *sinks, *w_conv_out, *w_attn_out, *w_out, *g_ffn,
                *w_group, *b_group, *w_expert, *b_expert, *w_gate, *w_up, *w_down, *g_final;
    float* out; unsigned char* ws;
};

__device__ __forceinline__ float wave_sum(float v) {
#pragma unroll
    for (int o = 1; o < 64; o <<= 1) v += __shfl_xor(v, o);
    return v;
}
__device__ __forceinline__ float sigmoidf_(float v) { return 1.f / (1.f + __expf(-v)); }

enum { EPI_STORE = 0, EPI_GATE_SET = 1, EPI_GATE_ADD = 2, EPI_RESID = 3, EPI_SILU_MUL = 4, EPI_SCATTER = 5 };
struct GemmP {
    const float* A; int lda; const int* arow;
    const float* B; int ldb;
    float* C; int ldc; int K;
    const float* X; int ldx;
    const int* srow; const float* sw;
};
template <int EPI>
__device__ __forceinline__ void gemm_tile(const GemmP& g, int m0, int n0, float* lds) {
    float (*As)[132] = (float (*)[132])lds;
    float (*Bs)[128] = (float (*)[128])(lds + 16 * 132);
    const int tid = threadIdx.x, tx = tid & 15, ty = tid >> 4;
    const int ar = tid >> 2, akq = (tid & 3) * 4;
    const int bk = tid >> 5, bc = (tid & 31) * 4;
    int arow = m0 + ar; if (g.arow) arow = g.arow[m0 + ar];
    const float* Ap = g.A + (size_t)(arow < 0 ? 0 : arow) * g.lda + akq;
    const float* Bp = g.B + (size_t)bk * g.ldb + n0 + bc;
    float acc[4][8];
#pragma unroll
    for (int i = 0; i < 4; ++i)
#pragma unroll
        for (int j = 0; j < 8; ++j) acc[i][j] = 0.f;
    float4 ra = (arow < 0) ? make_float4(0.f, 0.f, 0.f, 0.f) : *(const float4*)Ap;
    float4 rb = *(const float4*)Bp;
    for (int k0 = 0; k0 < g.K; k0 += 16) {
        __syncthreads();
        As[akq + 0][ar] = ra.x; As[akq + 1][ar] = ra.y; As[akq + 2][ar] = ra.z; As[akq + 3][ar] = ra.w;
        *(float4*)&Bs[bk][bc] = rb;
        __syncthreads();
        if (k0 + 16 < g.K) {
            ra = (arow < 0) ? make_float4(0.f, 0.f, 0.f, 0.f) : *(const float4*)(Ap + k0 + 16);
            rb = *(const float4*)(Bp + (size_t)(k0 + 16) * g.ldb);
        }
#pragma unroll
        for (int kk = 0; kk < 16; ++kk) {
            const float4 a = *(const float4*)&As[kk][ty * 4];
            const float4 b0 = *(const float4*)&Bs[kk][tx * 8], b1 = *(const float4*)&Bs[kk][tx * 8 + 4];
            const float av[4] = {a.x, a.y, a.z, a.w}; const float bv[8] = {b0.x, b0.y, b0.z, b0.w, b1.x, b1.y, b1.z, b1.w};
#pragma unroll
            for (int i = 0; i < 4; ++i)
#pragma unroll
                for (int j = 0; j < 8; ++j) acc[i][j] = fmaf(av[i], bv[j], acc[i][j]);
        }
    }
#pragma unroll
    for (int i = 0; i < 4; ++i) {
        const int r = m0 + ty * 4 + i, c = n0 + tx * 8;
        if (EPI == EPI_SCATTER) {
            const int tok = g.srow[r]; if (tok < 0) continue; const float w = g.sw[r];
            float* dst = g.C + (size_t)tok * g.ldc + c;
#pragma unroll
            for (int j = 0; j < 8; ++j) atomicAdd(dst + j, w * acc[i][j]);
        } else {
            float* dst = g.C + (size_t)r * g.ldc + c;
            float o[8];
#pragma unroll
            for (int j = 0; j < 8; ++j) {
                float v = acc[i][j];
                if (EPI == EPI_GATE_SET) v = sigmoidf_(g.X[(size_t)r * g.ldx + c + j]) * v;
                if (EPI == EPI_GATE_ADD) v = dst[j] + sigmoidf_(g.X[(size_t)r * g.ldx + c + j]) * v;
                if (EPI == EPI_RESID) v = g.X[(size_t)r * g.ldx + c + j] + v;
                if (EPI == EPI_SILU_MUL) { const float gt = dst[j]; v = gt * sigmoidf_(gt) * v; }
                o[j] = v;
            }
            *(float4*)dst = make_float4(o[0], o[1], o[2], o[3]); *(float4*)(dst + 4) = make_float4(o[4], o[5], o[6], o[7]);
        }
    }
}
template <int EPI>
__device__ __forceinline__ void gemm_dense(const GemmP& g, int M, int N, float* lds) {
    const int nN = N / 128, ntiles = (M / 128) * nN;
    for (int t = blockIdx.x; t < ntiles; t += gridDim.x) gemm_tile<EPI>(g, (t / nN) * 128, (t % nN) * 128, lds);
}

__device__ __forceinline__ void rmsnorm_rows(const float* in, const float* gain, float* outp) {
    const int lane = threadIdx.x & 63, gw = blockIdx.x * (NT / 64) + (threadIdx.x >> 6), NGW = gridDim.x * (NT / 64);
    for (int m = gw; m < T; m += NGW) {
        const float4* xr = (const float4*)(in + (size_t)m * D) + lane;
        float4 v[4]; float s = 0.f;
#pragma unroll
        for (int j = 0; j < 4; ++j) { v[j] = xr[64 * j]; s += v[j].x * v[j].x + v[j].y * v[j].y + v[j].z * v[j].z + v[j].w * v[j].w; }
        const float rstd = rsqrtf(wave_sum(s) * (1.f / D) + EPS);
        float4* o = (float4*)(outp + (size_t)m * D) + lane;
#pragma unroll
        for (int j = 0; j < 4; ++j) { const float4 gg = ((const float4*)gain)[lane + 64 * j];
            o[64 * j] = make_float4(v[j].x * rstd * gg.x, v[j].y * rstd * gg.y, v[j].z * rstd * gg.z, v[j].w * rstd * gg.w); }
    }
}
__device__ __forceinline__ float block_sum(float v, float* red) {
    v = wave_sum(v);
    __syncthreads();
    if ((threadIdx.x & 63) == 0) red[threadIdx.x >> 6] = v;
    __syncthreads();
    float s = 0.f;
#pragma unroll
    for (int i = 0; i < NT / 64; ++i) s += red[i];
    return s;
}
__device__ __forceinline__ void conv_phase(const Params& p, const float* u, float* outp, float* lds) {
    const int c = threadIdx.x;
    float w[CW];
#pragma unroll
    for (int j = 0; j < CW; ++j) w[j] = p.w_dw[j * CC + c];
    const float bias = p.b_dw[c], lg = p.ln_g[c], lb = p.ln_b[c];
    for (int t = blockIdx.x; t < T; t += gridDim.x) {
        const int s = t % SEQ;
        float y = bias;
#pragma unroll
        for (int j = 0; j < CW; ++j) {
            const int ss = s + j - (CW - 1);
            if (ss >= 0) { const float* ur = u + (size_t)(t + j - (CW - 1)) * 1024; y = fmaf(w[j], ur[c] * sigmoidf_(ur[CC + c]), y); }
        }
        const float mu = block_sum(y, lds) * (1.f / CC);
        const float d = y - mu;
        const float var = block_sum(d * d, lds) * (1.f / CC);
        const float z = d * rsqrtf(var + EPS) * lg + lb;
        outp[(size_t)t * CC + c] = z * sigmoidf_(z);
    }
}
__device__ __forceinline__ void attn_phase_naive(const Params& p, const float* qkv, float* outp) {
    const int lane = threadIdx.x & 63, h = __builtin_amdgcn_readfirstlane(threadIdx.x >> 6), kvh = h >> 2;
    const float slope = exp2f(-(float)(h + 1)), sink = p.sinks[h];
    for (int blk = blockIdx.x; blk < T / 64; blk += gridDim.x) {
        const int t0 = blk * 64, t = t0 + lane, s0 = t0 % SEQ;
        float q[HD], o[HD];
#pragma unroll
        for (int d = 0; d < HD; d += 4) { const float4 v = *(const float4*)(qkv + (size_t)t * 768 + h * HD + d); q[d] = v.x; q[d + 1] = v.y; q[d + 2] = v.z; q[d + 3] = v.w; }
#pragma unroll
        for (int d = 0; d < HD; ++d) o[d] = 0.f;
        float m = sink, l = 1.f;
        int klo = -127; if (s0 + klo < 0) klo = -s0;
        for (int kr = klo; kr < 64; ++kr) {
            const float* kp = qkv + (size_t)(t0 + kr) * 768 + QD + kvh * HD;
            float dot = 0.f;
#pragma unroll
            for (int d = 0; d < HD; d += 4) { const float4 kv = *(const float4*)(kp + d); dot = fmaf(q[d], kv.x, dot); dot = fmaf(q[d + 1], kv.y, dot); dot = fmaf(q[d + 2], kv.z, dot); dot = fmaf(q[d + 3], kv.w, dot); }
            const int rel = lane - kr;
            if (rel >= 0 && rel < 128) {
                const float sc = dot * 0.125f - slope * (float)rel;
                const float mn = fmaxf(m, sc), f = __expf(m - mn), pe = __expf(sc - mn);
                l = l * f + pe; m = mn;
                const float* vp = kp + KVD;
#pragma unroll
                for (int d = 0; d < HD; d += 4) { const float4 vv = *(const float4*)(vp + d);
                    o[d] = o[d] * f + pe * vv.x; o[d + 1] = o[d + 1] * f + pe * vv.y; o[d + 2] = o[d + 2] * f + pe * vv.z; o[d + 3] = o[d + 3] * f + pe * vv.w; }
            }
        }
        const float inv = 1.f / l;
#pragma unroll
        for (int d = 0; d < HD; d += 4) *(float4*)(outp + (size_t)t * QD + h * HD + d) = make_float4(o[d] * inv, o[d + 1] * inv, o[d + 2] * inv, o[d + 3] * inv);
    }
}
__device__ __forceinline__ void route_phase(const Params& p, const float* h, float* hn, int* toke, float* tokw, unsigned* counts, int* slott, float* slotw) {
    const int lane = threadIdx.x & 63, gw = blockIdx.x * (NT / 64) + (threadIdx.x >> 6), NGW = gridDim.x * (NT / 64);
    for (int i = blockIdx.x * NT + threadIdx.x; i < NSLOT_MAX; i += gridDim.x * NT) { slott[i] = -1; slotw[i] = 0.f; }
    for (int m = gw; m < T; m += NGW) {
        const float4* xr = (const float4*)(h + (size_t)m * D) + lane;
        float4 v[4]; float s = 0.f;
#pragma unroll
        for (int j = 0; j < 4; ++j) { v[j] = xr[64 * j]; s += v[j].x * v[j].x + v[j].y * v[j].y + v[j].z * v[j].z + v[j].w * v[j].w; }
        const float rstd = rsqrtf(wave_sum(s) * (1.f / D) + EPS);
        float lg[NG + NE];
#pragma unroll
        for (int e = 0; e < NG + NE; ++e) lg[e] = 0.f;
        float4* o = (float4*)(hn + (size_t)m * D) + lane;
#pragma unroll
        for (int j = 0; j < 4; ++j) {
            const float4 gg = ((const float4*)p.g_ffn)[lane + 64 * j];
            const float4 y = make_float4(v[j].x * rstd * gg.x, v[j].y * rstd * gg.y, v[j].z * rstd * gg.z, v[j].w * rstd * gg.w);
            o[64 * j] = y;
            const float yy[4] = {y.x, y.y, y.z, y.w};
            const int k0 = (lane + 64 * j) * 4;
#pragma unroll
            for (int q = 0; q < 4; ++q) {
                const float4 wg = *(const float4*)(p.w_group + (size_t)(k0 + q) * NG);
                lg[0] = fmaf(yy[q], wg.x, lg[0]); lg[1] = fmaf(yy[q], wg.y, lg[1]); lg[2] = fmaf(yy[q], wg.z, lg[2]); lg[3] = fmaf(yy[q], wg.w, lg[3]);
                const float4* we = (const float4*)(p.w_expert + (size_t)(k0 + q) * NE);
#pragma unroll
                for (int e4 = 0; e4 < NE / 4; ++e4) { const float4 w4 = we[e4];
                    lg[4 + e4 * 4 + 0] = fmaf(yy[q], w4.x, lg[4 + e4 * 4 + 0]); lg[4 + e4 * 4 + 1] = fmaf(yy[q], w4.y, lg[4 + e4 * 4 + 1]);
                    lg[4 + e4 * 4 + 2] = fmaf(yy[q], w4.z, lg[4 + e4 * 4 + 2]); lg[4 + e4 * 4 + 3] = fmaf(yy[q], w4.w, lg[4 + e4 * 4 + 3]); }
            }
        }
#pragma unroll
        for (int e = 0; e < NG + NE; ++e) lg[e] = wave_sum(lg[e]);
        float gl[NG]; float gmax = -INFINITY; int gsel = 0;
#pragma unroll
        for (int g = 0; g < NG; ++g) { gl[g] = lg[g] + p.b_group[g]; if (gl[g] > gmax) { gmax = gl[g]; gsel = g; } }
        float gden = 0.f;
#pragma unroll
        for (int g = 0; g < NG; ++g) gden += __expf(gl[g] - gmax);
        const float pg = 1.f / gden;
        float v1 = -INFINITY, v2 = -INFINITY; int i1 = 0, i2 = 0;
#pragma unroll
        for (int g = 0; g < NG; ++g) if (g == gsel) {
#pragma unroll
            for (int j = 0; j < EPG; ++j) { const float val = lg[4 + g * EPG + j] + p.b_expert[g * EPG + j];
                if (val > v1) { v2 = v1; i2 = i1; v1 = val; i1 = j; } else if (val > v2) { v2 = val; i2 = j; } }
        }
        const float e2 = __expf(v2 - v1), w1 = pg / (1.f + e2), w2 = pg * e2 / (1.f + e2);
        if (lane == 0) {
            const int ea = gsel * EPG + i1, eb = gsel * EPG + i2;
            toke[2 * m] = ea; toke[2 * m + 1] = eb; tokw[2 * m] = w1; tokw[2 * m + 1] = w2;
            atomicAdd(&counts[ea], 1u); atomicAdd(&counts[eb], 1u);
        }
    }
}
__device__ __forceinline__ void load_offsets(const unsigned* counts, int* pst) {
    __syncthreads();
    if (threadIdx.x == 0) { int acc = 0; for (int e = 0; e < NE; ++e) { pst[e] = acc; const int c = (int)__hip_atomic_load(counts + e, __ATOMIC_RELAXED, __HIP_MEMORY_SCOPE_AGENT); acc += ((c + MBLK - 1) / MBLK) * MBLK; } pst[NE] = acc; }
    __syncthreads();
}
__device__ __forceinline__ int block_expert(const int* pst, int row0) { int e = 0;
#pragma unroll 1
    for (int i = 1; i < NE; ++i) if (row0 >= pst[i]) e = i;
    return e; }
__device__ __forceinline__ void scatter_phase(const int* toke, const float* tokw, const unsigned* counts, unsigned* cursor, int* slott, float* slotw, int* pst) {
    load_offsets(counts, pst);
    for (int a = blockIdx.x * NT + threadIdx.x; a < 2 * T; a += gridDim.x * NT) {
        const int e = toke[a]; const int pos = pst[e] + (int)atomicAdd(&cursor[e], 1u);
        slott[pos] = a >> 1; slotw[pos] = tokw[a];
    }
}
template <int EPI>
__device__ __forceinline__ void gemm_moe(GemmP g, const float* wbase, size_t wstride, int N, const unsigned* counts, int* pst, float* lds) {
    load_offsets(counts, pst);
    const int nN = N / 128, ntiles = (pst[NE] / MBLK) * nN;
    for (int t = blockIdx.x; t < ntiles; t += gridDim.x) {
        const int m0 = (t / nN) * MBLK; const int e = block_expert(pst, m0);
        g.B = wbase + (size_t)e * wstride;
        gemm_tile<EPI>(g, m0, (t % nN) * 128, lds);
    }
}

constexpr int N_PHASES = 17;
template <int PH>
__device__ __forceinline__ void run_phase(const Params& p, float* lds) {
    unsigned char* ws = p.ws;
    float* R0 = (float*)(ws + WS_R0); float* R1 = (float*)(ws + WS_R1); float* C1 = (float*)(ws + WS_R2); float* C2 = C1 + (size_t)T * CC; float* HM = C1;
    float* E = p.out;
    unsigned* ctl = (unsigned*)(ws + WS_CTL); unsigned* counts = ctl + CW_CNT; unsigned* cursor = ctl + CW_CUR;
    int* toke = (int*)(ws + WS_TOKE); float* tokw = (float*)(ws + WS_TOKW); int* slott = (int*)(ws + WS_SLOTT); float* slotw = (float*)(ws + WS_SLOTW);
    int* pst = (int*)(lds + 16 * 132 + 16 * 128);
    if (PH == 0) rmsnorm_rows(p.x, p.g_mix, R0);
    if (PH == 1) { GemmP g{R0, D, nullptr, p.w_in + 0, INC, R1, 1024, D, nullptr, 0, nullptr, nullptr}; gemm_dense<EPI_STORE>(g, T, 1024, lds); }
    if (PH == 2) conv_phase(p, R1, C1, lds);
    if (PH == 3) { GemmP g{R0, D, nullptr, p.w_in + 1024, INC, R1, 768, D, nullptr, 0, nullptr, nullptr}; gemm_dense<EPI_STORE>(g, T, 768, lds); }
    if (PH == 4) attn_phase_naive(p, R1, C2);
    if (PH == 5) { GemmP g{R0, D, nullptr, p.w_in + 1792, INC, R1, 1024, D, nullptr, 0, nullptr, nullptr}; gemm_dense<EPI_STORE>(g, T, 1024, lds); }
    if (PH == 6) { GemmP g{C1, CC, nullptr, p.w_conv_out, D, E, D, CC, R1, 1024, nullptr, nullptr}; gemm_dense<EPI_GATE_SET>(g, T, D, lds); }
    if (PH == 7) { GemmP g{R0, D, nullptr, p.w_in + 2816, INC, R1, 1024, D, nullptr, 0, nullptr, nullptr}; gemm_dense<EPI_STORE>(g, T, 1024, lds); }
    if (PH == 8) { GemmP g{C2, QD, nullptr, p.w_attn_out, D, E, D, QD, R1, 1024, nullptr, nullptr}; gemm_dense<EPI_GATE_ADD>(g, T, D, lds); }
    if (PH == 9) { GemmP g{E, D, nullptr, p.w_out, D, R0, D, D, p.x, D, nullptr, nullptr}; gemm_dense<EPI_RESID>(g, T, D, lds); }
    if (PH == 10) route_phase(p, R0, R1, toke, tokw, counts, slott, slotw);
    if (PH == 11) scatter_phase(toke, tokw, counts, cursor, slott, slotw, pst);
    if (PH == 12) { GemmP g{R1, D, slott, nullptr, DFF, HM, DFF, D, nullptr, 0, nullptr, nullptr}; gemm_moe<EPI_STORE>(g, p.w_gate, (size_t)D * DFF, DFF, counts, pst, lds); }
    if (PH == 13) { GemmP g{R1, D, slott, nullptr, DFF, HM, DFF, D, nullptr, 0, nullptr, nullptr}; gemm_moe<EPI_SILU_MUL>(g, p.w_up, (size_t)D * DFF, DFF, counts, pst, lds); }
    if (PH == 14) { GemmP g{HM, DFF, nullptr, nullptr, D, R0, D, DFF, nullptr, 0, slott, slotw}; gemm_moe<EPI_SCATTER>(g, p.w_down, (size_t)DFF * D, D, counts, pst, lds); }
    if (PH == 15) rmsnorm_rows(R0, p.g_final, p.out);
}

constexpr int LDS_FLOATS = 16 * 132 + 16 * 128 + 64;

#if SINGLE_LAUNCH
__global__ void __launch_bounds__(NT, 2) k_all(Params p) {
    __shared__ __attribute__((aligned(16))) float lds[LDS_FLOATS];
    __shared__ uint4 xb_words;
    if (threadIdx.x == 0) xb_words = make_uint4(0u, 0u, 0u, 0u);
    __syncthreads();
    XcdBarrier bar = xcd_barrier_post((unsigned*)(p.ws + WS_CTL) + CW_BAR, (volatile LAS unsigned*)&xb_words);
    run_phase<0>(p, lds); xcd_barrier(bar);
    run_phase<1>(p, lds); xcd_barrier(bar);
    run_phase<2>(p, lds); xcd_barrier(bar);
    run_phase<3>(p, lds); xcd_barrier(bar);
    run_phase<4>(p, lds); xcd_barrier(bar);
    run_phase<5>(p, lds); xcd_barrier(bar);
    run_phase<6>(p, lds); xcd_barrier(bar);
    run_phase<7>(p, lds); xcd_barrier(bar);
    run_phase<8>(p, lds); xcd_barrier(bar);
    run_phase<9>(p, lds); xcd_barrier(bar);
    run_phase<10>(p, lds); xcd_barrier(bar);
    run_phase<11>(p, lds); xcd_barrier(bar);
    run_phase<12>(p, lds); xcd_barrier(bar);
    run_phase<13>(p, lds); xcd_barrier(bar);
    run_phase<14>(p, lds); xcd_barrier(bar);
    run_phase<15>(p, lds);
}
#else
template <int PH>
__global__ void __launch_bounds__(NT, 2) k_phase(Params p) {
    __shared__ __attribute__((aligned(16))) float lds[LDS_FLOATS];
    run_phase<PH>(p, lds);
}
#endif

extern "C" void kernel_launch(void* const* d_in, const int* in_sizes, int n_in, void* d_out, int out_size, void* d_ws, size_t ws_size, hipStream_t stream) {
    if (n_in != 20 || in_sizes[0] != T * D || out_size != T * D || ws_size < WS_END) {
        fprintf(stderr, "kernel_launch: unexpected shapes (n_in %d, in0 %d, out %d, ws %zu); nothing launched\n", n_in, n_in > 0 ? in_sizes[0] : -1, out_size, ws_size); return; }
    Params p{};
    const float** pp = (const float**)&p;
    for (int i = 0; i < 20; ++i) pp[i] = (const float*)d_in[i];
    p.out = (float*)d_out; p.ws = (unsigned char*)d_ws;
    (void)hipMemsetAsync((char*)d_ws + WS_CTL, 0, CTL_BYTES, stream);
#if SINGLE_LAUNCH
    static int grid = 0;
    if (grid == 0) {
        int dev = 0, cus = 0, per_cu = 0;
        (void)hipGetDevice(&dev); (void)hipDeviceGetAttribute(&cus, hipDeviceAttributeMultiprocessorCount, dev);
        (void)hipOccupancyMaxActiveBlocksPerMultiprocessor(&per_cu, (const void*)k_all, NT, 0);
        if (per_cu < 1) { fprintf(stderr, "kernel_launch: occupancy query says %d blocks per CU\n", per_cu); }
        grid = cus;
    }
    hipLaunchKernelGGL(k_all, dim3(grid), dim3(NT), 0, stream, p);
#else
    const int grid = 256;
#define LP(k) hipLaunchKernelGGL(k_phase<k>, dim3(grid), dim3(NT), 0, stream, p)
    LP(0); LP(1); LP(2); LP(3); LP(4); LP(5); LP(6); LP(7); LP(8); LP(9); LP(10); LP(11); LP(12); LP(13); LP(14); LP(15);
#undef LP
#endif
}
```

```cpp
#include <hip/hip_runtime.h>
#include <cstdio>
#include <cstdint>

constexpr int T = 32768, D = 1024, SEQ = 4096;
constexpr int CC = 512, CW = 31, NH = 8, HD = 64, QD = 512, KVD = 128, INC = 3840;
constexpr int NE = 32, NG = 4, EPG = 8, DFF = 512;
constexpr float EPS = 1e-6f;
constexpr int NT = 512;
constexpr float LOG2E = 1.4426950408889634f;

#define GAS __attribute__((address_space(1)))
#define LAS __attribute__((address_space(3)))
typedef unsigned short bf16_t;
typedef short bf16x8 __attribute__((ext_vector_type(8)));
typedef float f32x4 __attribute__((ext_vector_type(4)));
typedef float f32x16 __attribute__((ext_vector_type(16)));
typedef unsigned u32x4 __attribute__((ext_vector_type(4)));
typedef unsigned u32x2 __attribute__((ext_vector_type(2)));

__device__ __forceinline__ int opaque_tid(int wave_s) { int t = wave_s * 64 + (int)__builtin_amdgcn_mbcnt_hi(~0u, __builtin_amdgcn_mbcnt_lo(~0u, 0u)); asm volatile("" : "+v"(t)); return t; }
__device__ __forceinline__ int opaque_i(int v) { asm volatile("" : "+v"(v)); return v; }
__device__ __forceinline__ float wave_sum(float v) {
#pragma unroll
    for (int o = 1; o < 64; o <<= 1) v += __shfl_xor(v, o);
    return v;
}
__device__ __forceinline__ float sigmoidf_(float v) { return 1.f / (1.f + __expf(-v)); }
__device__ __forceinline__ float fsig(float v) { return __builtin_amdgcn_rcpf(1.f + __builtin_amdgcn_exp2f(-LOG2E * v)); }
__device__ __forceinline__ unsigned cvt_pk_bf16(float lo, float hi) { unsigned r; asm volatile("v_cvt_pk_bf16_f32 %0, %1, %2" : "=v"(r) : "v"(lo), "v"(hi)); return r; }
__device__ __forceinline__ float bf_lo(unsigned w) { return __uint_as_float(w << 16); }
__device__ __forceinline__ float bf_hi(unsigned w) { return __uint_as_float(w & 0xffff0000u); }

namespace pg8 {
#define PG8_LAS __attribute__((address_space(3)))
constexpr int BM = 256, BK = 64, HALF = 128, HTB = HALF * BK * 2  , STAGE_BYTES = 8 * HTB, NXCD = 8, WGM = 8;

__host__ __device__ __forceinline__ int lds_byte(int r, int c) { const int st = (r >> 4) * 2 + (c >> 5), rr = r & 15, cc = c & 31, ob = rr * 64 + cc * 2; return st * 1024 + (ob ^ (((ob >> 9) & 1) << 5)); }
__host__ __device__ __forceinline__ void stage_rc(int b, int& R, int& C) { const int st = b / 1024, sb = b % 1024, swz = sb ^ (((sb >> 9) & 1) << 5); R = (st >> 1) * 16 + swz / 64; C = (st & 1) * 32 + (swz % 64) / 2; }
__host__ __device__ __forceinline__ int perm32(int rho) { const int n = rho >> 4, i = rho & 15; return 8 * (i >> 2) + 4 * n + (i & 3); }

struct Unit { int pm, pn; const char* a; const char* b; int aux; };

struct StaticOrder {
    int nM, nN, nwg, G, c;
    __host__ __device__ void init(int M, int N, int G_, int c_) { nM = M / BM; nN = N / BM; nwg = nM * nN; G = G_; c = c_; }
    __host__ __device__ bool next_mn(int i, int& pm, int& pn) const {
        const long L = (long)i * G + c; if (L >= nwg) return false;
        int wgid = (int)L; { const int q = nwg / NXCD, r = nwg % NXCD, xcd = wgid % NXCD, off = wgid / NXCD; wgid = (xcd < r ? xcd * (q + 1) : r * (q + 1) + (xcd - r) * q) + off; }
        const int nig = WGM * nN, gid = wgid / nig, fm = gid * WGM, gsz = (nM - fm) < WGM ? (nM - fm) : WGM;
        pm = fm + ((wgid % nig) % gsz); pn = (wgid % nig) / gsz; return true;
    }
};
struct DenseSched {
    StaticOrder so; const char* A; const char* Bt; size_t tstep;
    __device__ __forceinline__ void init(const bf16_t* A_, const bf16_t* Bt_, int M, int N, int K, int G, int c) { so.init(M, N, G, c); A = (const char*)A_; Bt = (const char*)Bt_; tstep = (size_t)BM * K * 2; }
    __device__ __forceinline__ bool next(int i, Unit& u) const { if (!so.next_mn(i, u.pm, u.pn)) return false; u.a = A + (size_t)u.pm * tstep; u.b = Bt + (size_t)u.pn * tstep; u.aux = 0; return true; }
    __device__ __forceinline__ void a_ready(const Unit&) const {}
    __device__ __forceinline__ void done(const Unit&) const {}
};

template <class Epi, class Sched, bool ALIGN_EPI = false, bool SP2 = false>
__device__ __forceinline__ void gemm_phase(PG8_LAS unsigned char* lds, const int K_, const Sched& S, const Epi& E, const int wave_s) {
    const int tid_ = opaque_tid(wave_s); const int tid = tid_, wid = __builtin_amdgcn_readfirstlane(tid >> 6), lane = tid & 63, wr = wid >> 2, wc = wid & 3, fr = lane & 15, fq = lane >> 4;
    const int K = K_, nt = K / BK;
    unsigned voffA[2], voffB[2];
#pragma unroll
    for (int i = 0; i < 2; ++i) { int R, C; stage_rc(tid * 16 + i * 8192, R, C); const int Rb = Epi::PERM ? ((R & ~31) + perm32(R & 31)) : R;
        voffA[i] = (unsigned)(R * K + C) * 2u; voffB[i] = (unsigned)(Rb * K + C) * 2u; }
    const size_t kstep = (size_t)(BK * 2);
    const size_t hstep = (size_t)HALF * K * 2;
    const unsigned ldsw = (unsigned)wid * 1024u;
    const int aoff = lds_byte(wr * 64 + fr, fq * 8), boff = lds_byte(wc * 32 + fr, fq * 8);
#define PG8_SA(b, h) (((b) * 2 + (h)) * HTB)
#define PG8_SB(b, h) ((4 + (b) * 2 + (h)) * HTB)
#define PG8_STAGE(bufoff, gbase, voff) do { _Pragma("unroll") for (int _i = 0; _i < 2; ++_i) \
        __builtin_amdgcn_global_load_lds((const unsigned*)((const char*)(gbase) + (voff)[_i]), (PG8_LAS unsigned*)(lds + (bufoff) + ldsw + _i * 8192), 16, 0, 0); } while (0)
#define PG8_LDA(dst, b, h) do { _Pragma("unroll") for (int m = 0; m < 4; ++m) _Pragma("unroll") for (int k = 0; k < 2; ++k) dst[m][k] = *(const PG8_LAS bf16x8*)(lds + PG8_SA(b, h) + aoff + m * 2048 + k * 1024); } while (0)
#define PG8_LDB(dst, b, h) do { _Pragma("unroll") for (int n = 0; n < 2; ++n) _Pragma("unroll") for (int k = 0; k < 2; ++k) dst[n][k] = *(const PG8_LAS bf16x8*)(lds + PG8_SB(b, h) + boff + n * 2048 + k * 1024); } while (0)
#define PG8_MMA(ai, bj, At, Bt) do { __builtin_amdgcn_s_setprio(1); _Pragma("unroll") for (int m = 0; m < 4; ++m) _Pragma("unroll") for (int n = 0; n < 2; ++n) _Pragma("unroll") for (int k = 0; k < 2; ++k) \
        acc[ai][bj][m][n] = __builtin_amdgcn_mfma_f32_16x16x32_bf16(Bt[n][k], At[m][k], acc[ai][bj][m][n], 0, 0, 0); __builtin_amdgcn_s_setprio(0); } while (0)
#define PG8_WAIT_V(n) asm volatile("s_waitcnt vmcnt(" #n ")" ::: "memory")
#define PG8_WAIT_L(n) asm volatile("s_waitcnt lgkmcnt(" #n ")" ::: "memory")
#define PG8_BAR __builtin_amdgcn_s_barrier()
#define PG8_SCHED __builtin_amdgcn_sched_barrier(0)
    Unit cur, nxt; int ui = 0;
    if (!S.next(0, cur)) return;
    f32x4 acc[2][2][4][2];
#pragma unroll
    for (int a = 0; a < 2; ++a)
#pragma unroll
        for (int b = 0; b < 2; ++b)
#pragma unroll
            for (int m = 0; m < 4; ++m)
#pragma unroll
                for (int n = 0; n < 2; ++n) acc[a][b][m][n] = (f32x4){0.f, 0.f, 0.f, 0.f};
    bf16x8 At[4][2], B0[2][2], B1[2][2];
    const char* cA = cur.a; const char* cB = cur.b;
    S.a_ready(cur);
    if constexpr (SP2) {
        PG8_STAGE(PG8_SB(0, 0), cB, voffB); PG8_STAGE(PG8_SB(0, 1), cB + hstep, voffB); PG8_STAGE(PG8_SA(0, 0), cA, voffA); PG8_STAGE(PG8_SA(0, 1), cA + hstep, voffA);
        if (wr == 1) PG8_BAR;
        PG8_WAIT_V(2); PG8_BAR;
        PG8_STAGE(PG8_SB(1, 0), cB + kstep, voffB); PG8_STAGE(PG8_SA(1, 0), cA + kstep, voffA); PG8_STAGE(PG8_SB(1, 1), cB + hstep + kstep, voffB);
        PG8_WAIT_V(6); PG8_BAR;
    } else {
        PG8_STAGE(PG8_SB(0, 0), cB, voffB); PG8_STAGE(PG8_SA(0, 0), cA, voffA); PG8_STAGE(PG8_SB(0, 1), cB + hstep, voffB); PG8_STAGE(PG8_SA(0, 1), cA + hstep, voffA);
        if (wr == 1) PG8_BAR;
        PG8_WAIT_V(4); PG8_BAR;
        PG8_STAGE(PG8_SB(1, 0), cB + kstep, voffB); PG8_STAGE(PG8_SA(1, 0), cA + kstep, voffA); PG8_STAGE(PG8_SB(1, 1), cB + hstep + kstep, voffB);
        PG8_WAIT_V(6); PG8_BAR;
    }
    for (;;) {
        const bool has_next = S.next(ui + 1, nxt);
        const char* nA = has_next ? nxt.a : cA; const char* nB = has_next ? nxt.b : cB;
        for (int t = 0; t < nt; t += 2) {
            const bool last = (t == nt - 2);
            const char* a1 = cA + (size_t)(t + 1) * kstep;
            const char* a2 = last ? nA : cA + (size_t)(t + 2) * kstep; const char* b2 = last ? nB : cB + (size_t)(t + 2) * kstep;
            const char* a3 = a2 + kstep; const char* b3 = b2 + kstep;
            if (last && has_next) S.a_ready(nxt);
            if constexpr (SP2) {
            PG8_LDB(B0, 0, 0); PG8_LDB(B1, 0, 1); PG8_SCHED; PG8_LDA(At, 0, 0); PG8_STAGE(PG8_SA(1, 1), a1 + hstep, voffA);
            PG8_WAIT_V(8); PG8_WAIT_L(0); PG8_BAR; PG8_MMA(0, 0, At, B0); PG8_MMA(0, 1, At, B1); PG8_BAR; PG8_SCHED;
            PG8_LDA(At, 0, 1); PG8_STAGE(PG8_SB(0, 0), b2, voffB); PG8_STAGE(PG8_SB(0, 1), b2 + hstep, voffB); PG8_STAGE(PG8_SA(0, 0), a2, voffA);
            PG8_WAIT_V(8); PG8_WAIT_L(0); PG8_BAR; PG8_MMA(1, 0, At, B0); PG8_MMA(1, 1, At, B1); PG8_BAR; PG8_SCHED;
            PG8_LDB(B0, 1, 0); PG8_LDB(B1, 1, 1); PG8_SCHED; PG8_LDA(At, 1, 0); PG8_STAGE(PG8_SA(0, 1), a2 + hstep, voffA);
            PG8_WAIT_V(8); PG8_WAIT_L(0); PG8_BAR; PG8_MMA(0, 0, At, B0); PG8_MMA(0, 1, At, B1); PG8_BAR; PG8_SCHED;
            PG8_LDA(At, 1, 1); PG8_STAGE(PG8_SB(1, 0), b3, voffB); PG8_STAGE(PG8_SB(1, 1), b3 + hstep, voffB); PG8_STAGE(PG8_SA(1, 0), a3, voffA);
            PG8_WAIT_V(8); PG8_WAIT_L(0); PG8_BAR; PG8_MMA(1, 0, At, B0); PG8_MMA(1, 1, At, B1); PG8_BAR; PG8_SCHED;
            } else {
            PG8_LDB(B0, 0, 0); PG8_SCHED; PG8_LDA(At, 0, 0); PG8_STAGE(PG8_SA(1, 1), a1 + hstep, voffA);
            PG8_WAIT_L(8); PG8_BAR; PG8_WAIT_L(0); PG8_MMA(0, 0, At, B0); PG8_BAR; PG8_SCHED;
            PG8_LDB(B1, 0, 1); PG8_STAGE(PG8_SB(0, 0), b2, voffB);
            PG8_BAR; PG8_WAIT_L(0); PG8_MMA(0, 1, At, B1); PG8_BAR;
            PG8_LDA(At, 0, 1); PG8_STAGE(PG8_SA(0, 0), a2, voffA);
            PG8_BAR; PG8_WAIT_L(0); PG8_MMA(1, 0, At, B0); PG8_BAR; PG8_SCHED;
            PG8_STAGE(PG8_SB(0, 1), b2 + hstep, voffB);
            PG8_WAIT_V(6); PG8_BAR; PG8_MMA(1, 1, At, B1); PG8_BAR;
            PG8_LDB(B0, 1, 0); PG8_SCHED; PG8_LDA(At, 1, 0); PG8_STAGE(PG8_SA(0, 1), a2 + hstep, voffA);
            PG8_WAIT_L(8); PG8_BAR; PG8_WAIT_L(0); PG8_MMA(0, 0, At, B0); PG8_BAR; PG8_SCHED;
            PG8_LDB(B1, 1, 1); PG8_STAGE(PG8_SB(1, 0), b3, voffB);
            PG8_BAR; PG8_WAIT_L(0); PG8_MMA(0, 1, At, B1); PG8_BAR;
            PG8_LDA(At, 1, 1); PG8_STAGE(PG8_SA(1, 0), a3, voffA);
            PG8_BAR; PG8_WAIT_L(0); PG8_MMA(1, 0, At, B0); PG8_BAR; PG8_SCHED;
            PG8_STAGE(PG8_SB(1, 1), b3 + hstep, voffB);
            PG8_WAIT_V(6); PG8_BAR; PG8_MMA(1, 1, At, B1); PG8_BAR;
            }
        }
        if constexpr (ALIGN_EPI) { if (wr == 0) PG8_BAR; }
        if constexpr (!Epi::AFTER_DRAIN) { E(acc, cur, wr, wc, fr, fq); S.done(cur); }
        if (!has_next) break;
#pragma unroll
        for (int a = 0; a < 2; ++a)
#pragma unroll
            for (int b = 0; b < 2; ++b)
#pragma unroll
                for (int m = 0; m < 4; ++m)
#pragma unroll
                    for (int n = 0; n < 2; ++n) acc[a][b][m][n] = (f32x4){0.f, 0.f, 0.f, 0.f};
        cur = nxt; cA = nA; cB = nB; ++ui;
        if constexpr (ALIGN_EPI) { if (wr == 1) PG8_BAR; }
    }
    PG8_WAIT_V(0);
    if constexpr (!ALIGN_EPI) { if (wr == 0) PG8_BAR; }
    PG8_BAR;
    if constexpr (Epi::AFTER_DRAIN) { E.fused(acc, cur, wr, wc, fr, fq, lds, wid, lane); S.done(cur); }
#undef PG8_SA
#undef PG8_SB
#undef PG8_STAGE
#undef PG8_LDA
#undef PG8_LDB
#undef PG8_MMA
#undef PG8_WAIT_V
#undef PG8_WAIT_L
#undef PG8_BAR
#undef PG8_SCHED
}

__device__ __forceinline__ u32x4 pack8(const f32x4 v0, const f32x4 v1) { u32x4 w; w.x = cvt_pk_bf16(v0[0], v0[1]); w.y = cvt_pk_bf16(v0[2], v0[3]); w.z = cvt_pk_bf16(v1[0], v1[1]); w.w = cvt_pk_bf16(v1[2], v1[3]); return w; }
__device__ __forceinline__ f32x4 sig4(const f32x4 v) { return (f32x4){fsig(v[0]), fsig(v[1]), fsig(v[2]), fsig(v[3])}; }

struct EpiProj {
    static constexpr bool PERM = true, AFTER_DRAIN = false;
    const float* rstd; bf16_t *vglu, *qb, *kvb, *sgc, *sga; float qscale;
    __device__ __forceinline__ void operator()(const f32x4 (&acc)[2][2][4][2], const Unit& u, int wr, int wc, int fr, int fq) const {
        const int pn = __builtin_amdgcn_readfirstlane(u.pn); const int coff = wc * 32 + 8 * fq; const int row0 = u.pm * BM + wr * 64 + fr;
#pragma unroll
        for (int ai = 0; ai < 2; ++ai)
#pragma unroll
            for (int m = 0; m < 4; ++m) {
                const int r = row0 + ai * HALF + m * 16; const float s = rstd[r];
                const f32x4 a0 = acc[ai][0][m][0] * s, a1 = acc[ai][0][m][1] * s, b0 = acc[ai][1][m][0] * s, b1 = acc[ai][1][m][1] * s;
                if (pn < 4) {
                    *(u32x4*)(vglu + (size_t)r * CC + 128 * pn + coff) = pack8(a0 * sig4(b0), a1 * sig4(b1));
                } else if (pn < 6) {
                    bf16_t* qp = qb + (size_t)r * QD + 256 * (pn - 4) + coff;
                    *(u32x4*)qp = pack8(a0 * qscale, a1 * qscale); *(u32x4*)(qp + HALF) = pack8(b0 * qscale, b1 * qscale);
                } else if (pn == 6) {
                    bf16_t* kp = kvb + (size_t)r * 256 + coff;
                    *(u32x4*)kp = pack8(a0, a1); *(u32x4*)(kp + HALF) = pack8(b0, b1);
                } else {
                    const size_t o = (size_t)r * D + 128 * (pn - 7) + coff;
                    *(u32x4*)(sgc + o) = pack8(sig4(a0), sig4(a1)); *(u32x4*)(sga + o) = pack8(sig4(b0), sig4(b1));
                }
            }
    }
};
template <bool ADD> struct EpiGate {
    static constexpr bool PERM = true, AFTER_DRAIN = false;
    const bf16_t* G; bf16_t* O;
    __device__ __forceinline__ void operator()(const f32x4 (&acc)[2][2][4][2], const Unit& u, int wr, int wc, int fr, int fq) const {
        const int row0 = u.pm * BM + wr * 64 + fr, col0 = u.pn * BM + wc * 32 + 8 * fq;
#pragma unroll
        for (int ai = 0; ai < 2; ++ai)
#pragma unroll
            for (int m = 0; m < 4; ++m) {
                const size_t o = (size_t)(row0 + ai * HALF + m * 16) * D + col0;
#pragma unroll
                for (int bj = 0; bj < 2; ++bj) {
                    const u32x4 g = *(const u32x4*)(G + o + bj * HALF);
                    f32x4 v0 = acc[ai][bj][m][0] * (f32x4){bf_lo(g.x), bf_hi(g.x), bf_lo(g.y), bf_hi(g.y)};
                    f32x4 v1 = acc[ai][bj][m][1] * (f32x4){bf_lo(g.z), bf_hi(g.z), bf_lo(g.w), bf_hi(g.w)};
                    if (ADD) { const u32x4 p = *(const u32x4*)(O + o + bj * HALF);
                        v0 += (f32x4){bf_lo(p.x), bf_hi(p.x), bf_lo(p.y), bf_hi(p.y)}; v1 += (f32x4){bf_lo(p.z), bf_hi(p.z), bf_lo(p.w), bf_hi(p.w)}; }
                    *(u32x4*)(O + o + bj * HALF) = pack8(v0, v1);
                }
                if (m & 1) asm volatile("" ::: "memory");
            }
    }
};
struct EpiResid {
    static constexpr bool PERM = false, AFTER_DRAIN = false;
    const float* X; float* H;
    __device__ __forceinline__ void operator()(const f32x4 (&acc)[2][2][4][2], const Unit& u, int wr, int wc, int fr, int fq) const {
        const int row0 = u.pm * BM + wr * 64 + fr, col0 = u.pn * BM + wc * 32 + 4 * fq;
#pragma unroll
        for (int ai = 0; ai < 2; ++ai)
#pragma unroll
            for (int m = 0; m < 4; ++m) {
                const size_t o = (size_t)(row0 + ai * HALF + m * 16) * D + col0;
#pragma unroll
                for (int bj = 0; bj < 2; ++bj)
#pragma unroll
                    for (int n = 0; n < 2; ++n) *(f32x4*)(H + o + bj * HALF + n * 16) = *(const f32x4*)(X + o + bj * HALF + n * 16) + acc[ai][bj][m][n];
                if (m & 1) asm volatile("" ::: "memory");
            }
    }
};
}


constexpr size_t MiB = 1u << 20;
constexpr size_t WS_CTL = 0, CTL_BYTES = 1 * MiB;
constexpr size_t WS_WT_IN = 2 * MiB;
constexpr size_t WS_WT_CO = 10 * MiB, WS_WT_AO = 11 * MiB;
constexpr size_t WS_WT_OUT = 12 * MiB;
constexpr size_t WS_RSTD1 = 112 * MiB;
constexpr size_t WS_TOKE = 114 * MiB, WS_TOKW = 115 * MiB, WS_SLOTT = 116 * MiB, WS_SLOTW = 117 * MiB;
constexpr size_t WS_XB = 128 * MiB;
constexpr size_t WS_MERGED = WS_XB;
constexpr size_t WS_VGLU = 192 * MiB;
constexpr size_t WS_QB = 224 * MiB;
constexpr size_t WS_KVB = 256 * MiB;
constexpr size_t WS_SGC = 272 * MiB, WS_SGA = 336 * MiB;
constexpr size_t WS_CACT = 400 * MiB, WS_ATT = 432 * MiB;
constexpr size_t WS_HN = 128 * MiB;
constexpr size_t WS_HM = 256 * MiB;
constexpr size_t WS_END = 464 * MiB;
constexpr int MBLK = 128, NBLK_MAX = 544, NSLOT_MAX = NBLK_MAX * MBLK;
constexpr int CW_BAR = 4096, CW_CNT = 16384, CW_CUR = 16384 + 64;
constexpr int RING_BYTES = 131072, LDSCTL_OFF = RING_BYTES, MISC_OFF = LDSCTL_OFF + 320, LDS_BYTES = 147456;

#define XB_TMO      128
#define XB_XCNT(j)  (256  + 64 * (j))
#define XB_XSUB(j)  (1280 + 64 * (j))
#define XB_XGEN(j)  (2304 + 64 * (j))
#define XB_TOP      3328
#define XB_TOPGEN   3392
#define XCD_BAR_WORDS 3456
#define XB_SPIN_CAP (1u << 18)

__device__ __forceinline__ unsigned xb_ld(unsigned* p)              { return __hip_atomic_load(p, __ATOMIC_RELAXED, __HIP_MEMORY_SCOPE_AGENT); }
__device__ __forceinline__ unsigned xb_add(unsigned* p, unsigned v) { return __hip_atomic_fetch_add(p, v, __ATOMIC_RELAXED, __HIP_MEMORY_SCOPE_AGENT); }
__device__ __forceinline__ unsigned xb_xcc_id() { return (unsigned)__builtin_amdgcn_s_getreg((3 << 11) | 20) & 0xFu; }
#define XB_SPIN(cond, bar) do { unsigned _sp = 0; while (cond) { __builtin_amdgcn_s_sleep(1); \
    if ((++_sp & 255u) == 0u) { if (xb_ld(&(bar)[XB_TMO])) break; if (_sp > XB_SPIN_CAP) { atomicAdd(&(bar)[XB_TMO], 1u); break; } } } } while (0)

struct XcdBarrier { unsigned* bar; unsigned x; volatile LAS unsigned* st; bool leader; };

__device__ __forceinline__ XcdBarrier xcd_barrier_post(unsigned* bar, volatile LAS unsigned* st, bool wave0) {
    XcdBarrier b; b.bar = bar; b.x = xb_xcc_id(); b.st = st; b.leader = wave0;
    if (wave0 && __builtin_amdgcn_mbcnt_hi(~0u, __builtin_amdgcn_mbcnt_lo(~0u, 0u)) == 0u) (void)xb_add(&bar[XB_XCNT(b.x)], 1u);
    return b;
}
__device__ __forceinline__ void xcd_barrier_complete(unsigned* bar, unsigned x, unsigned& nloc, unsigned& nx) {
    const unsigned G = gridDim.x * gridDim.y * gridDim.z;
    unsigned sum, cnt, mine, sp = 0u;
    for (;;) {
        sum = 0u; cnt = 0u; mine = 0u;
#pragma unroll
        for (unsigned j = 0; j < 16; ++j) { const unsigned c = xb_ld(&bar[XB_XCNT(j)]); sum += c; cnt += (c > 0u) ? 1u : 0u; mine = (j == x) ? c : mine; }
        if (sum == G) break;
        __builtin_amdgcn_s_sleep(1);
        if ((++sp & 255u) == 0u) { if (xb_ld(&bar[XB_TMO])) break; if (sp > XB_SPIN_CAP) { atomicAdd(&bar[XB_TMO], 1u); break; } }
    }
    nloc = mine > 0u ? mine : 1u; nx = cnt > 0u ? cnt : 1u;
}
__device__ __forceinline__ void xcd_barrier(const XcdBarrier& b) {
    asm volatile("s_waitcnt vmcnt(0)" ::: "memory");
    __syncthreads();
    if (b.leader && __builtin_amdgcn_mbcnt_hi(~0u, __builtin_amdgcn_mbcnt_lo(~0u, 0u)) == 0u) {
        unsigned* bar = b.bar;
        __builtin_amdgcn_s_waitcnt(0);
        unsigned nloc = b.st[0], nx = b.st[1];
        if (nloc == 0u) { xcd_barrier_complete(bar, b.x, nloc, nx); b.st[0] = nloc; b.st[1] = nx; }
        const unsigned old = xb_add(&bar[XB_XSUB(b.x)], 1u);
        const unsigned gen = old / nloc;
        if (old + 1u == (gen + 1u) * nloc) {
            __builtin_amdgcn_fence(__ATOMIC_RELEASE, "agent");
            asm volatile("s_waitcnt vmcnt(0)" ::: "memory");
            const unsigned og = xb_add(&bar[XB_TOP], 1u);
            const unsigned tg = og / nx;
            if (og + 1u == (tg + 1u) * nx) xb_add(&bar[XB_TOPGEN], 1u);
            else XB_SPIN(xb_ld(&bar[XB_TOPGEN]) == tg, bar);
            __builtin_amdgcn_fence(__ATOMIC_ACQUIRE, "agent");
            xb_add(&bar[XB_XGEN(b.x)], 1u);
            asm volatile("s_waitcnt vmcnt(0)" ::: "memory");
        } else {
            XB_SPIN(xb_ld(&bar[XB_XGEN(b.x)]) == gen, bar);
            __builtin_amdgcn_fence(__ATOMIC_ACQUIRE, "agent");
            asm volatile("s_waitcnt vmcnt(0)" ::: "memory");
        }
    }
    __syncthreads();
}

struct Params {
    const float *x, *g_mix, *w_in, *w_dw, *b_dw, *ln_g, *ln_b, *sinks, *w_conv_out, *w_attn_out, *w_out, *g_ffn,
                *w_group, *b_group, *w_expert, *b_expert, *w_gate, *w_up, *w_down, *g_final;
    float* out; unsigned char* ws;
};

__device__ __forceinline__ void p0_transpose_item(const float* W, int ld, int srccol, int k0, const float* gain, bf16_t* WT, int K, int dstrow, LAS float* scr, int lane) {
#pragma unroll 8
    for (int i = 0; i < 32; ++i) { const int kk = 2 * i + (lane >> 5); float v = W[(size_t)(k0 + kk) * ld + srccol + (lane & 31)]; if (gain) v *= gain[k0 + kk]; scr[kk * 33 + (lane & 31)] = v; }
    asm volatile("s_waitcnt lgkmcnt(0)" ::: "memory");
    const int c = lane & 7;
#pragma unroll
    for (int j = 0; j < 4; ++j) { const int n = (lane >> 3) + 8 * j; const LAS float* s = scr + (8 * c) * 33 + n;
        u32x4 o; o.x = cvt_pk_bf16(s[0 * 33], s[1 * 33]); o.y = cvt_pk_bf16(s[2 * 33], s[3 * 33]); o.z = cvt_pk_bf16(s[4 * 33], s[5 * 33]); o.w = cvt_pk_bf16(s[6 * 33], s[7 * 33]);
        *(u32x4*)(WT + (size_t)(dstrow + n) * K + k0 + 8 * c) = o; }
    asm volatile("s_waitcnt lgkmcnt(0)" ::: "memory");
}
__device__ __forceinline__ int win_srccol(int np) {
    const int pn = np >> 8, bj = (np >> 7) & 1, o = np & 127;
    if (pn < 4) return (bj ? 512 : 0) + 128 * pn + o;
    if (pn < 6) return 1024 + 256 * (pn - 4) + 128 * bj + o;
    if (pn == 6) return (bj ? 1664 : 1536) + o;
    return (bj ? 2816 : 1792) + 128 * (pn - 7) + o;
}
__device__ __forceinline__ void p0_prologue(const Params& p, LAS unsigned char* lds, const int wave_s) {
    unsigned char* ws = p.ws;
    const int tidx = opaque_tid(wave_s), lane = tidx & 63, wave = tidx >> 6;
    LAS float* scr = (LAS float*)(lds + wave * 16384);
    const int gw = blockIdx.x * (NT / 64) + wave, NGW = gridDim.x * (NT / 64);
    bf16_t* wt_in = (bf16_t*)(ws + WS_WT_IN); bf16_t* wt_co = (bf16_t*)(ws + WS_WT_CO); bf16_t* wt_ao = (bf16_t*)(ws + WS_WT_AO); bf16_t* wt_out = (bf16_t*)(ws + WS_WT_OUT);
    constexpr int I_IN = (D / 64) * (INC / 32), I_CO = (CC / 64) * (D / 32), I_AO = (QD / 64) * (D / 32), I_OUT = (D / 64) * (D / 32);
    constexpr int NITEMS = I_IN + I_CO + I_AO + I_OUT;
    for (int it = gw; it < NITEMS; it += NGW) {
        int r = it;
        if (r < I_IN) { const int nblk = INC / 32, kb = r / nblk, nb = r % nblk; p0_transpose_item(p.w_in, INC, win_srccol(32 * nb), 64 * kb, p.g_mix, wt_in, D, 32 * nb, scr, lane); continue; } r -= I_IN;
        if (r < I_CO) { const int nblk = D / 32, kb = r / nblk, nb = r % nblk; p0_transpose_item(p.w_conv_out, D, 32 * nb, 64 * kb, nullptr, wt_co, CC, 32 * nb, scr, lane); continue; } r -= I_CO;
        if (r < I_AO) { const int nblk = D / 32, kb = r / nblk, nb = r % nblk; p0_transpose_item(p.w_attn_out, D, 32 * nb, 64 * kb, nullptr, wt_ao, QD, 32 * nb, scr, lane); continue; } r -= I_AO;
        { const int nblk = D / 32, kb = r / nblk, nb = r % nblk; p0_transpose_item(p.w_out, D, 32 * nb, 64 * kb, nullptr, wt_out, D, 32 * nb, scr, lane); }
    }
    bf16_t* xb = (bf16_t*)(ws + WS_XB); float* rstd1 = (float*)(ws + WS_RSTD1);
    for (int m = gw; m < T; m += NGW) {
        const f32x4* xr = (const f32x4*)(p.x + (size_t)m * D) + lane;
        f32x4 v[4]; float s = 0.f;
#pragma unroll
        for (int j = 0; j < 4; ++j) { v[j] = xr[64 * j]; s += (v[j][0] * v[j][0] + v[j][1] * v[j][1]) + (v[j][2] * v[j][2] + v[j][3] * v[j][3]); }
        s = wave_sum(s);
        if (lane == 0) rstd1[m] = rsqrtf(s * (1.f / D) + EPS);
        u32x2* o = (u32x2*)(xb + (size_t)m * D) + lane;
#pragma unroll
        for (int j = 0; j < 4; ++j) { u32x2 w; w.x = cvt_pk_bf16(v[j][0], v[j][1]); w.y = cvt_pk_bf16(v[j][2], v[j][3]); o[64 * j] = w; }
    }
}

template <int N> __device__ __forceinline__ void red_step(float (&v)[16], int lane, int k) {
#pragma unroll
    for (int a = 0; a < N / 2; ++a) { const bool up = (lane & k) != 0; const float send = up ? v[a] : v[a + N / 2], keep = up ? v[a + N / 2] : v[a]; v[a] = keep + __shfl_xor(send, k); }
}
constexpr int CONV_ROWS = 64 + CW - 1;
__device__ __forceinline__ void conv_phase(const Params& p, const bf16_t* vglu, bf16_t* cact, LAS unsigned char* lds, const int wave_s) {
    const int tid = opaque_tid(wave_s), lane = tid & 63, wid = tid >> 6, cp = tid & 255, th = tid >> 8, wq = wid & 3;
    float w0[CW], w1[CW];
#pragma unroll
    for (int j = 0; j < CW; ++j) { w0[j] = p.w_dw[j * CC + 2 * cp]; w1[j] = p.w_dw[j * CC + 2 * cp + 1]; }
    const float bi0 = p.b_dw[2 * cp], bi1 = p.b_dw[2 * cp + 1], lg0 = p.ln_g[2 * cp], lg1 = p.ln_g[2 * cp + 1], lb0 = p.ln_b[2 * cp], lb1 = p.ln_b[2 * cp + 1];
    LAS unsigned char* Vs = lds;
    LAS float* red = (LAS float*)(lds + CONV_ROWS * 1024);
    for (int cb = blockIdx.x; cb < T / 64; cb += gridDim.x) {
        const int t0 = cb * 64, seq0 = (t0 / SEQ) * SEQ;
        __syncthreads();
        for (int c = tid; c < CONV_ROWS * 64; c += NT) {
            const int row = c >> 6, ch = c & 63, pos = t0 - (CW - 1) + row; u32x4 v = {0u, 0u, 0u, 0u};
            if (pos >= seq0) v = *(const u32x4*)(vglu + (size_t)pos * CC + ch * 8);
            *(LAS u32x4*)(Vs + row * 1024 + ch * 16) = v; }
        __syncthreads();
#pragma unroll 1
        for (int grp = 0; grp < 4; ++grp) {
            float y[8][2]; const int tok0 = 32 * th + 8 * grp;
#pragma unroll
            for (int i = 0; i < 8; ++i) { float y0 = bi0, y1 = bi1; const LAS unsigned char* base = Vs + (tok0 + i) * 1024 + cp * 4;
#pragma unroll
                for (int j = 0; j < CW; ++j) { const unsigned pr = *(const LAS unsigned*)(base + j * 1024); y0 = fmaf(w0[j], bf_lo(pr), y0); y1 = fmaf(w1[j], bf_hi(pr), y1); }
                y[i][0] = y0; y[i][1] = y1; }
            float v[16];
#pragma unroll
            for (int i = 0; i < 8; ++i) { v[i] = y[i][0] + y[i][1]; v[8 + i] = y[i][0] * y[i][0] + y[i][1] * y[i][1]; }
            red_step<16>(v, lane, 32); red_step<8>(v, lane, 16); red_step<4>(v, lane, 8); red_step<2>(v, lane, 4);
            float tot = v[0]; tot += __shfl_xor(tot, 2); tot += __shfl_xor(tot, 1);
            const int idx = ((lane >> 5) & 1) * 8 + ((lane >> 4) & 1) * 4 + ((lane >> 3) & 1) * 2 + ((lane >> 2) & 1);
            LAS float* rb = red + (grp & 1) * 128;
            if ((lane & 3) == 0) rb[(th * 4 + wq) * 16 + idx] = tot;
            __syncthreads();
#pragma unroll
            for (int i = 0; i < 8; ++i) {
                float S = 0.f, Q = 0.f;
#pragma unroll
                for (int q = 0; q < 4; ++q) { S += rb[(th * 4 + q) * 16 + i]; Q += rb[(th * 4 + q) * 16 + 8 + i]; }
                const float mean = S * (1.f / CC), var = Q * (1.f / CC) - mean * mean, rstd = rsqrtf(fmaxf(var, 0.f) + EPS);
                float z0 = (y[i][0] - mean) * rstd * lg0 + lb0, z1 = (y[i][1] - mean) * rstd * lg1 + lb1;
                z0 *= fsig(z0); z1 *= fsig(z1);
                *(unsigned*)(cact + (size_t)(t0 + tok0 + i) * CC + 2 * cp) = cvt_pk_bf16(z0, z1);
            }
        }
    }
}

__device__ __forceinline__ int crow(int r, int hi) { return (r & 3) + 8 * (r >> 2) + 4 * hi; }
constexpr int ATT_KS = 144, ATT_VT = 400, ATT_VT_OFF = 192 * ATT_KS;
__device__ __forceinline__ void attn_phase(const Params& p, const bf16_t* qb, const bf16_t* kvb, bf16_t* att, LAS unsigned char* lds, const int wave_s) {
    const int tid = opaque_tid(wave_s), lane = tid & 63, wid = __builtin_amdgcn_readfirstlane(tid >> 6), r32 = lane & 31, hi = lane >> 5, g = wid & 3, w2 = wid >> 2;
    LAS unsigned char* Ks = lds; LAS unsigned char* Vt = lds + ATT_VT_OFF;
    for (int u = blockIdx.x; u < (T / 64) * 2; u += gridDim.x) {
        const int qblk = u >> 1, kvh = u & 1, t0 = qblk * 64, seq0 = (t0 / SEQ) * SEQ, kpos0 = t0 - 128, h = kvh * 4 + g;
        __syncthreads();
        for (int c = tid; c < 192 * 8; c += NT) {
            const int row = c >> 3, ch = c & 7, pos = kpos0 + row; u32x4 kk = {0u, 0u, 0u, 0u}, vv = {0u, 0u, 0u, 0u};
            if (pos >= seq0) { const bf16_t* src = kvb + (size_t)pos * 256 + kvh * HD + ch * 8; kk = *(const u32x4*)src; vv = *(const u32x4*)(src + 128); }
            *(LAS u32x4*)(Ks + row * ATT_KS + ch * 16) = kk;
            LAS bf16_t* vt = (LAS bf16_t*)(Vt + (ch * 8) * ATT_VT) + row;
            vt[0 * (ATT_VT / 2)] = (bf16_t)(vv.x & 0xffffu); vt[1 * (ATT_VT / 2)] = (bf16_t)(vv.x >> 16); vt[2 * (ATT_VT / 2)] = (bf16_t)(vv.y & 0xffffu); vt[3 * (ATT_VT / 2)] = (bf16_t)(vv.y >> 16);
            vt[4 * (ATT_VT / 2)] = (bf16_t)(vv.z & 0xffffu); vt[5 * (ATT_VT / 2)] = (bf16_t)(vv.z >> 16); vt[6 * (ATT_VT / 2)] = (bf16_t)(vv.w & 0xffffu); vt[7 * (ATT_VT / 2)] = (bf16_t)(vv.w >> 16);
        }
        __syncthreads();
        const int tw = t0 + 32 * w2;
        bf16x8 qf[4]; { const bf16_t* qp = qb + (size_t)(tw + r32) * QD + h * HD + hi * 8;
#pragma unroll
            for (int ks = 0; ks < 4; ++ks) qf[ks] = *(const bf16x8*)(qp + ks * 16); }
        f32x16 pt[5];
#pragma unroll
        for (int jj = 0; jj < 5; ++jj) { f32x16 a = {0.f, 0.f, 0.f, 0.f, 0.f, 0.f, 0.f, 0.f, 0.f, 0.f, 0.f, 0.f, 0.f, 0.f, 0.f, 0.f};
            const LAS unsigned char* kp = Ks + (32 * (w2 + jj) + r32) * ATT_KS + hi * 16;
#pragma unroll
            for (int ks = 0; ks < 4; ++ks) { const bf16x8 kf = *(const LAS bf16x8*)(kp + ks * 32); a = __builtin_amdgcn_mfma_f32_32x32x16_bf16(kf, qf[ks], a, 0, 0, 0); }
            pt[jj] = a; __builtin_amdgcn_sched_barrier(0); }
        const float slope2 = exp2f(-(float)(h + 1)) * LOG2E, sink2 = p.sinks[h] * LOG2E;
        const int kmin = seq0 - (tw - 128); const int r32o = opaque_i(r32), hio = opaque_i(hi);
        float m = sink2;
#pragma unroll
        for (int jj = 0; jj < 5; ++jj)
#pragma unroll
            for (int r = 0; r < 16; ++r) { const int kw = 32 * jj + crow(r, hio), rel = 128 + r32o - kw; const bool valid = (kw > r32o) && (kw <= r32o + 128) && (kw >= kmin);
                const float s = valid ? pt[jj][r] - slope2 * (float)rel : -INFINITY; pt[jj][r] = s; m = fmaxf(m, s); }
        m = fmaxf(m, __shfl_xor(m, 32));
        float l = 0.f;
#pragma unroll
        for (int jj = 0; jj < 5; ++jj)
#pragma unroll
            for (int r = 0; r < 16; ++r) { const float e = __builtin_amdgcn_exp2f(pt[jj][r] - m); pt[jj][r] = e; l += e; }
        l += __shfl_xor(l, 32); l += __builtin_amdgcn_exp2f(sink2 - m);
        f32x16 o0 = {0.f, 0.f, 0.f, 0.f, 0.f, 0.f, 0.f, 0.f, 0.f, 0.f, 0.f, 0.f, 0.f, 0.f, 0.f, 0.f}, o1 = o0;
#pragma unroll
        for (int jj = 0; jj < 5; ++jj)
#pragma unroll
            for (int s2 = 0; s2 < 2; ++s2) {
                u32x4 pw; pw.x = cvt_pk_bf16(pt[jj][8 * s2 + 0], pt[jj][8 * s2 + 1]); pw.y = cvt_pk_bf16(pt[jj][8 * s2 + 2], pt[jj][8 * s2 + 3]);
                pw.z = cvt_pk_bf16(pt[jj][8 * s2 + 4], pt[jj][8 * s2 + 5]); pw.w = cvt_pk_bf16(pt[jj][8 * s2 + 6], pt[jj][8 * s2 + 7]);
                const bf16x8 pf = __builtin_bit_cast(bf16x8, pw);
                const LAS unsigned char* vp = Vt + r32 * ATT_VT + (32 * (w2 + jj) + 16 * s2 + 4 * hi) * 2;
                const u32x2 a0 = *(const LAS u32x2*)vp, a1 = *(const LAS u32x2*)(vp + 16), b0 = *(const LAS u32x2*)(vp + 32 * ATT_VT), b1 = *(const LAS u32x2*)(vp + 32 * ATT_VT + 16);
                const bf16x8 vf0 = __builtin_bit_cast(bf16x8, (u32x4){a0.x, a0.y, a1.x, a1.y}), vf1 = __builtin_bit_cast(bf16x8, (u32x4){b0.x, b0.y, b1.x, b1.y});
                o0 = __builtin_amdgcn_mfma_f32_32x32x16_bf16(vf0, pf, o0, 0, 0, 0); o1 = __builtin_amdgcn_mfma_f32_32x32x16_bf16(vf1, pf, o1, 0, 0, 0);
                __builtin_amdgcn_sched_barrier(0);
            }
        const float inv = 1.f / l;
        bf16_t* op = att + (size_t)(tw + r32) * QD + h * HD + 4 * hi;
#pragma unroll
        for (int rg = 0; rg < 4; ++rg) {
            u32x2 w0, w1; w0.x = cvt_pk_bf16(o0[4 * rg] * inv, o0[4 * rg + 1] * inv); w0.y = cvt_pk_bf16(o0[4 * rg + 2] * inv, o0[4 * rg + 3] * inv);
            w1.x = cvt_pk_bf16(o1[4 * rg] * inv, o1[4 * rg + 1] * inv); w1.y = cvt_pk_bf16(o1[4 * rg + 2] * inv, o1[4 * rg + 3] * inv);
            *(u32x2*)(op + 8 * rg) = w0; *(u32x2*)(op + 32 + 8 * rg) = w1; }
    }
}


enum { EPI_STORE = 0, EPI_SILU_MUL = 4, EPI_SCATTER = 5 };
struct GemmP {
    const float* A; int lda; const int* arow;
    const float* B; int ldb;
    float* C; int ldc; int K;
    const int* srow; const float* sw;
};
template <int EPI>
__device__ __forceinline__ void gemm_tile(const GemmP& g, int m0, int n0, float* lds, const int wave_s) {
    const int tidx = opaque_tid(wave_s);
    float (*As)[132] = (float (*)[132])lds;
    float (*Bs)[128] = (float (*)[128])(lds + 16 * 132);
    const int tid = tidx, tx = tid & 15, ty = tid >> 4;
    const int ar = tid >> 2, akq = (tid & 3) * 4;
    const int bk = tid >> 5, bc = (tid & 31) * 4;
    int arow = m0 + ar; if (g.arow) arow = g.arow[m0 + ar];
    const float* Ap = g.A + (size_t)(arow < 0 ? 0 : arow) * g.lda + akq;
    const float* Bp = g.B + (size_t)bk * g.ldb + n0 + bc;
    float acc[4][8];
#pragma unroll
    for (int i = 0; i < 4; ++i)
#pragma unroll
        for (int j = 0; j < 8; ++j) acc[i][j] = 0.f;
    float4 ra = (arow < 0) ? make_float4(0.f, 0.f, 0.f, 0.f) : *(const float4*)Ap;
    float4 rb = *(const float4*)Bp;
    for (int k0 = 0; k0 < g.K; k0 += 16) {
        __syncthreads();
        As[akq + 0][ar] = ra.x; As[akq + 1][ar] = ra.y; As[akq + 2][ar] = ra.z; As[akq + 3][ar] = ra.w;
        *(float4*)&Bs[bk][bc] = rb;
        __syncthreads();
        if (k0 + 16 < g.K) {
            ra = (arow < 0) ? make_float4(0.f, 0.f, 0.f, 0.f) : *(const float4*)(Ap + k0 + 16);
            rb = *(const float4*)(Bp + (size_t)(k0 + 16) * g.ldb);
        }
#pragma unroll
        for (int kk = 0; kk < 16; ++kk) {
            const float4 a = *(const float4*)&As[kk][ty * 4];
            const float4 b0 = *(const float4*)&Bs[kk][tx * 8], b1 = *(const float4*)&Bs[kk][tx * 8 + 4];
            const float av[4] = {a.x, a.y, a.z, a.w}; const float bv[8] = {b0.x, b0.y, b0.z, b0.w, b1.x, b1.y, b1.z, b1.w};
#pragma unroll
            for (int i = 0; i < 4; ++i)
#pragma unroll
                for (int j = 0; j < 8; ++j) acc[i][j] = fmaf(av[i], bv[j], acc[i][j]);
        }
    }
#pragma unroll
    for (int i = 0; i < 4; ++i) {
        const int r = m0 + ty * 4 + i, c = n0 + tx * 8;
        if (EPI == EPI_SCATTER) {
            const int tok = g.srow[r]; if (tok < 0) continue; const float w = g.sw[r];
            float* dst = g.C + (size_t)tok * g.ldc + c;
#pragma unroll
            for (int j = 0; j < 8; ++j) atomicAdd(dst + j, w * acc[i][j]);
        } else {
            float* dst = g.C + (size_t)r * g.ldc + c;
            float o[8];
#pragma unroll
            for (int j = 0; j < 8; ++j) {
                float v = acc[i][j];
                if (EPI == EPI_SILU_MUL) { const float gt = dst[j]; v = gt * sigmoidf_(gt) * v; }
                o[j] = v;
            }
            *(float4*)dst = make_float4(o[0], o[1], o[2], o[3]); *(float4*)(dst + 4) = make_float4(o[4], o[5], o[6], o[7]);
        }
    }
}
__device__ __forceinline__ void rmsnorm_rows(const float* in, const float* gain, float* outp, const int wave_s) {
    const int tidx = opaque_tid(wave_s);
    const int lane = tidx & 63, gw = blockIdx.x * (NT / 64) + (tidx >> 6), NGW = gridDim.x * (NT / 64);
    for (int m = gw; m < T; m += NGW) {
        const float4* xr = (const float4*)(in + (size_t)m * D) + lane;
        float4 v[4]; float s = 0.f;
#pragma unroll
        for (int j = 0; j < 4; ++j) { v[j] = xr[64 * j]; s += v[j].x * v[j].x + v[j].y * v[j].y + v[j].z * v[j].z + v[j].w * v[j].w; }
        const float rstd = rsqrtf(wave_sum(s) * (1.f / D) + EPS);
        float4* o = (float4*)(outp + (size_t)m * D) + lane;
#pragma unroll
        for (int j = 0; j < 4; ++j) { const float4 gg = ((const float4*)gain)[lane + 64 * j];
            o[64 * j] = make_float4(v[j].x * rstd * gg.x, v[j].y * rstd * gg.y, v[j].z * rstd * gg.z, v[j].w * rstd * gg.w); }
    }
}
__device__ __forceinline__ void route_phase(const Params& p, const float* h, float* hn, int* toke, float* tokw, unsigned* counts, int* slott, float* slotw, const int wave_s) {
    const int tidx = opaque_tid(wave_s);
    const int lane = tidx & 63, gw = blockIdx.x * (NT / 64) + (tidx >> 6), NGW = gridDim.x * (NT / 64);
    for (int i = blockIdx.x * NT + tidx; i < NSLOT_MAX; i += gridDim.x * NT) { slott[i] = -1; slotw[i] = 0.f; }
    for (int m = gw; m < T; m += NGW) {
        const int lane_o = opaque_i(lane);
        const float4* xr = (const float4*)(h + (size_t)m * D) + lane;
        float4 v[4]; float s = 0.f;
#pragma unroll
        for (int j = 0; j < 4; ++j) { v[j] = xr[64 * j]; s += v[j].x * v[j].x + v[j].y * v[j].y + v[j].z * v[j].z + v[j].w * v[j].w; }
        const float rstd = rsqrtf(wave_sum(s) * (1.f / D) + EPS);
        float lg[NG + NE];
#pragma unroll
        for (int e = 0; e < NG + NE; ++e) lg[e] = 0.f;
        float4* o = (float4*)(hn + (size_t)m * D) + lane;
#pragma unroll
        for (int j = 0; j < 4; ++j) {
            const float4 gg = ((const float4*)p.g_ffn)[lane + 64 * j];
            const float4 y = make_float4(v[j].x * rstd * gg.x, v[j].y * rstd * gg.y, v[j].z * rstd * gg.z, v[j].w * rstd * gg.w);
            o[64 * j] = y;
            const float yy[4] = {y.x, y.y, y.z, y.w};
            const int k0 = (lane_o + 64 * j) * 4;
#pragma unroll
            for (int q = 0; q < 4; ++q) {
                const float4 wg = *(const float4*)(p.w_group + (size_t)(k0 + q) * NG);
                lg[0] = fmaf(yy[q], wg.x, lg[0]); lg[1] = fmaf(yy[q], wg.y, lg[1]); lg[2] = fmaf(yy[q], wg.z, lg[2]); lg[3] = fmaf(yy[q], wg.w, lg[3]);
                const float4* we = (const float4*)(p.w_expert + (size_t)(k0 + q) * NE);
#pragma unroll
                for (int e4 = 0; e4 < NE / 4; ++e4) { const float4 w4 = we[e4];
                    lg[4 + e4 * 4 + 0] = fmaf(yy[q], w4.x, lg[4 + e4 * 4 + 0]); lg[4 + e4 * 4 + 1] = fmaf(yy[q], w4.y, lg[4 + e4 * 4 + 1]);
                    lg[4 + e4 * 4 + 2] = fmaf(yy[q], w4.z, lg[4 + e4 * 4 + 2]); lg[4 + e4 * 4 + 3] = fmaf(yy[q], w4.w, lg[4 + e4 * 4 + 3]); }
            }
        }
#pragma unroll
        for (int e = 0; e < NG + NE; ++e) lg[e] = wave_sum(lg[e]);
        float gl[NG]; float gmax = -INFINITY; int gsel = 0;
#pragma unroll
        for (int g = 0; g < NG; ++g) { gl[g] = lg[g] + p.b_group[g]; if (gl[g] > gmax) { gmax = gl[g]; gsel = g; } }
        float gden = 0.f;
#pragma unroll
        for (int g = 0; g < NG; ++g) gden += __expf(gl[g] - gmax);
        const float pg = 1.f / gden;
        float v1 = -INFINITY, v2 = -INFINITY; int i1 = 0, i2 = 0;
#pragma unroll
        for (int g = 0; g < NG; ++g) if (g == gsel) {
#pragma unroll
            for (int j = 0; j < EPG; ++j) { const float val = lg[4 + g * EPG + j] + p.b_expert[g * EPG + j];
                if (val > v1) { v2 = v1; i2 = i1; v1 = val; i1 = j; } else if (val > v2) { v2 = val; i2 = j; } }
        }
        const float e2 = __expf(v2 - v1), w1 = pg / (1.f + e2), w2 = pg * e2 / (1.f + e2);
        if (lane == 0) {
            const int ea = gsel * EPG + i1, eb = gsel * EPG + i2;
            toke[2 * m] = ea; toke[2 * m + 1] = eb; tokw[2 * m] = w1; tokw[2 * m + 1] = w2;
            atomicAdd(&counts[ea], 1u); atomicAdd(&counts[eb], 1u);
        }
    }
}
__device__ __forceinline__ void load_offsets(const unsigned* counts, int* pst, const int wave_s) {
    const int tidx = opaque_tid(wave_s);
    __syncthreads();
    if (tidx == 0) { int acc = 0; for (int e = 0; e < NE; ++e) { pst[e] = acc; const int c = (int)__hip_atomic_load(counts + e, __ATOMIC_RELAXED, __HIP_MEMORY_SCOPE_AGENT); acc += ((c + MBLK - 1) / MBLK) * MBLK; } pst[NE] = acc; }
    __syncthreads();
}
__device__ __forceinline__ int block_expert(const int* pst, int row0) { int e = 0;
#pragma unroll 1
    for (int i = 1; i < NE; ++i) if (row0 >= pst[i]) e = i;
    return e; }
__device__ __forceinline__ void scatter_phase(const int* toke, const float* tokw, const unsigned* counts, unsigned* cursor, int* slott, float* slotw, int* pst, const int wave_s) {
    const int tidx = opaque_tid(wave_s);
    load_offsets(counts, pst, wave_s);
    for (int a = blockIdx.x * NT + tidx; a < 2 * T; a += gridDim.x * NT) {
        const int e = toke[a]; const int pos = pst[e] + (int)atomicAdd(&cursor[e], 1u);
        slott[pos] = a >> 1; slotw[pos] = tokw[a];
    }
}
template <int EPI>
__device__ __forceinline__ void gemm_moe(GemmP g, const float* wbase, size_t wstride, int N, const unsigned* counts, int* pst, float* lds, const int wave_s) {
    load_offsets(counts, pst, wave_s);
    const int nN = N / 128, ntiles = (pst[NE] / MBLK) * nN;
    for (int t = blockIdx.x; t < ntiles; t += gridDim.x) {
        const int m0 = (t / nN) * MBLK; const int e = block_expert(pst, m0);
        g.B = wbase + (size_t)e * wstride;
        gemm_tile<EPI>(g, m0, (t % nN) * 128, lds, wave_s);
    }
}


__global__ void __launch_bounds__(NT, 2) k_all(Params p) {
    extern __shared__ __attribute__((aligned(16))) unsigned char lds_raw[];
    LAS unsigned char* lds = (LAS unsigned char*)lds_raw;
    volatile LAS unsigned* MISC = (volatile LAS unsigned*)(lds + MISC_OFF);
    const int wave_s = __builtin_amdgcn_readfirstlane((int)threadIdx.x >> 6);
    for (int u = threadIdx.x; u < (LDS_BYTES - LDSCTL_OFF) / 4; u += NT) ((LAS unsigned*)(lds + LDSCTL_OFF))[u] = 0u;
    __syncthreads();
    unsigned char* ws = p.ws;
    unsigned* ctl = (unsigned*)(ws + WS_CTL);
    XcdBarrier bar = xcd_barrier_post(ctl + CW_BAR, MISC + 8, wave_s == 0);
    const int G = gridDim.x;

    bf16_t* wt_in = (bf16_t*)(ws + WS_WT_IN); bf16_t* wt_co = (bf16_t*)(ws + WS_WT_CO); bf16_t* wt_ao = (bf16_t*)(ws + WS_WT_AO); bf16_t* wt_out = (bf16_t*)(ws + WS_WT_OUT);
    bf16_t* xb = (bf16_t*)(ws + WS_XB); bf16_t* merged = (bf16_t*)(ws + WS_MERGED); float* rstd1 = (float*)(ws + WS_RSTD1);
    bf16_t* vglu = (bf16_t*)(ws + WS_VGLU); bf16_t* qb = (bf16_t*)(ws + WS_QB); bf16_t* kvb = (bf16_t*)(ws + WS_KVB);
    bf16_t* sgc = (bf16_t*)(ws + WS_SGC); bf16_t* sga = (bf16_t*)(ws + WS_SGA); bf16_t* cact = (bf16_t*)(ws + WS_CACT); bf16_t* att = (bf16_t*)(ws + WS_ATT);
    float* H = p.out;

#ifndef ENABLE
#define ENABLE 0xff
#endif
    asm volatile("; PHASE_MARK 0");
    if (ENABLE & 1) p0_prologue(p, lds, wave_s);
    xcd_barrier(bar);
    asm volatile("; PHASE_MARK 1");
    if (ENABLE & 2) { pg8::DenseSched S; S.init(xb, wt_in, T, INC, D, G, (int)blockIdx.x);
      pg8::EpiProj E{rstd1, vglu, qb, kvb, sgc, sga, 0.125f * LOG2E};
      pg8::gemm_phase<pg8::EpiProj, pg8::DenseSched, true, true>(lds, D, S, E, wave_s); }
    xcd_barrier(bar);
    asm volatile("; PHASE_MARK 2");
    if (ENABLE & 4) conv_phase(p, vglu, cact, lds, wave_s);
    asm volatile("; PHASE_MARK 3");
    if (ENABLE & 8) attn_phase(p, qb, kvb, att, lds, wave_s);
    xcd_barrier(bar);
    asm volatile("; PHASE_MARK 4");
    if (ENABLE & 16) { pg8::DenseSched S; S.init(cact, wt_co, T, D, CC, G, (int)blockIdx.x);
      pg8::EpiGate<false> E{sgc, merged};
      pg8::gemm_phase<pg8::EpiGate<false>, pg8::DenseSched, true, true>(lds, CC, S, E, wave_s); }
    asm volatile("; PHASE_MARK 5");
    if (ENABLE & 16) { pg8::DenseSched S; S.init(att, wt_ao, T, D, QD, G, (int)blockIdx.x);
      pg8::EpiGate<true> E{sga, merged};
      pg8::gemm_phase<pg8::EpiGate<true>, pg8::DenseSched, true, true>(lds, QD, S, E, wave_s); }
    xcd_barrier(bar);
    asm volatile("; PHASE_MARK 6");
    if (ENABLE & 32) { pg8::DenseSched S; S.init(merged, wt_out, T, D, D, G, (int)blockIdx.x);
      pg8::EpiResid E{p.x, H};
      pg8::gemm_phase<pg8::EpiResid, pg8::DenseSched, true, true>(lds, D, S, E, wave_s); }
    xcd_barrier(bar);
    asm volatile("; PHASE_MARK 7");
    if (ENABLE & 64) {
        float* fl = (float*)lds_raw; int* pst = (int*)(fl + 16 * 132 + 16 * 128);
        float* HN = (float*)(ws + WS_HN); float* HM = (float*)(ws + WS_HM);
        unsigned* counts = ctl + CW_CNT; unsigned* cursor = ctl + CW_CUR;
        int* toke = (int*)(ws + WS_TOKE); float* tokw = (float*)(ws + WS_TOKW); int* slott = (int*)(ws + WS_SLOTT); float* slotw = (float*)(ws + WS_SLOTW);
        route_phase(p, H, HN, toke, tokw, counts, slott, slotw, wave_s);
        xcd_barrier(bar);
        scatter_phase(toke, tokw, counts, cursor, slott, slotw, pst, wave_s);
        xcd_barrier(bar);
        { GemmP g{HN, D, slott, nullptr, DFF, HM, DFF, D, nullptr, nullptr}; gemm_moe<EPI_STORE>(g, p.w_gate, (size_t)D * DFF, DFF, counts, pst, fl, wave_s); }
        xcd_barrier(bar);
        { GemmP g{HN, D, slott, nullptr, DFF, HM, DFF, D, nullptr, nullptr}; gemm_moe<EPI_SILU_MUL>(g, p.w_up, (size_t)D * DFF, DFF, counts, pst, fl, wave_s); }
        xcd_barrier(bar);
        { GemmP g{HM, DFF, nullptr, nullptr, D, H, D, DFF, slott, slotw}; gemm_moe<EPI_SCATTER>(g, p.w_down, (size_t)DFF * D, D, counts, pst, fl, wave_s); }
        xcd_barrier(bar);
        rmsnorm_rows(H, p.g_final, p.out, wave_s);
    }
}

extern "C" void kernel_launch(void* const* d_in, const int* in_sizes, int n_in, void* d_out, int out_size, void* d_ws, size_t ws_size, hipStream_t stream) {
    static int grid = 0;
    if (grid == 0) {
        if (n_in != 20 || in_sizes[0] != T * D || out_size != T * D || ws_size < WS_END) {
            fprintf(stderr, "kernel_launch: unexpected shapes (n_in %d, in0 %d, out %d, ws %zu); nothing launched\n", n_in, n_in > 0 ? in_sizes[0] : -1, out_size, ws_size); grid = -1; return; }
        int dev = 0, cus = 0, per_cu = 0;
        if (hipGetDevice(&dev) != hipSuccess || hipDeviceGetAttribute(&cus, hipDeviceAttributeMultiprocessorCount, dev) != hipSuccess) { grid = -1; return; }
        if (hipFuncSetAttribute((const void*)k_all, hipFuncAttributeMaxDynamicSharedMemorySize, LDS_BYTES) != hipSuccess) { fprintf(stderr, "kernel_launch: hipFuncSetAttribute failed\n"); grid = -1; return; }
        if (hipOccupancyMaxActiveBlocksPerMultiprocessor(&per_cu, (const void*)k_all, NT, LDS_BYTES) != hipSuccess || per_cu < 1)
            fprintf(stderr, "kernel_launch: note: occupancy query reports %d workgroups per CU\n", per_cu);
        (void)hipGetLastError();
        grid = cus;
    }
    if (grid < 0) return;
    if (hipMemsetAsync((char*)d_ws + WS_CTL, 0, CTL_BYTES, stream) != hipSuccess) return;
    Params p{};
    const float** pp = (const float**)&p;
    for (int i = 0; i < 20; ++i) pp[i] = (const float*)d_in[i];
    p.out = (float*)d_out; p.ws = (unsigned char*)d_ws;
    hipLaunchKernelGGL(k_all, dim3(grid), dim3(NT), LDS_BYTES, stream, p);
}
```

```cpp
#include <hip/hip_runtime.h>
#include <cstdio>
#include <cstdint>

constexpr int T = 32768, D = 1024, SEQ = 4096;
constexpr int CC = 512, CW = 31, NH = 8, HD = 64, QD = 512, KVD = 128, INC = 3840;
constexpr int NE = 32, NG = 4, EPG = 8, DFF = 512;
constexpr float EPS = 1e-6f;
constexpr int NT = 512;
constexpr float LOG2E = 1.4426950408889634f;

#define GAS __attribute__((address_space(1)))
#define LAS __attribute__((address_space(3)))
typedef unsigned short bf16_t;
typedef short bf16x8 __attribute__((ext_vector_type(8)));
typedef float f32x4 __attribute__((ext_vector_type(4)));
typedef float f32x16 __attribute__((ext_vector_type(16)));
typedef unsigned u32x4 __attribute__((ext_vector_type(4)));
typedef unsigned u32x2 __attribute__((ext_vector_type(2)));

__device__ __forceinline__ int opaque_tid(int wave_s) { int t = wave_s * 64 + (int)__builtin_amdgcn_mbcnt_hi(~0u, __builtin_amdgcn_mbcnt_lo(~0u, 0u)); asm volatile("" : "+v"(t)); return t; }
__device__ __forceinline__ int opaque_i(int v) { asm volatile("" : "+v"(v)); return v; }
__device__ __forceinline__ float wave_sum(float v) {
#pragma unroll
    for (int o = 1; o < 64; o <<= 1) v += __shfl_xor(v, o);
    return v;
}
__device__ __forceinline__ float sigmoidf_(float v) { return 1.f / (1.f + __expf(-v)); }
__device__ __forceinline__ float fsig(float v) { return __builtin_amdgcn_rcpf(1.f + __builtin_amdgcn_exp2f(-LOG2E * v)); }
__device__ __forceinline__ unsigned cvt_pk_bf16(float lo, float hi) { unsigned r; asm volatile("v_cvt_pk_bf16_f32 %0, %1, %2" : "=v"(r) : "v"(lo), "v"(hi)); return r; }
__device__ __forceinline__ float bf_lo(unsigned w) { return __uint_as_float(w << 16); }
__device__ __forceinline__ float bf_hi(unsigned w) { return __uint_as_float(w & 0xffff0000u); }

namespace pg8 {
#define PG8_LAS __attribute__((address_space(3)))
constexpr int BM = 256, BK = 64, HALF = 128, HTB = HALF * BK * 2  , STAGE_BYTES = 8 * HTB, NXCD = 8, WGM = 8;

__host__ __device__ __forceinline__ int lds_byte(int r, int c) { const int st = (r >> 4) * 2 + (c >> 5), rr = r & 15, cc = c & 31, ob = rr * 64 + cc * 2; return st * 1024 + (ob ^ (((ob >> 9) & 1) << 5)); }
__host__ __device__ __forceinline__ void stage_rc(int b, int& R, int& C) { const int st = b / 1024, sb = b % 1024, swz = sb ^ (((sb >> 9) & 1) << 5); R = (st >> 1) * 16 + swz / 64; C = (st & 1) * 32 + (swz % 64) / 2; }
__host__ __device__ __forceinline__ int perm32(int rho) { const int n = rho >> 4, i = rho & 15; return 8 * (i >> 2) + 4 * n + (i & 3); }

struct Unit { int pm, pn; const char* a; const char* b; int aux, rank0; };

struct StaticOrder {
    int nM, nN, nwg, G, c;
    __host__ __device__ void init(int M, int N, int G_, int c_) { nM = M / BM; nN = N / BM; nwg = nM * nN; G = G_; c = c_; }
    __host__ __device__ bool next_mn(int i, int& pm, int& pn) const {
        const long L = (long)i * G + c; if (L >= nwg) return false;
        int wgid = (int)L; { const int q = nwg / NXCD, r = nwg % NXCD, xcd = wgid % NXCD, off = wgid / NXCD; wgid = (xcd < r ? xcd * (q + 1) : r * (q + 1) + (xcd - r) * q) + off; }
        const int nig = WGM * nN, gid = wgid / nig, fm = gid * WGM, gsz = (nM - fm) < WGM ? (nM - fm) : WGM;
        pm = fm + ((wgid % nig) % gsz); pn = (wgid % nig) / gsz; return true;
    }
};
struct DenseSched {
    StaticOrder so; const char* A; const char* Bt; size_t tstep;
    __device__ __forceinline__ void init(const bf16_t* A_, const bf16_t* Bt_, int M, int N, int K, int G, int c) { so.init(M, N, G, c); A = (const char*)A_; Bt = (const char*)Bt_; tstep = (size_t)BM * K * 2; }
    __device__ __forceinline__ bool next(int i, Unit& u) const { if (!so.next_mn(i, u.pm, u.pn)) return false; u.a = A + (size_t)u.pm * tstep; u.b = Bt + (size_t)u.pn * tstep; u.aux = 0; u.rank0 = 0; return true; }
    __device__ __forceinline__ void a_voff(const Unit&, int, int tid, int K, unsigned (&v)[2][2]) const {
#pragma unroll
        for (int i = 0; i < 2; ++i) { int R, C; stage_rc(tid * 16 + i * 8192, R, C); v[0][i] = (unsigned)(R * K + C) * 2u; v[1][i] = (unsigned)((HALF + R) * K + C) * 2u; } }
    __device__ __forceinline__ void a_ready(const Unit&) const {}
    __device__ __forceinline__ void done(const Unit&) const {}
};

template <class Epi, class Sched, bool ALIGN_EPI = false, bool SP2 = false>
__device__ __forceinline__ void gemm_phase(PG8_LAS unsigned char* lds, const int K_, const Sched& S, const Epi& E, const int wave_s) {
    const int tid_ = opaque_tid(wave_s); const int tid = tid_, wid = __builtin_amdgcn_readfirstlane(tid >> 6), lane = tid & 63, wr = wid >> 2, wc = wid & 3, fr = lane & 15, fq = lane >> 4;
    const int K = K_, nt = K / BK;
    unsigned voffB[2]; unsigned vC[2][2], vN[2][2];
#pragma unroll
    for (int i = 0; i < 2; ++i) { int R, C; stage_rc(tid * 16 + i * 8192, R, C); const int Rb = Epi::PERM ? ((R & ~31) + perm32(R & 31)) : R;
        voffB[i] = (unsigned)(Rb * K + C) * 2u; }
    const size_t kstep = (size_t)(BK * 2);
    const size_t hstep = (size_t)HALF * K * 2;
    const unsigned ldsw = (unsigned)wid * 1024u;
    const int aoff = lds_byte(wr * 64 + fr, fq * 8), boff = lds_byte(wc * 32 + fr, fq * 8);
#define PG8_SA(b, h) (((b) * 2 + (h)) * HTB)
#define PG8_SB(b, h) ((4 + (b) * 2 + (h)) * HTB)
#define PG8_STAGE(bufoff, gbase, voff) do { _Pragma("unroll") for (int _i = 0; _i < 2; ++_i) \
        __builtin_amdgcn_global_load_lds((const unsigned*)((const char*)(gbase) + (voff)[_i]), (PG8_LAS unsigned*)(lds + (bufoff) + ldsw + _i * 8192), 16, 0, 0); } while (0)
#define PG8_LDA(dst, b, h) do { _Pragma("unroll") for (int m = 0; m < 4; ++m) _Pragma("unroll") for (int k = 0; k < 2; ++k) dst[m][k] = *(const PG8_LAS bf16x8*)(lds + PG8_SA(b, h) + aoff + m * 2048 + k * 1024); } while (0)
#define PG8_LDB(dst, b, h) do { _Pragma("unroll") for (int n = 0; n < 2; ++n) _Pragma("unroll") for (int k = 0; k < 2; ++k) dst[n][k] = *(const PG8_LAS bf16x8*)(lds + PG8_SB(b, h) + boff + n * 2048 + k * 1024); } while (0)
#define PG8_MMA(ai, bj, At, Bt) do { __builtin_amdgcn_s_setprio(1); _Pragma("unroll") for (int m = 0; m < 4; ++m) _Pragma("unroll") for (int n = 0; n < 2; ++n) _Pragma("unroll") for (int k = 0; k < 2; ++k) \
        acc[ai][bj][m][n] = __builtin_amdgcn_mfma_f32_16x16x32_bf16(Bt[n][k], At[m][k], acc[ai][bj][m][n], 0, 0, 0); __builtin_amdgcn_s_setprio(0); } while (0)
#define PG8_WAIT_V(n) asm volatile("s_waitcnt vmcnt(" #n ")" ::: "memory")
#define PG8_WAIT_L(n) asm volatile("s_waitcnt lgkmcnt(" #n ")" ::: "memory")
#define PG8_BAR __builtin_amdgcn_s_barrier()
#define PG8_SCHED __builtin_amdgcn_sched_barrier(0)
    Unit cur, nxt; int ui = 0;
    if (!S.next(0, cur)) return;
    S.a_voff(cur, 0, tid, K, vC);
    f32x4 acc[2][2][4][2];
#pragma unroll
    for (int a = 0; a < 2; ++a)
#pragma unroll
        for (int b = 0; b < 2; ++b)
#pragma unroll
            for (int m = 0; m < 4; ++m)
#pragma unroll
                for (int n = 0; n < 2; ++n) acc[a][b][m][n] = (f32x4){0.f, 0.f, 0.f, 0.f};
    bf16x8 At[4][2], B0[2][2], B1[2][2];
    const char* cA = cur.a; const char* cB = cur.b;
    S.a_ready(cur);
    if constexpr (SP2) {
        PG8_STAGE(PG8_SB(0, 0), cB, voffB); PG8_STAGE(PG8_SB(0, 1), cB + hstep, voffB); PG8_STAGE(PG8_SA(0, 0), cA, vC[0]); PG8_STAGE(PG8_SA(0, 1), cA, vC[1]);
        if (wr == 1) PG8_BAR;
        PG8_WAIT_V(2); PG8_BAR;
        PG8_STAGE(PG8_SB(1, 0), cB + kstep, voffB); PG8_STAGE(PG8_SA(1, 0), cA + kstep, vC[0]); PG8_STAGE(PG8_SB(1, 1), cB + hstep + kstep, voffB);
        PG8_WAIT_V(6); PG8_BAR;
    } else {
        PG8_STAGE(PG8_SB(0, 0), cB, voffB); PG8_STAGE(PG8_SA(0, 0), cA, vC[0]); PG8_STAGE(PG8_SB(0, 1), cB + hstep, voffB); PG8_STAGE(PG8_SA(0, 1), cA, vC[1]);
        if (wr == 1) PG8_BAR;
        PG8_WAIT_V(4); PG8_BAR;
        PG8_STAGE(PG8_SB(1, 0), cB + kstep, voffB); PG8_STAGE(PG8_SA(1, 0), cA + kstep, vC[0]); PG8_STAGE(PG8_SB(1, 1), cB + hstep + kstep, voffB);
        PG8_WAIT_V(6); PG8_BAR;
    }
    for (;;) {
        const bool has_next = S.next(ui + 1, nxt);
        if (has_next) S.a_voff(nxt, ui + 1, tid, K, vN); else { vN[0][0] = vC[0][0]; vN[0][1] = vC[0][1]; vN[1][0] = vC[1][0]; vN[1][1] = vC[1][1]; }
        const char* nA = has_next ? nxt.a : cA; const char* nB = has_next ? nxt.b : cB;
        for (int t = 0; t < nt; t += 2) {
            const bool last = (t == nt - 2);
            unsigned v2[2][2]; v2[0][0] = last ? vN[0][0] : vC[0][0]; v2[0][1] = last ? vN[0][1] : vC[0][1]; v2[1][0] = last ? vN[1][0] : vC[1][0]; v2[1][1] = last ? vN[1][1] : vC[1][1];
            const char* a1 = cA + (size_t)(t + 1) * kstep;
            const char* a2 = last ? nA : cA + (size_t)(t + 2) * kstep; const char* b2 = last ? nB : cB + (size_t)(t + 2) * kstep;
            const char* a3 = a2 + kstep; const char* b3 = b2 + kstep;
            if (last && has_next) S.a_ready(nxt);
            if constexpr (SP2) {
            PG8_LDB(B0, 0, 0); PG8_LDB(B1, 0, 1); PG8_SCHED; PG8_LDA(At, 0, 0); PG8_STAGE(PG8_SA(1, 1), a1, vC[1]);
            PG8_WAIT_V(8); PG8_WAIT_L(0); PG8_BAR; PG8_MMA(0, 0, At, B0); PG8_MMA(0, 1, At, B1); PG8_BAR; PG8_SCHED;
            PG8_LDA(At, 0, 1); PG8_STAGE(PG8_SB(0, 0), b2, voffB); PG8_STAGE(PG8_SB(0, 1), b2 + hstep, voffB); PG8_STAGE(PG8_SA(0, 0), a2, v2[0]);
            PG8_WAIT_V(8); PG8_WAIT_L(0); PG8_BAR; PG8_MMA(1, 0, At, B0); PG8_MMA(1, 1, At, B1); PG8_BAR; PG8_SCHED;
            PG8_LDB(B0, 1, 0); PG8_LDB(B1, 1, 1); PG8_SCHED; PG8_LDA(At, 1, 0); PG8_STAGE(PG8_SA(0, 1), a2, v2[1]);
            PG8_WAIT_V(8); PG8_WAIT_L(0); PG8_BAR; PG8_MMA(0, 0, At, B0); PG8_MMA(0, 1, At, B1); PG8_BAR; PG8_SCHED;
            PG8_LDA(At, 1, 1); PG8_STAGE(PG8_SB(1, 0), b3, voffB); PG8_STAGE(PG8_SB(1, 1), b3 + hstep, voffB); PG8_STAGE(PG8_SA(1, 0), a3, v2[0]);
            PG8_WAIT_V(8); PG8_WAIT_L(0); PG8_BAR; PG8_MMA(1, 0, At, B0); PG8_MMA(1, 1, At, B1); PG8_BAR; PG8_SCHED;
            } else {
            PG8_LDB(B0, 0, 0); PG8_SCHED; PG8_LDA(At, 0, 0); PG8_STAGE(PG8_SA(1, 1), a1, vC[1]);
            PG8_WAIT_L(8); PG8_BAR; PG8_WAIT_L(0); PG8_MMA(0, 0, At, B0); PG8_BAR; PG8_SCHED;
            PG8_LDB(B1, 0, 1); PG8_STAGE(PG8_SB(0, 0), b2, voffB);
            PG8_BAR; PG8_WAIT_L(0); PG8_MMA(0, 1, At, B1); PG8_BAR;
            PG8_LDA(At, 0, 1); PG8_STAGE(PG8_SA(0, 0), a2, v2[0]);
            PG8_BAR; PG8_WAIT_L(0); PG8_MMA(1, 0, At, B0); PG8_BAR; PG8_SCHED;
            PG8_STAGE(PG8_SB(0, 1), b2 + hstep, voffB);
            PG8_WAIT_V(6); PG8_BAR; PG8_MMA(1, 1, At, B1); PG8_BAR;
            PG8_LDB(B0, 1, 0); PG8_SCHED; PG8_LDA(At, 1, 0); PG8_STAGE(PG8_SA(0, 1), a2, v2[1]);
            PG8_WAIT_L(8); PG8_BAR; PG8_WAIT_L(0); PG8_MMA(0, 0, At, B0); PG8_BAR; PG8_SCHED;
            PG8_LDB(B1, 1, 1); PG8_STAGE(PG8_SB(1, 0), b3, voffB);
            PG8_BAR; PG8_WAIT_L(0); PG8_MMA(0, 1, At, B1); PG8_BAR;
            PG8_LDA(At, 1, 1); PG8_STAGE(PG8_SA(1, 0), a3, v2[0]);
            PG8_BAR; PG8_WAIT_L(0); PG8_MMA(1, 0, At, B0); PG8_BAR; PG8_SCHED;
            PG8_STAGE(PG8_SB(1, 1), b3 + hstep, voffB);
            PG8_WAIT_V(6); PG8_BAR; PG8_MMA(1, 1, At, B1); PG8_BAR;
            }
        }
        if constexpr (ALIGN_EPI) { if (wr == 0) PG8_BAR; }
        if constexpr (!Epi::AFTER_DRAIN) { E(acc, cur, wr, wc, fr, fq); S.done(cur); }
        if (!has_next) break;
#pragma unroll
        for (int a = 0; a < 2; ++a)
#pragma unroll
            for (int b = 0; b < 2; ++b)
#pragma unroll
                for (int m = 0; m < 4; ++m)
#pragma unroll
                    for (int n = 0; n < 2; ++n) acc[a][b][m][n] = (f32x4){0.f, 0.f, 0.f, 0.f};
        cur = nxt; cA = nA; cB = nB; ++ui; vC[0][0] = vN[0][0]; vC[0][1] = vN[0][1]; vC[1][0] = vN[1][0]; vC[1][1] = vN[1][1];
        if constexpr (ALIGN_EPI) { if (wr == 1) PG8_BAR; }
    }
    PG8_WAIT_V(0);
    if constexpr (!ALIGN_EPI) { if (wr == 0) PG8_BAR; }
    PG8_BAR;
    if constexpr (Epi::AFTER_DRAIN) { E.fused(acc, cur, wr, wc, fr, fq, lds, wid, lane); S.done(cur); }
#undef PG8_SA
#undef PG8_SB
#undef PG8_STAGE
#undef PG8_LDA
#undef PG8_LDB
#undef PG8_MMA
#undef PG8_WAIT_V
#undef PG8_WAIT_L
#undef PG8_BAR
#undef PG8_SCHED
}

__device__ __forceinline__ u32x4 pack8(const f32x4 v0, const f32x4 v1) { u32x4 w; w.x = cvt_pk_bf16(v0[0], v0[1]); w.y = cvt_pk_bf16(v0[2], v0[3]); w.z = cvt_pk_bf16(v1[0], v1[1]); w.w = cvt_pk_bf16(v1[2], v1[3]); return w; }
__device__ __forceinline__ f32x4 sig4(const f32x4 v) { return (f32x4){fsig(v[0]), fsig(v[1]), fsig(v[2]), fsig(v[3])}; }

struct EpiProj {
    static constexpr bool PERM = true, AFTER_DRAIN = false;
    const float* rstd; bf16_t *vglu, *qb, *kvb, *sgc, *sga; float qscale;
    __device__ __forceinline__ void operator()(const f32x4 (&acc)[2][2][4][2], const Unit& u, int wr, int wc, int fr, int fq) const {
        const int pn = __builtin_amdgcn_readfirstlane(u.pn); const int coff = wc * 32 + 8 * fq; const int row0 = u.pm * BM + wr * 64 + fr;
#pragma unroll
        for (int ai = 0; ai < 2; ++ai)
#pragma unroll
            for (int m = 0; m < 4; ++m) {
                const int r = row0 + ai * HALF + m * 16; const float s = rstd[r];
                const f32x4 a0 = acc[ai][0][m][0] * s, a1 = acc[ai][0][m][1] * s, b0 = acc[ai][1][m][0] * s, b1 = acc[ai][1][m][1] * s;
                if (pn < 4) {
                    *(u32x4*)(vglu + (size_t)r * CC + 128 * pn + coff) = pack8(a0 * sig4(b0), a1 * sig4(b1));
                } else if (pn < 6) {
                    bf16_t* qp = qb + (size_t)r * QD + 256 * (pn - 4) + coff;
                    *(u32x4*)qp = pack8(a0 * qscale, a1 * qscale); *(u32x4*)(qp + HALF) = pack8(b0 * qscale, b1 * qscale);
                } else if (pn == 6) {
                    bf16_t* kp = kvb + (size_t)r * 256 + coff;
                    *(u32x4*)kp = pack8(a0, a1); *(u32x4*)(kp + HALF) = pack8(b0, b1);
                } else {
                    const size_t o = (size_t)r * D + 128 * (pn - 7) + coff;
                    *(u32x4*)(sgc + o) = pack8(sig4(a0), sig4(a1)); *(u32x4*)(sga + o) = pack8(sig4(b0), sig4(b1));
                }
            }
    }
};
template <bool ADD> struct EpiGate {
    static constexpr bool PERM = true, AFTER_DRAIN = false;
    const bf16_t* G; bf16_t* O;
    __device__ __forceinline__ void operator()(const f32x4 (&acc)[2][2][4][2], const Unit& u, int wr, int wc, int fr, int fq) const {
        const int row0 = u.pm * BM + wr * 64 + fr, col0 = u.pn * BM + wc * 32 + 8 * fq;
#pragma unroll
        for (int ai = 0; ai < 2; ++ai)
#pragma unroll
            for (int m = 0; m < 4; ++m) {
                const size_t o = (size_t)(row0 + ai * HALF + m * 16) * D + col0;
#pragma unroll
                for (int bj = 0; bj < 2; ++bj) {
                    const u32x4 g = *(const u32x4*)(G + o + bj * HALF);
                    f32x4 v0 = acc[ai][bj][m][0] * (f32x4){bf_lo(g.x), bf_hi(g.x), bf_lo(g.y), bf_hi(g.y)};
                    f32x4 v1 = acc[ai][bj][m][1] * (f32x4){bf_lo(g.z), bf_hi(g.z), bf_lo(g.w), bf_hi(g.w)};
                    if (ADD) { const u32x4 p = *(const u32x4*)(O + o + bj * HALF);
                        v0 += (f32x4){bf_lo(p.x), bf_hi(p.x), bf_lo(p.y), bf_hi(p.y)}; v1 += (f32x4){bf_lo(p.z), bf_hi(p.z), bf_lo(p.w), bf_hi(p.w)}; }
                    *(u32x4*)(O + o + bj * HALF) = pack8(v0, v1);
                }
                if (m & 1) asm volatile("" ::: "memory");
            }
    }
};
struct EpiResid {
    static constexpr bool PERM = false, AFTER_DRAIN = false;
    const float* X; float* H;
    __device__ __forceinline__ void operator()(const f32x4 (&acc)[2][2][4][2], const Unit& u, int wr, int wc, int fr, int fq) const {
        const int row0 = u.pm * BM + wr * 64 + fr, col0 = u.pn * BM + wc * 32 + 4 * fq;
#pragma unroll
        for (int ai = 0; ai < 2; ++ai)
#pragma unroll
            for (int m = 0; m < 4; ++m) {
                const size_t o = (size_t)(row0 + ai * HALF + m * 16) * D + col0;
#pragma unroll
                for (int bj = 0; bj < 2; ++bj)
#pragma unroll
                    for (int n = 0; n < 2; ++n) *(f32x4*)(H + o + bj * HALF + n * 16) = *(const f32x4*)(X + o + bj * HALF + n * 16) + acc[ai][bj][m][n];
                if (m & 1) asm volatile("" ::: "memory");
            }
    }
};
}


constexpr size_t MiB = 1u << 20;
constexpr size_t WS_CTL = 0, CTL_BYTES = 1 * MiB;
constexpr size_t WS_WT_IN = 2 * MiB;
constexpr size_t WS_WT_CO = 10 * MiB, WS_WT_AO = 11 * MiB;
constexpr size_t WS_WT_OUT = 12 * MiB;
constexpr size_t WS_WT_GU = 16 * MiB;
constexpr size_t WS_WT_D = 80 * MiB;
constexpr size_t WS_RSTD1 = 112 * MiB;
constexpr size_t WS_TOKE = 113 * MiB;
constexpr size_t WS_TOKR = 113 * MiB + 512 * 1024;
constexpr size_t WS_LTOK = 114 * MiB, WS_LRS = 118 * MiB, WS_LW = 122 * MiB;
constexpr size_t WS_XB = 128 * MiB;
constexpr size_t WS_MERGED = WS_XB;
constexpr size_t WS_VGLU = 192 * MiB;
constexpr size_t WS_QB = 224 * MiB;
constexpr size_t WS_HB = 192 * MiB;
constexpr size_t WS_KVB = 256 * MiB;
constexpr size_t WS_SGC = 272 * MiB, WS_SGA = 336 * MiB;
constexpr size_t WS_Y = 256 * MiB;
constexpr size_t WS_CACT = 400 * MiB, WS_ATT = 432 * MiB;
constexpr size_t WS_HMID = 400 * MiB;
constexpr size_t WS_END = 472 * MiB;
constexpr int CAP = 32768;
constexpr int NSLOT = 2 * T + NE * 256;
static_assert(WS_Y + (size_t)NSLOT * D * 2 <= WS_CACT && WS_HMID + (size_t)NSLOT * DFF * 2 <= WS_END, "d_ws map");
constexpr int CW_BAR = 4096, CW_CNT = 16384;
constexpr int RING_BYTES = 131072, LDS_BYTES = 147456, MISC_OFF = LDS_BYTES - 128;
constexpr int MOE_TBL_OFF = RING_BYTES, MOE_MAXU = 8;
constexpr int MOE_UT_OFF = MOE_TBL_OFF + MOE_MAXU * 1024, MOE_NBP_OFF = MOE_UT_OFF + MOE_MAXU * 16, MOE_CNT_OFF = MOE_NBP_OFF + 160;
static_assert(MOE_CNT_OFF + 128 <= MISC_OFF, "LDS map");

#define XB_TMO      128
#define XB_XCNT(j)  (256  + 64 * (j))
#define XB_XSUB(j)  (1280 + 64 * (j))
#define XB_XGEN(j)  (2304 + 64 * (j))
#define XB_TOP      3328
#define XB_TOPGEN   3392
#define XCD_BAR_WORDS 3456
#define XB_SPIN_CAP (1u << 18)

__device__ __forceinline__ unsigned xb_ld(unsigned* p)              { return __hip_atomic_load(p, __ATOMIC_RELAXED, __HIP_MEMORY_SCOPE_AGENT); }
__device__ __forceinline__ unsigned xb_add(unsigned* p, unsigned v) { return __hip_atomic_fetch_add(p, v, __ATOMIC_RELAXED, __HIP_MEMORY_SCOPE_AGENT); }
__device__ __forceinline__ unsigned xb_xcc_id() { return (unsigned)__builtin_amdgcn_s_getreg((3 << 11) | 20) & 0xFu; }
#define XB_SPIN(cond, bar) do { unsigned _sp = 0; while (cond) { __builtin_amdgcn_s_sleep(1); \
    if ((++_sp & 255u) == 0u) { if (xb_ld(&(bar)[XB_TMO])) break; if (_sp > XB_SPIN_CAP) { atomicAdd(&(bar)[XB_TMO], 1u); break; } } } } while (0)

struct XcdBarrier { unsigned* bar; unsigned x; volatile LAS unsigned* st; bool leader; };

__device__ __forceinline__ XcdBarrier xcd_barrier_post(unsigned* bar, volatile LAS unsigned* st, bool wave0) {
    XcdBarrier b; b.bar = bar; b.x = xb_xcc_id(); b.st = st; b.leader = wave0;
    if (wave0 && __builtin_amdgcn_mbcnt_hi(~0u, __builtin_amdgcn_mbcnt_lo(~0u, 0u)) == 0u) (void)xb_add(&bar[XB_XCNT(b.x)], 1u);
    return b;
}
__device__ __forceinline__ void xcd_barrier_complete(unsigned* bar, unsigned x, unsigned& nloc, unsigned& nx) {
    const unsigned G = gridDim.x * gridDim.y * gridDim.z;
    unsigned sum, cnt, mine, sp = 0u;
    for (;;) {
        sum = 0u; cnt = 0u; mine = 0u;
#pragma unroll
        for (unsigned j = 0; j < 16; ++j) { const unsigned c = xb_ld(&bar[XB_XCNT(j)]); sum += c; cnt += (c > 0u) ? 1u : 0u; mine = (j == x) ? c : mine; }
        if (sum == G) break;
        __builtin_amdgcn_s_sleep(1);
        if ((++sp & 255u) == 0u) { if (xb_ld(&bar[XB_TMO])) break; if (sp > XB_SPIN_CAP) { atomicAdd(&bar[XB_TMO], 1u); break; } }
    }
    nloc = mine > 0u ? mine : 1u; nx = cnt > 0u ? cnt : 1u;
}
__device__ __forceinline__ void xcd_barrier(const XcdBarrier& b) {
    asm volatile("s_waitcnt vmcnt(0)" ::: "memory");
    __syncthreads();
    if (b.leader && __builtin_amdgcn_mbcnt_hi(~0u, __builtin_amdgcn_mbcnt_lo(~0u, 0u)) == 0u) {
        unsigned* bar = b.bar;
        __builtin_amdgcn_s_waitcnt(0);
        unsigned nloc = b.st[0], nx = b.st[1];
        if (nloc == 0u) { xcd_barrier_complete(bar, b.x, nloc, nx); b.st[0] = nloc; b.st[1] = nx; }
        const unsigned old = xb_add(&bar[XB_XSUB(b.x)], 1u);
        const unsigned gen = old / nloc;
        if (old + 1u == (gen + 1u) * nloc) {
            __builtin_amdgcn_fence(__ATOMIC_RELEASE, "agent");
            asm volatile("s_waitcnt vmcnt(0)" ::: "memory");
            const unsigned og = xb_add(&bar[XB_TOP], 1u);
            const unsigned tg = og / nx;
            if (og + 1u == (tg + 1u) * nx) xb_add(&bar[XB_TOPGEN], 1u);
            else XB_SPIN(xb_ld(&bar[XB_TOPGEN]) == tg, bar);
            __builtin_amdgcn_fence(__ATOMIC_ACQUIRE, "agent");
            xb_add(&bar[XB_XGEN(b.x)], 1u);
            asm volatile("s_waitcnt vmcnt(0)" ::: "memory");
        } else {
            XB_SPIN(xb_ld(&bar[XB_XGEN(b.x)]) == gen, bar);
            __builtin_amdgcn_fence(__ATOMIC_ACQUIRE, "agent");
            asm volatile("s_waitcnt vmcnt(0)" ::: "memory");
        }
    }
    __syncthreads();
}

struct Params {
    const float *x, *g_mix, *w_in, *w_dw, *b_dw, *ln_g, *ln_b, *sinks, *w_conv_out, *w_attn_out, *w_out, *g_ffn,
                *w_group, *b_group, *w_expert, *b_expert, *w_gate, *w_up, *w_down, *g_final;
    float* out; unsigned char* ws;
};

__device__ __forceinline__ void p0_transpose_item(const float* W, int ld, int srccol, int k0, const float* gain, bf16_t* WT, int K, int dstrow, LAS float* scr, int lane) {
#pragma unroll 8
    for (int i = 0; i < 32; ++i) { const int kk = 2 * i + (lane >> 5); float v = W[(size_t)(k0 + kk) * ld + srccol + (lane & 31)]; if (gain) v *= gain[k0 + kk]; scr[kk * 33 + (lane & 31)] = v; }
    asm volatile("s_waitcnt lgkmcnt(0)" ::: "memory");
    const int c = lane & 7;
#pragma unroll
    for (int j = 0; j < 4; ++j) { const int n = (lane >> 3) + 8 * j; const LAS float* s = scr + (8 * c) * 33 + n;
        u32x4 o; o.x = cvt_pk_bf16(s[0 * 33], s[1 * 33]); o.y = cvt_pk_bf16(s[2 * 33], s[3 * 33]); o.z = cvt_pk_bf16(s[4 * 33], s[5 * 33]); o.w = cvt_pk_bf16(s[6 * 33], s[7 * 33]);
        *(u32x4*)(WT + (size_t)(dstrow + n) * K + k0 + 8 * c) = o; }
    asm volatile("s_waitcnt lgkmcnt(0)" ::: "memory");
}
__device__ __forceinline__ int win_srccol(int np) {
    const int pn = np >> 8, bj = (np >> 7) & 1, o = np & 127;
    if (pn < 4) return (bj ? 512 : 0) + 128 * pn + o;
    if (pn < 6) return 1024 + 256 * (pn - 4) + 128 * bj + o;
    if (pn == 6) return (bj ? 1664 : 1536) + o;
    return (bj ? 2816 : 1792) + 128 * (pn - 7) + o;
}
__device__ __forceinline__ void p0_prologue(const Params& p, LAS unsigned char* lds, const int wave_s) {
    unsigned char* ws = p.ws;
    const int tidx = opaque_tid(wave_s), lane = tidx & 63, wave = tidx >> 6;
    LAS float* scr = (LAS float*)(lds + wave * 16384);
    const int gw = blockIdx.x * (NT / 64) + wave, NGW = gridDim.x * (NT / 64);
    bf16_t* wt_in = (bf16_t*)(ws + WS_WT_IN); bf16_t* wt_co = (bf16_t*)(ws + WS_WT_CO); bf16_t* wt_ao = (bf16_t*)(ws + WS_WT_AO); bf16_t* wt_out = (bf16_t*)(ws + WS_WT_OUT);
    constexpr int I_IN = (D / 64) * (INC / 32), I_CO = (CC / 64) * (D / 32), I_AO = (QD / 64) * (D / 32), I_OUT = (D / 64) * (D / 32);
    constexpr int NITEMS = I_IN + I_CO + I_AO + I_OUT;
    for (int it = gw; it < NITEMS; it += NGW) {
        int r = it;
        if (r < I_IN) { const int nblk = INC / 32, kb = r / nblk, nb = r % nblk; p0_transpose_item(p.w_in, INC, win_srccol(32 * nb), 64 * kb, p.g_mix, wt_in, D, 32 * nb, scr, lane); continue; } r -= I_IN;
        if (r < I_CO) { const int nblk = D / 32, kb = r / nblk, nb = r % nblk; p0_transpose_item(p.w_conv_out, D, 32 * nb, 64 * kb, nullptr, wt_co, CC, 32 * nb, scr, lane); continue; } r -= I_CO;
        if (r < I_AO) { const int nblk = D / 32, kb = r / nblk, nb = r % nblk; p0_transpose_item(p.w_attn_out, D, 32 * nb, 64 * kb, nullptr, wt_ao, QD, 32 * nb, scr, lane); continue; } r -= I_AO;
        { const int nblk = D / 32, kb = r / nblk, nb = r % nblk; p0_transpose_item(p.w_out, D, 32 * nb, 64 * kb, nullptr, wt_out, D, 32 * nb, scr, lane); }
    }
    bf16_t* xb = (bf16_t*)(ws + WS_XB); float* rstd1 = (float*)(ws + WS_RSTD1);
    for (int m = gw; m < T; m += NGW) {
        const f32x4* xr = (const f32x4*)(p.x + (size_t)m * D) + lane;
        f32x4 v[4]; float s = 0.f;
#pragma unroll
        for (int j = 0; j < 4; ++j) { v[j] = xr[64 * j]; s += (v[j][0] * v[j][0] + v[j][1] * v[j][1]) + (v[j][2] * v[j][2] + v[j][3] * v[j][3]); }
        s = wave_sum(s);
        if (lane == 0) rstd1[m] = rsqrtf(s * (1.f / D) + EPS);
        u32x2* o = (u32x2*)(xb + (size_t)m * D) + lane;
#pragma unroll
        for (int j = 0; j < 4; ++j) { u32x2 w; w.x = cvt_pk_bf16(v[j][0], v[j][1]); w.y = cvt_pk_bf16(v[j][2], v[j][3]); o[64 * j] = w; }
    }
}

template <int N> __device__ __forceinline__ void red_step(float (&v)[16], int lane, int k) {
#pragma unroll
    for (int a = 0; a < N / 2; ++a) { const bool up = (lane & k) != 0; const float send = up ? v[a] : v[a + N / 2], keep = up ? v[a + N / 2] : v[a]; v[a] = keep + __shfl_xor(send, k); }
}
constexpr int CONV_ROWS = 64 + CW - 1;
__device__ __forceinline__ void conv_phase(const Params& p, const bf16_t* vglu, bf16_t* cact, LAS unsigned char* lds, const int wave_s) {
    const int tid = opaque_tid(wave_s), lane = tid & 63, wid = tid >> 6, cp = tid & 255, th = tid >> 8, wq = wid & 3;
    float w0[CW], w1[CW];
#pragma unroll
    for (int j = 0; j < CW; ++j) { w0[j] = p.w_dw[j * CC + 2 * cp]; w1[j] = p.w_dw[j * CC + 2 * cp + 1]; }
    const float bi0 = p.b_dw[2 * cp], bi1 = p.b_dw[2 * cp + 1], lg0 = p.ln_g[2 * cp], lg1 = p.ln_g[2 * cp + 1], lb0 = p.ln_b[2 * cp], lb1 = p.ln_b[2 * cp + 1];
    LAS unsigned char* Vs = lds;
    LAS float* red = (LAS float*)(lds + CONV_ROWS * 1024);
    for (int cb = blockIdx.x; cb < T / 64; cb += gridDim.x) {
        const int t0 = cb * 64, seq0 = (t0 / SEQ) * SEQ;
        __syncthreads();
        for (int c = tid; c < CONV_ROWS * 64; c += NT) {
            const int row = c >> 6, ch = c & 63, pos = t0 - (CW - 1) + row; u32x4 v = {0u, 0u, 0u, 0u};
            if (pos >= seq0) v = *(const u32x4*)(vglu + (size_t)pos * CC + ch * 8);
            *(LAS u32x4*)(Vs + row * 1024 + ch * 16) = v; }
        __syncthreads();
#pragma unroll 1
        for (int grp = 0; grp < 4; ++grp) {
            float y[8][2]; const int tok0 = 32 * th + 8 * grp;
#pragma unroll
            for (int i = 0; i < 8; ++i) { float y0 = bi0, y1 = bi1; const LAS unsigned char* base = Vs + (tok0 + i) * 1024 + cp * 4;
#pragma unroll
                for (int j = 0; j < CW; ++j) { const unsigned pr = *(const LAS unsigned*)(base + j * 1024); y0 = fmaf(w0[j], bf_lo(pr), y0); y1 = fmaf(w1[j], bf_hi(pr), y1); }
                y[i][0] = y0; y[i][1] = y1; }
            float v[16];
#pragma unroll
            for (int i = 0; i < 8; ++i) { v[i] = y[i][0] + y[i][1]; v[8 + i] = y[i][0] * y[i][0] + y[i][1] * y[i][1]; }
            red_step<16>(v, lane, 32); red_step<8>(v, lane, 16); red_step<4>(v, lane, 8); red_step<2>(v, lane, 4);
            float tot = v[0]; tot += __shfl_xor(tot, 2); tot += __shfl_xor(tot, 1);
            const int idx = ((lane >> 5) & 1) * 8 + ((lane >> 4) & 1) * 4 + ((lane >> 3) & 1) * 2 + ((lane >> 2) & 1);
            LAS float* rb = red + (grp & 1) * 128;
            if ((lane & 3) == 0) rb[(th * 4 + wq) * 16 + idx] = tot;
            __syncthreads();
#pragma unroll
            for (int i = 0; i < 8; ++i) {
                float S = 0.f, Q = 0.f;
#pragma unroll
                for (int q = 0; q < 4; ++q) { S += rb[(th * 4 + q) * 16 + i]; Q += rb[(th * 4 + q) * 16 + 8 + i]; }
                const float mean = S * (1.f / CC), var = Q * (1.f / CC) - mean * mean, rstd = rsqrtf(fmaxf(var, 0.f) + EPS);
                float z0 = (y[i][0] - mean) * rstd * lg0 + lb0, z1 = (y[i][1] - mean) * rstd * lg1 + lb1;
                z0 *= fsig(z0); z1 *= fsig(z1);
                *(unsigned*)(cact + (size_t)(t0 + tok0 + i) * CC + 2 * cp) = cvt_pk_bf16(z0, z1);
            }
        }
    }
}

__device__ __forceinline__ int crow(int r, int hi) { return (r & 3) + 8 * (r >> 2) + 4 * hi; }
constexpr int ATT_KS = 144, ATT_VT = 400, ATT_VT_OFF = 192 * ATT_KS;
__device__ __forceinline__ void attn_phase(const Params& p, const bf16_t* qb, const bf16_t* kvb, bf16_t* att, LAS unsigned char* lds, const int wave_s) {
    const int tid = opaque_tid(wave_s), lane = tid & 63, wid = __builtin_amdgcn_readfirstlane(tid >> 6), r32 = lane & 31, hi = lane >> 5, g = wid & 3, w2 = wid >> 2;
    LAS unsigned char* Ks = lds; LAS unsigned char* Vt = lds + ATT_VT_OFF;
    for (int u = blockIdx.x; u < (T / 64) * 2; u += gridDim.x) {
        const int qblk = u >> 1, kvh = u & 1, t0 = qblk * 64, seq0 = (t0 / SEQ) * SEQ, kpos0 = t0 - 128, h = kvh * 4 + g;
        __syncthreads();
        for (int c = tid; c < 192 * 8; c += NT) {
            const int row = c >> 3, ch = c & 7, pos = kpos0 + row; u32x4 kk = {0u, 0u, 0u, 0u}, vv = {0u, 0u, 0u, 0u};
            if (pos >= seq0) { const bf16_t* src = kvb + (size_t)pos * 256 + kvh * HD + ch * 8; kk = *(const u32x4*)src; vv = *(const u32x4*)(src + 128); }
            *(LAS u32x4*)(Ks + row * ATT_KS + ch * 16) = kk;
            LAS bf16_t* vt = (LAS bf16_t*)(Vt + (ch * 8) * ATT_VT) + row;
            vt[0 * (ATT_VT / 2)] = (bf16_t)(vv.x & 0xffffu); vt[1 * (ATT_VT / 2)] = (bf16_t)(vv.x >> 16); vt[2 * (ATT_VT / 2)] = (bf16_t)(vv.y & 0xffffu); vt[3 * (ATT_VT / 2)] = (bf16_t)(vv.y >> 16);
            vt[4 * (ATT_VT / 2)] = (bf16_t)(vv.z & 0xffffu); vt[5 * (ATT_VT / 2)] = (bf16_t)(vv.z >> 16); vt[6 * (ATT_VT / 2)] = (bf16_t)(vv.w & 0xffffu); vt[7 * (ATT_VT / 2)] = (bf16_t)(vv.w >> 16);
        }
        __syncthreads();
        const int tw = t0 + 32 * w2;
        bf16x8 qf[4]; { const bf16_t* qp = qb + (size_t)(tw + r32) * QD + h * HD + hi * 8;
#pragma unroll
            for (int ks = 0; ks < 4; ++ks) qf[ks] = *(const bf16x8*)(qp + ks * 16); }
        f32x16 pt[5];
#pragma unroll
        for (int jj = 0; jj < 5; ++jj) { f32x16 a = {0.f, 0.f, 0.f, 0.f, 0.f, 0.f, 0.f, 0.f, 0.f, 0.f, 0.f, 0.f, 0.f, 0.f, 0.f, 0.f};
            const LAS unsigned char* kp = Ks + (32 * (w2 + jj) + r32) * ATT_KS + hi * 16;
#pragma unroll
            for (int ks = 0; ks < 4; ++ks) { const bf16x8 kf = *(const LAS bf16x8*)(kp + ks * 32); a = __builtin_amdgcn_mfma_f32_32x32x16_bf16(kf, qf[ks], a, 0, 0, 0); }
            pt[jj] = a; __builtin_amdgcn_sched_barrier(0); }
        const float slope2 = exp2f(-(float)(h + 1)) * LOG2E, sink2 = p.sinks[h] * LOG2E;
        const int kmin = seq0 - (tw - 128); const int r32o = opaque_i(r32), hio = opaque_i(hi);
        float m = sink2;
#pragma unroll
        for (int jj = 0; jj < 5; ++jj)
#pragma unroll
            for (int r = 0; r < 16; ++r) { const int kw = 32 * jj + crow(r, hio), rel = 128 + r32o - kw; const bool valid = (kw > r32o) && (kw <= r32o + 128) && (kw >= kmin);
                const float s = valid ? pt[jj][r] - slope2 * (float)rel : -INFINITY; pt[jj][r] = s; m = fmaxf(m, s); }
        m = fmaxf(m, __shfl_xor(m, 32));
        float l = 0.f;
#pragma unroll
        for (int jj = 0; jj < 5; ++jj)
#pragma unroll
            for (int r = 0; r < 16; ++r) { const float e = __builtin_amdgcn_exp2f(pt[jj][r] - m); pt[jj][r] = e; l += e; }
        l += __shfl_xor(l, 32); l += __builtin_amdgcn_exp2f(sink2 - m);
        f32x16 o0 = {0.f, 0.f, 0.f, 0.f, 0.f, 0.f, 0.f, 0.f, 0.f, 0.f, 0.f, 0.f, 0.f, 0.f, 0.f, 0.f}, o1 = o0;
#pragma unroll
        for (int jj = 0; jj < 5; ++jj)
#pragma unroll
            for (int s2 = 0; s2 < 2; ++s2) {
                u32x4 pw; pw.x = cvt_pk_bf16(pt[jj][8 * s2 + 0], pt[jj][8 * s2 + 1]); pw.y = cvt_pk_bf16(pt[jj][8 * s2 + 2], pt[jj][8 * s2 + 3]);
                pw.z = cvt_pk_bf16(pt[jj][8 * s2 + 4], pt[jj][8 * s2 + 5]); pw.w = cvt_pk_bf16(pt[jj][8 * s2 + 6], pt[jj][8 * s2 + 7]);
                const bf16x8 pf = __builtin_bit_cast(bf16x8, pw);
                const LAS unsigned char* vp = Vt + r32 * ATT_VT + (32 * (w2 + jj) + 16 * s2 + 4 * hi) * 2;
                const u32x2 a0 = *(const LAS u32x2*)vp, a1 = *(const LAS u32x2*)(vp + 16), b0 = *(const LAS u32x2*)(vp + 32 * ATT_VT), b1 = *(const LAS u32x2*)(vp + 32 * ATT_VT + 16);
                const bf16x8 vf0 = __builtin_bit_cast(bf16x8, (u32x4){a0.x, a0.y, a1.x, a1.y}), vf1 = __builtin_bit_cast(bf16x8, (u32x4){b0.x, b0.y, b1.x, b1.y});
                o0 = __builtin_amdgcn_mfma_f32_32x32x16_bf16(vf0, pf, o0, 0, 0, 0); o1 = __builtin_amdgcn_mfma_f32_32x32x16_bf16(vf1, pf, o1, 0, 0, 0);
                __builtin_amdgcn_sched_barrier(0);
            }
        const float inv = 1.f / l;
        bf16_t* op = att + (size_t)(tw + r32) * QD + h * HD + 4 * hi;
#pragma unroll
        for (int rg = 0; rg < 4; ++rg) {
            u32x2 w0, w1; w0.x = cvt_pk_bf16(o0[4 * rg] * inv, o0[4 * rg + 1] * inv); w0.y = cvt_pk_bf16(o0[4 * rg + 2] * inv, o0[4 * rg + 3] * inv);
            w1.x = cvt_pk_bf16(o1[4 * rg] * inv, o1[4 * rg + 1] * inv); w1.y = cvt_pk_bf16(o1[4 * rg + 2] * inv, o1[4 * rg + 3] * inv);
            *(u32x2*)(op + 8 * rg) = w0; *(u32x2*)(op + 32 + 8 * rg) = w1; }
    }
}


__device__ __forceinline__ void p0_moe_weights(const Params& p, LAS unsigned char* lds, const int wave_s) {
    unsigned char* ws = p.ws;
    const int tidx = opaque_tid(wave_s), lane = tidx & 63, wave = tidx >> 6;
    LAS float* scr = (LAS float*)(lds + wave * 16384);
    const int gw = blockIdx.x * (NT / 64) + wave, NGW = gridDim.x * (NT / 64);
    bf16_t* wt_gu = (bf16_t*)(ws + WS_WT_GU); bf16_t* wt_d = (bf16_t*)(ws + WS_WT_D);
    constexpr int I_GU = (D / 64) * (1024 / 32), I_D = (DFF / 64) * (D / 32);
    for (int it = gw; it < NE * (I_GU + I_D); it += NGW) {
        const int e = it / (I_GU + I_D); int r = it % (I_GU + I_D);
        if (r < I_GU) { const int kb = r >> 5, nb = r & 31, np = 32 * nb, pn = np >> 8, bj = (np >> 7) & 1, o = np & 127;
            const float* W = (bj ? p.w_up : p.w_gate) + (size_t)e * D * DFF;
            p0_transpose_item(W, DFF, 128 * pn + o, 64 * kb, p.g_ffn, wt_gu + (size_t)e * 1024 * D, D, np, scr, lane); }
        else { r -= I_GU; const int kb = r >> 5, nb = r & 31;
            p0_transpose_item(p.w_down + (size_t)e * DFF * D, D, 32 * nb, 64 * kb, nullptr, wt_d + (size_t)e * D * DFF, DFF, 32 * nb, scr, lane); }
    }
}

typedef __attribute__((address_space(4))) const float cf32;
typedef __attribute__((address_space(4))) const f32x4 cf32x4;
constexpr int RT_TILE = 64 * 68 * 4;
__device__ __forceinline__ void route_phase_fast(const Params& p, const float* H, bf16_t* hb, int* toke, int* tokr, int* ltok, float* lrs, float* lw, unsigned* gcount,
                                                 LAS unsigned char* lds, const int wave_s) {
    const int tid = opaque_tid(wave_s), lane = tid & 63, kq = wave_s & 3, tg = wave_s >> 2;
    LAS float* tile = (LAS float*)(lds + wave_s * RT_TILE);
    LAS unsigned* hist = (LAS unsigned*)(lds + 8 * RT_TILE);
    cf32* G = (cf32*)p.g_ffn; cf32* WG = (cf32*)p.w_group; cf32* WE = (cf32*)p.w_expert;
    for (int task = blockIdx.x; task < T / 128; task += gridDim.x) {
        const int tok0 = task * 128 + tg * 64;
        if (tid < 32) hist[tid] = 0u;
        float acc[NG + NE];
#pragma unroll
        for (int e = 0; e < NG + NE; ++e) acc[e] = 0.f;
        float ss = 0.f;
#pragma unroll 1
        for (int ch = 0; ch < 4; ++ch) {
            const int k0 = kq * 256 + ch * 64, rsub = lane >> 4, c4 = (lane & 15) * 4;
#pragma unroll
            for (int i = 0; i < 16; ++i) { const int row = 4 * i + rsub; const size_t off = (size_t)(tok0 + row) * D + k0 + c4;
                const f32x4 v = *(const f32x4*)(H + off);
                u32x2 w; w.x = cvt_pk_bf16(v[0], v[1]); w.y = cvt_pk_bf16(v[2], v[3]); *(u32x2*)(hb + off) = w;
                *(LAS f32x4*)(tile + row * 68 + c4) = v; }
#pragma unroll 1
            for (int kk = 0; kk < 64; kk += 4) {
                const f32x4 hv = *(const LAS f32x4*)(tile + lane * 68 + kk);
                const int k = __builtin_amdgcn_readfirstlane(k0 + kk);
                const f32x4 g4 = *(cf32x4*)(G + k);
#pragma unroll
                for (int q = 0; q < 4; ++q) {
                    const float hq = hv[q], hg = hq * g4[q]; ss = fmaf(hq, hq, ss);
                    const f32x4 wg = *(cf32x4*)(WG + (k + q) * NG);
                    acc[0] = fmaf(hg, wg[0], acc[0]); acc[1] = fmaf(hg, wg[1], acc[1]); acc[2] = fmaf(hg, wg[2], acc[2]); acc[3] = fmaf(hg, wg[3], acc[3]);
#pragma unroll
                    for (int e4 = 0; e4 < NE / 4; ++e4) { const f32x4 w4 = *(cf32x4*)(WE + (k + q) * NE + e4 * 4);
                        acc[4 + 4 * e4 + 0] = fmaf(hg, w4[0], acc[4 + 4 * e4 + 0]); acc[4 + 4 * e4 + 1] = fmaf(hg, w4[1], acc[4 + 4 * e4 + 1]);
                        acc[4 + 4 * e4 + 2] = fmaf(hg, w4[2], acc[4 + 4 * e4 + 2]); acc[4 + 4 * e4 + 3] = fmaf(hg, w4[3], acc[4 + 4 * e4 + 3]); }
                }
            }
        }
#pragma unroll
        for (int e = 0; e < NG + NE; ++e) tile[lane * 37 + e] = acc[e];
        tile[lane * 37 + 36] = ss;
        __syncthreads();
        int ea = 0, eb = 0; unsigned ra = 0u, rb = 0u; float w1 = 0.f, w2 = 0.f, rstd = 0.f;
        if (kq == 0) {
            float lg[NG + NE]; float s2 = 0.f;
#pragma unroll
            for (int e = 0; e < NG + NE; ++e) lg[e] = 0.f;
#pragma unroll
            for (int q = 0; q < 4; ++q) { const LAS float* pt = (const LAS float*)(lds + (tg * 4 + q) * RT_TILE) + lane * 37;
#pragma unroll
                for (int e = 0; e < NG + NE; ++e) lg[e] += pt[e];
                s2 += pt[36]; }
            rstd = rsqrtf(s2 * (1.f / D) + EPS);
            float gl[NG]; float gmax = -INFINITY; int gsel = 0;
#pragma unroll
            for (int g = 0; g < NG; ++g) { gl[g] = lg[g] * rstd + p.b_group[g]; if (gl[g] > gmax) { gmax = gl[g]; gsel = g; } }
            float gden = 0.f;
#pragma unroll
            for (int g = 0; g < NG; ++g) gden += __expf(gl[g] - gmax);
            const float pg = 1.f / gden;
            float v1 = -INFINITY, v2 = -INFINITY; int i1 = 0, i2 = 0;
#pragma unroll
            for (int g = 0; g < NG; ++g) if (g == gsel) {
#pragma unroll
                for (int j = 0; j < EPG; ++j) { const float val = lg[4 + g * EPG + j] * rstd + p.b_expert[g * EPG + j];
                    if (val > v1) { v2 = v1; i2 = i1; v1 = val; i1 = j; } else if (val > v2) { v2 = val; i2 = j; } }
            }
            const float e2 = __expf(v2 - v1); w1 = pg / (1.f + e2); w2 = pg * e2 / (1.f + e2);
            ea = gsel * EPG + i1; eb = gsel * EPG + i2;
            ra = __hip_atomic_fetch_add(hist + ea, 1u, __ATOMIC_RELAXED, __HIP_MEMORY_SCOPE_WORKGROUP);
            rb = __hip_atomic_fetch_add(hist + eb, 1u, __ATOMIC_RELAXED, __HIP_MEMORY_SCOPE_WORKGROUP);
        }
        __syncthreads();
        if (tid < 32) hist[32 + tid] = __hip_atomic_fetch_add(gcount + tid, hist[tid], __ATOMIC_RELAXED, __HIP_MEMORY_SCOPE_AGENT);
        __syncthreads();
        if (kq == 0) {
            const int tok = tok0 + lane; const unsigned pa = hist[32 + ea] + ra, pb = hist[32 + eb] + rb;
            ltok[(size_t)ea * CAP + pa] = tok; lrs[(size_t)ea * CAP + pa] = rstd; lw[(size_t)ea * CAP + pa] = w1;
            ltok[(size_t)eb * CAP + pb] = tok; lrs[(size_t)eb * CAP + pb] = rstd; lw[(size_t)eb * CAP + pb] = w2;
            toke[2 * tok] = ea; toke[2 * tok + 1] = eb; tokr[2 * tok] = (int)pa; tokr[2 * tok + 1] = (int)pb;
        }
        __syncthreads();
    }
}

__device__ __forceinline__ void moe_build_map(const unsigned* gcount, LAS unsigned char* lds, int tid) {
    LAS int* nbp = (LAS int*)(lds + MOE_NBP_OFF); LAS int* cnt = (LAS int*)(lds + MOE_CNT_OFF);
    __syncthreads();
    if (tid == 0) { int acc = 0;
        for (int e = 0; e < NE; ++e) { const int c = (int)__hip_atomic_load(gcount + e, __ATOMIC_RELAXED, __HIP_MEMORY_SCOPE_AGENT); cnt[e] = c; nbp[e] = acc; acc += (c + 255) >> 8; }
        nbp[NE] = acc; }
    __syncthreads();
}
__device__ __forceinline__ void moe_build_units(const int* ltok, LAS unsigned char* lds, int G, int c, int tid, bool gather) {
    const LAS int* nbp = (const LAS int*)(lds + MOE_NBP_OFF); const LAS int* cnt = (const LAS int*)(lds + MOE_CNT_OFF);
    LAS int* ut = (LAS int*)(lds + MOE_UT_OFF); LAS unsigned* tbl = (LAS unsigned*)(lds + MOE_TBL_OFF);
    const int nunits = nbp[NE] * 4;
    for (int i = 0; i < MOE_MAXU; ++i) {
        const int L = i * G + c; if (L >= nunits) break;
        const int blk = L >> 2; int e = 0;
        for (int j = 1; j < NE; ++j) if (blk >= nbp[j]) e = j;
        const int rb = blk - nbp[e];
        if (tid == 0) { ut[4 * i] = e; ut[4 * i + 1] = blk; ut[4 * i + 2] = L & 3; ut[4 * i + 3] = rb * 256; }
        if (gather && tid < 256) { const int rank = rb * 256 + tid; tbl[i * 256 + tid] = rank < cnt[e] ? (unsigned)ltok[(size_t)e * CAP + rank] * (unsigned)(D * 2) : 0u; }
    }
    __syncthreads();
}
namespace pg8 {
struct MoeSched {
    const LAS int* ut; const LAS unsigned* tbl; const LAS int* nbp; const char* A; const char* Bt; int G, c, K; bool gather;
    __device__ __forceinline__ bool next(int i, Unit& u) const {
        const int nunits = __builtin_amdgcn_readfirstlane(nbp[NE]) * 4;
        if (i >= MOE_MAXU || i * G + c >= nunits) return false;
        const int e = __builtin_amdgcn_readfirstlane(ut[4 * i]), blk = __builtin_amdgcn_readfirstlane(ut[4 * i + 1]), pn = __builtin_amdgcn_readfirstlane(ut[4 * i + 2]), r0 = __builtin_amdgcn_readfirstlane(ut[4 * i + 3]);
        u.pm = blk; u.pn = pn; u.aux = e; u.rank0 = r0;
        u.a = gather ? A : A + (size_t)blk * 256 * K * 2;
        u.b = Bt + ((size_t)e * 1024 + (size_t)pn * 256) * K * 2;
        return true;
    }
    __device__ __forceinline__ void a_voff(const Unit&, int ui, int tid, int K_, unsigned (&v)[2][2]) const {
#pragma unroll
        for (int i = 0; i < 2; ++i) { int R, C; stage_rc(tid * 16 + i * 8192, R, C);
            if (gather) { v[0][i] = tbl[ui * 256 + R] + (unsigned)C * 2u; v[1][i] = tbl[ui * 256 + HALF + R] + (unsigned)C * 2u; }
            else { v[0][i] = (unsigned)(R * K_ + C) * 2u; v[1][i] = (unsigned)((HALF + R) * K_ + C) * 2u; } }
    }
    __device__ __forceinline__ void a_ready(const Unit&) const {}
    __device__ __forceinline__ void done(const Unit&) const {}
};
struct EpiSwiglu {
    static constexpr bool PERM = true, AFTER_DRAIN = false;
    const float* lrs; const LAS int* cnt; bf16_t* hmid;
    __device__ __forceinline__ void operator()(const f32x4 (&acc)[2][2][4][2], const Unit& u, int wr, int wc, int fr, int fq) const {
        const int e = u.aux, n = __builtin_amdgcn_readfirstlane(cnt[e]); const int coff = wc * 32 + 8 * fq;
#pragma unroll
        for (int ai = 0; ai < 2; ++ai)
#pragma unroll
            for (int m = 0; m < 4; ++m) {
                const int ri = ai * HALF + wr * 64 + m * 16 + fr, rank = u.rank0 + ri; const float s = rank < n ? lrs[(size_t)e * CAP + rank] : 0.f;
                const f32x4 a0 = acc[ai][0][m][0] * s, a1 = acc[ai][0][m][1] * s, b0 = acc[ai][1][m][0] * s, b1 = acc[ai][1][m][1] * s;
                *(u32x4*)(hmid + (size_t)(u.pm * 256 + ri) * DFF + 128 * u.pn + coff) = pack8(a0 * sig4(a0) * b0, a1 * sig4(a1) * b1);
            }
    }
};
struct EpiDown {
    static constexpr bool PERM = true, AFTER_DRAIN = false;
    const float* lw; const LAS int* cnt; bf16_t* y;
    __device__ __forceinline__ void operator()(const f32x4 (&acc)[2][2][4][2], const Unit& u, int wr, int wc, int fr, int fq) const {
        const int e = u.aux, n = __builtin_amdgcn_readfirstlane(cnt[e]); const int col0 = u.pn * BM + wc * 32 + 8 * fq;
#pragma unroll
        for (int ai = 0; ai < 2; ++ai)
#pragma unroll
            for (int m = 0; m < 4; ++m) {
                const int ri = ai * HALF + wr * 64 + m * 16 + fr, rank = u.rank0 + ri; const float s = rank < n ? lw[(size_t)e * CAP + rank] : 0.f;
                bf16_t* yp = y + (size_t)(u.pm * 256 + ri) * D + col0;
                *(u32x4*)yp = pack8(acc[ai][0][m][0] * s, acc[ai][0][m][1] * s); *(u32x4*)(yp + HALF) = pack8(acc[ai][1][m][0] * s, acc[ai][1][m][1] * s);
            }
    }
};
}

__device__ __forceinline__ void final_phase(const Params& p, const float* H, const bf16_t* y, const int* toke, const int* tokr, LAS unsigned char* lds, const int wave_s) {
    const int tidx = opaque_tid(wave_s), lane = tidx & 63, gw = blockIdx.x * (NT / 64) + (tidx >> 6), NGW = gridDim.x * (NT / 64);
    const LAS int* nbp = (const LAS int*)(lds + MOE_NBP_OFF);
    for (int m = gw; m < T; m += NGW) {
        const int ea = toke[2 * m], eb = toke[2 * m + 1];
        const size_t sa = (size_t)nbp[ea] * 256 + tokr[2 * m], sb = (size_t)nbp[eb] * 256 + tokr[2 * m + 1];
        const f32x4* xr = (const f32x4*)(H + (size_t)m * D) + lane; const u32x2* ya = (const u32x2*)(y + sa * D) + lane; const u32x2* yb = (const u32x2*)(y + sb * D) + lane;
        f32x4 v[4]; float s = 0.f;
#pragma unroll
        for (int j = 0; j < 4; ++j) { const u32x2 a = ya[64 * j], b = yb[64 * j];
            v[j] = xr[64 * j] + (f32x4){bf_lo(a.x), bf_hi(a.x), bf_lo(a.y), bf_hi(a.y)} + (f32x4){bf_lo(b.x), bf_hi(b.x), bf_lo(b.y), bf_hi(b.y)};
            s += (v[j][0] * v[j][0] + v[j][1] * v[j][1]) + (v[j][2] * v[j][2] + v[j][3] * v[j][3]); }
        const float rstd = rsqrtf(wave_sum(s) * (1.f / D) + EPS);
        f32x4* o = (f32x4*)(p.out + (size_t)m * D) + lane;
#pragma unroll
        for (int j = 0; j < 4; ++j) o[64 * j] = v[j] * rstd * ((const f32x4*)p.g_final)[lane + 64 * j];
    }
}


__global__ void __launch_bounds__(NT, 2) k_all(Params p) {
    extern __shared__ __attribute__((aligned(16))) unsigned char lds_raw[];
    LAS unsigned char* lds = (LAS unsigned char*)lds_raw;
    volatile LAS unsigned* MISC = (volatile LAS unsigned*)(lds + MISC_OFF);
    const int wave_s = __builtin_amdgcn_readfirstlane((int)threadIdx.x >> 6);
    if (threadIdx.x < 32) MISC[threadIdx.x] = 0u;
    __syncthreads();
    unsigned char* ws = p.ws;
    unsigned* ctl = (unsigned*)(ws + WS_CTL);
    XcdBarrier bar = xcd_barrier_post(ctl + CW_BAR, MISC, wave_s == 0);
    const int G = gridDim.x;

    bf16_t* wt_in = (bf16_t*)(ws + WS_WT_IN); bf16_t* wt_co = (bf16_t*)(ws + WS_WT_CO); bf16_t* wt_ao = (bf16_t*)(ws + WS_WT_AO); bf16_t* wt_out = (bf16_t*)(ws + WS_WT_OUT);
    bf16_t* xb = (bf16_t*)(ws + WS_XB); bf16_t* merged = (bf16_t*)(ws + WS_MERGED); float* rstd1 = (float*)(ws + WS_RSTD1);
    bf16_t* vglu = (bf16_t*)(ws + WS_VGLU); bf16_t* qb = (bf16_t*)(ws + WS_QB); bf16_t* kvb = (bf16_t*)(ws + WS_KVB);
    bf16_t* sgc = (bf16_t*)(ws + WS_SGC); bf16_t* sga = (bf16_t*)(ws + WS_SGA); bf16_t* cact = (bf16_t*)(ws + WS_CACT); bf16_t* att = (bf16_t*)(ws + WS_ATT);
    float* H = p.out;

#ifndef ENABLE
#define ENABLE 0xff
#endif
    asm volatile("; PHASE_MARK 0");
    if (ENABLE & 1) { p0_prologue(p, lds, wave_s); p0_moe_weights(p, lds, wave_s); }
    xcd_barrier(bar);
    asm volatile("; PHASE_MARK 1");
    if (ENABLE & 2) { pg8::DenseSched S; S.init(xb, wt_in, T, INC, D, G, (int)blockIdx.x);
      pg8::EpiProj E{rstd1, vglu, qb, kvb, sgc, sga, 0.125f * LOG2E};
      pg8::gemm_phase<pg8::EpiProj, pg8::DenseSched, true, true>(lds, D, S, E, wave_s); }
    xcd_barrier(bar);
    asm volatile("; PHASE_MARK 2");
    if (ENABLE & 4) conv_phase(p, vglu, cact, lds, wave_s);
    asm volatile("; PHASE_MARK 3");
    if (ENABLE & 8) attn_phase(p, qb, kvb, att, lds, wave_s);
    xcd_barrier(bar);
    asm volatile("; PHASE_MARK 4");
    if (ENABLE & 16) { pg8::DenseSched S; S.init(cact, wt_co, T, D, CC, G, (int)blockIdx.x);
      pg8::EpiGate<false> E{sgc, merged};
      pg8::gemm_phase<pg8::EpiGate<false>, pg8::DenseSched, true, true>(lds, CC, S, E, wave_s); }
    asm volatile("; PHASE_MARK 5");
    if (ENABLE & 16) { pg8::DenseSched S; S.init(att, wt_ao, T, D, QD, G, (int)blockIdx.x);
      pg8::EpiGate<true> E{sga, merged};
      pg8::gemm_phase<pg8::EpiGate<true>, pg8::DenseSched, true, true>(lds, QD, S, E, wave_s); }
    xcd_barrier(bar);
    asm volatile("; PHASE_MARK 6");
    if (ENABLE & 32) { pg8::DenseSched S; S.init(merged, wt_out, T, D, D, G, (int)blockIdx.x);
      pg8::EpiResid E{p.x, H};
      pg8::gemm_phase<pg8::EpiResid, pg8::DenseSched, true, true>(lds, D, S, E, wave_s); }
    xcd_barrier(bar);
    bf16_t* hb = (bf16_t*)(ws + WS_HB); bf16_t* hmid = (bf16_t*)(ws + WS_HMID); bf16_t* y = (bf16_t*)(ws + WS_Y);
    int* toke = (int*)(ws + WS_TOKE); int* tokr = (int*)(ws + WS_TOKR); int* ltok = (int*)(ws + WS_LTOK); float* lrs = (float*)(ws + WS_LRS); float* lw = (float*)(ws + WS_LW);
    unsigned* gcount = ctl + CW_CNT;
    asm volatile("; PHASE_MARK 7");
    route_phase_fast(p, H, hb, toke, tokr, ltok, lrs, lw, gcount, lds, wave_s);
    xcd_barrier(bar);
    asm volatile("; PHASE_MARK 8");
    { const int tid = opaque_tid(wave_s);
      moe_build_map(gcount, lds, tid); moe_build_units(ltok, lds, G, (int)blockIdx.x, tid, true);
      pg8::MoeSched S{(const LAS int*)(lds + MOE_UT_OFF), (const LAS unsigned*)(lds + MOE_TBL_OFF), (const LAS int*)(lds + MOE_NBP_OFF), (const char*)hb, (const char*)(ws + WS_WT_GU), G, (int)blockIdx.x, D, true};
      pg8::EpiSwiglu E{lrs, (const LAS int*)(lds + MOE_CNT_OFF), hmid};
      pg8::gemm_phase<pg8::EpiSwiglu, pg8::MoeSched, true, true>(lds, D, S, E, wave_s); }
    xcd_barrier(bar);
    asm volatile("; PHASE_MARK 9");
    { const int tid = opaque_tid(wave_s);
      moe_build_map(gcount, lds, tid); moe_build_units(ltok, lds, G, (int)blockIdx.x, tid, false);
      pg8::MoeSched S{(const LAS int*)(lds + MOE_UT_OFF), (const LAS unsigned*)(lds + MOE_TBL_OFF), (const LAS int*)(lds + MOE_NBP_OFF), (const char*)hmid, (const char*)(ws + WS_WT_D), G, (int)blockIdx.x, DFF, false};
      pg8::EpiDown E{lw, (const LAS int*)(lds + MOE_CNT_OFF), y};
      pg8::gemm_phase<pg8::EpiDown, pg8::MoeSched, true, true>(lds, DFF, S, E, wave_s); }
    xcd_barrier(bar);
    asm volatile("; PHASE_MARK 10");
    { const int tid = opaque_tid(wave_s); moe_build_map(gcount, lds, tid); }
    final_phase(p, H, y, toke, tokr, lds, wave_s);
}

extern "C" void kernel_launch(void* const* d_in, const int* in_sizes, int n_in, void* d_out, int out_size, void* d_ws, size_t ws_size, hipStream_t stream) {
    static int grid = 0;
    if (grid == 0) {
        if (n_in != 20 || in_sizes[0] != T * D || out_size != T * D || ws_size < WS_END) {
            fprintf(stderr, "kernel_launch: unexpected shapes (n_in %d, in0 %d, out %d, ws %zu); nothing launched\n", n_in, n_in > 0 ? in_sizes[0] : -1, out_size, ws_size); grid = -1; return; }
        int dev = 0, cus = 0, per_cu = 0;
        if (hipGetDevice(&dev) != hipSuccess || hipDeviceGetAttribute(&cus, hipDeviceAttributeMultiprocessorCount, dev) != hipSuccess) { grid = -1; return; }
        if (hipFuncSetAttribute((const void*)k_all, hipFuncAttributeMaxDynamicSharedMemorySize, LDS_BYTES) != hipSuccess) { fprintf(stderr, "kernel_launch: hipFuncSetAttribute failed\n"); grid = -1; return; }
        if (hipOccupancyMaxActiveBlocksPerMultiprocessor(&per_cu, (const void*)k_all, NT, LDS_BYTES) != hipSuccess || per_cu < 1)
            fprintf(stderr, "kernel_launch: note: occupancy query reports %d workgroups per CU\n", per_cu);
        (void)hipGetLastError();
        grid = cus;
    }
    if (grid < 0) return;
    if (hipMemsetAsync((char*)d_ws + WS_CTL, 0, CTL_BYTES, stream) != hipSuccess) return;
    Params p{};
    const float** pp = (const float**)&p;
    for (int i = 0; i < 20; ++i) pp[i] = (const float*)d_in[i];
    p.out = (float*)d_out; p.ws = (unsigned char*)d_ws;
    hipLaunchKernelGGL(k_all, dim3(grid), dim3(NT), LDS_BYTES, stream, p);
}
```

```cpp
#include <hip/hip_runtime.h>
#include <cstdio>
#include <cstdint>

constexpr int T = 32768, D = 1024, SEQ = 4096;
constexpr int CC = 512, CW = 31, NH = 8, HD = 64, QD = 512, KVD = 128, INC = 3840;
constexpr int NE = 32, NG = 4, EPG = 8, DFF = 512;
constexpr float EPS = 1e-6f;
constexpr int NT = 512;
constexpr float LOG2E = 1.4426950408889634f;

#define GAS __attribute__((address_space(1)))
#define LAS __attribute__((address_space(3)))
typedef unsigned short bf16_t;
typedef short bf16x8 __attribute__((ext_vector_type(8)));
typedef float f32x4 __attribute__((ext_vector_type(4)));
typedef float f32x16 __attribute__((ext_vector_type(16)));
typedef unsigned u32x4 __attribute__((ext_vector_type(4)));
typedef unsigned u32x2 __attribute__((ext_vector_type(2)));

__device__ __forceinline__ int opaque_tid(int wave_s) { int t = wave_s * 64 + (int)__builtin_amdgcn_mbcnt_hi(~0u, __builtin_amdgcn_mbcnt_lo(~0u, 0u)); asm volatile("" : "+v"(t)); return t; }
__device__ __forceinline__ int opaque_i(int v) { asm volatile("" : "+v"(v)); return v; }
__device__ __forceinline__ float wave_sum(float v) {
#pragma unroll
    for (int o = 1; o < 64; o <<= 1) v += __shfl_xor(v, o);
    return v;
}
__device__ __forceinline__ float sigmoidf_(float v) { return 1.f / (1.f + __expf(-v)); }
__device__ __forceinline__ float fsig(float v) { return __builtin_amdgcn_rcpf(1.f + __builtin_amdgcn_exp2f(-LOG2E * v)); }
__device__ __forceinline__ unsigned cvt_pk_bf16(float lo, float hi) { unsigned r; asm volatile("v_cvt_pk_bf16_f32 %0, %1, %2" : "=v"(r) : "v"(lo), "v"(hi)); return r; }
__device__ __forceinline__ float bf_lo(unsigned w) { return __uint_as_float(w << 16); }
__device__ __forceinline__ float bf_hi(unsigned w) { return __uint_as_float(w & 0xffff0000u); }

namespace pg8 {
#define PG8_LAS __attribute__((address_space(3)))
constexpr int BM = 256, BK = 64, HALF = 128, HTB = HALF * BK * 2  , STAGE_BYTES = 8 * HTB, NXCD = 8, WGM = 8;

__host__ __device__ __forceinline__ int lds_byte(int r, int c) { const int st = (r >> 4) * 2 + (c >> 5), rr = r & 15, cc = c & 31, ob = rr * 64 + cc * 2; return st * 1024 + (ob ^ (((ob >> 9) & 1) << 5)); }
__host__ __device__ __forceinline__ void stage_rc(int b, int& R, int& C) { const int st = b / 1024, sb = b % 1024, swz = sb ^ (((sb >> 9) & 1) << 5); R = (st >> 1) * 16 + swz / 64; C = (st & 1) * 32 + (swz % 64) / 2; }
__host__ __device__ __forceinline__ int perm32(int rho) { const int n = rho >> 4, i = rho & 15; return 8 * (i >> 2) + 4 * n + (i & 3); }

struct Unit { int pm, pn; const char* a; const char* b; int aux, rank0; };

struct StaticOrder {
    int nM, nN, nwg, G, c;
    __host__ __device__ void init(int M, int N, int G_, int c_) { nM = M / BM; nN = N / BM; nwg = nM * nN; G = G_; c = c_; }
    __host__ __device__ bool next_mn(int i, int& pm, int& pn) const {
        const long L = (long)i * G + c; if (L >= nwg) return false;
        int wgid = (int)L; { const int q = nwg / NXCD, r = nwg % NXCD, xcd = wgid % NXCD, off = wgid / NXCD; wgid = (xcd < r ? xcd * (q + 1) : r * (q + 1) + (xcd - r) * q) + off; }
        const int nig = WGM * nN, gid = wgid / nig, fm = gid * WGM, gsz = (nM - fm) < WGM ? (nM - fm) : WGM;
        pm = fm + ((wgid % nig) % gsz); pn = (wgid % nig) / gsz; return true;
    }
};
struct DenseSched {
    StaticOrder so; const char* A; const char* Bt; size_t tstep;
    __device__ __forceinline__ void init(const bf16_t* A_, const bf16_t* Bt_, int M, int N, int K, int G, int c) { so.init(M, N, G, c); A = (const char*)A_; Bt = (const char*)Bt_; tstep = (size_t)BM * K * 2; }
    __device__ __forceinline__ bool next(int i, Unit& u) const { if (!so.next_mn(i, u.pm, u.pn)) return false; u.a = A + (size_t)u.pm * tstep; u.b = Bt + (size_t)u.pn * tstep; u.aux = 0; u.rank0 = 0; return true; }
    __device__ __forceinline__ void a_voff(const Unit&, int, int tid, int K, unsigned (&v)[2][2]) const {
#pragma unroll
        for (int i = 0; i < 2; ++i) { int R, C; stage_rc(tid * 16 + i * 8192, R, C); v[0][i] = (unsigned)(R * K + C) * 2u; v[1][i] = (unsigned)((HALF + R) * K + C) * 2u; } }
    __device__ __forceinline__ void a_ready(const Unit&) const {}
    __device__ __forceinline__ void done(const Unit&) const {}
};

template <class Epi, class Sched, bool ALIGN_EPI = false, bool SP2 = false>
__device__ __forceinline__ void gemm_phase(PG8_LAS unsigned char* lds, const int K_, const Sched& S, const Epi& E, const int wave_s) {
    const int tid_ = opaque_tid(wave_s); const int tid = tid_, wid = __builtin_amdgcn_readfirstlane(tid >> 6), lane = tid & 63, wr = wid >> 2, wc = wid & 3, fr = lane & 15, fq = lane >> 4;
    const int K = K_, nt = K / BK;
    unsigned voffB[2]; unsigned vC[2][2], vN[2][2];
#pragma unroll
    for (int i = 0; i < 2; ++i) { int R, C; stage_rc(tid * 16 + i * 8192, R, C); const int Rb = Epi::PERM ? ((R & ~31) + perm32(R & 31)) : R;
        voffB[i] = (unsigned)(Rb * K + C) * 2u; }
    const size_t kstep = (size_t)(BK * 2);
    const size_t hstep = (size_t)HALF * K * 2;
    const unsigned ldsw = (unsigned)wid * 1024u;
    const int aoff = lds_byte(wr * 64 + fr, fq * 8), boff = lds_byte(wc * 32 + fr, fq * 8);
#define PG8_SA(b, h) (((b) * 2 + (h)) * HTB)
#define PG8_SB(b, h) ((4 + (b) * 2 + (h)) * HTB)
#define PG8_STAGE(bufoff, gbase, voff) do { _Pragma("unroll") for (int _i = 0; _i < 2; ++_i) \
        __builtin_amdgcn_global_load_lds((const unsigned*)((const char*)(gbase) + (voff)[_i]), (PG8_LAS unsigned*)(lds + (bufoff) + ldsw + _i * 8192), 16, 0, 0); } while (0)
#define PG8_LDA(dst, b, h) do { _Pragma("unroll") for (int m = 0; m < 4; ++m) _Pragma("unroll") for (int k = 0; k < 2; ++k) dst[m][k] = *(const PG8_LAS bf16x8*)(lds + PG8_SA(b, h) + aoff + m * 2048 + k * 1024); } while (0)
#define PG8_LDB(dst, b, h) do { _Pragma("unroll") for (int n = 0; n < 2; ++n) _Pragma("unroll") for (int k = 0; k < 2; ++k) dst[n][k] = *(const PG8_LAS bf16x8*)(lds + PG8_SB(b, h) + boff + n * 2048 + k * 1024); } while (0)
#define PG8_MMA(ai, bj, At, Bt) do { __builtin_amdgcn_s_setprio(1); _Pragma("unroll") for (int m = 0; m < 4; ++m) _Pragma("unroll") for (int n = 0; n < 2; ++n) _Pragma("unroll") for (int k = 0; k < 2; ++k) \
        acc[ai][bj][m][n] = __builtin_amdgcn_mfma_f32_16x16x32_bf16(Bt[n][k], At[m][k], acc[ai][bj][m][n], 0, 0, 0); __builtin_amdgcn_s_setprio(0); } while (0)
#define PG8_WAIT_V(n) asm volatile("s_waitcnt vmcnt(" #n ")" ::: "memory")
#define PG8_WAIT_L(n) asm volatile("s_waitcnt lgkmcnt(" #n ")" ::: "memory")
#define PG8_BAR __builtin_amdgcn_s_barrier()
#define PG8_SCHED __builtin_amdgcn_sched_barrier(0)
    Unit cur, nxt; int ui = 0;
    if (!S.next(0, cur)) return;
    S.a_voff(cur, 0, tid, K, vC);
    f32x4 acc[2][2][4][2];
#pragma unroll
    for (int a = 0; a < 2; ++a)
#pragma unroll
        for (int b = 0; b < 2; ++b)
#pragma unroll
            for (int m = 0; m < 4; ++m)
#pragma unroll
                for (int n = 0; n < 2; ++n) acc[a][b][m][n] = (f32x4){0.f, 0.f, 0.f, 0.f};
    bf16x8 At[4][2], B0[2][2], B1[2][2];
    const char* cA = cur.a; const char* cB = cur.b;
    S.a_ready(cur);
    if constexpr (SP2) {
        PG8_STAGE(PG8_SB(0, 0), cB, voffB); PG8_STAGE(PG8_SB(0, 1), cB + hstep, voffB); PG8_STAGE(PG8_SA(0, 0), cA, vC[0]); PG8_STAGE(PG8_SA(0, 1), cA, vC[1]);
        if (wr == 1) PG8_BAR;
        PG8_WAIT_V(2); PG8_BAR;
        PG8_STAGE(PG8_SB(1, 0), cB + kstep, voffB); PG8_STAGE(PG8_SA(1, 0), cA + kstep, vC[0]); PG8_STAGE(PG8_SB(1, 1), cB + hstep + kstep, voffB);
        PG8_WAIT_V(6); PG8_BAR;
    } else {
        PG8_STAGE(PG8_SB(0, 0), cB, voffB); PG8_STAGE(PG8_SA(0, 0), cA, vC[0]); PG8_STAGE(PG8_SB(0, 1), cB + hstep, voffB); PG8_STAGE(PG8_SA(0, 1), cA, vC[1]);
        if (wr == 1) PG8_BAR;
        PG8_WAIT_V(4); PG8_BAR;
        PG8_STAGE(PG8_SB(1, 0), cB + kstep, voffB); PG8_STAGE(PG8_SA(1, 0), cA + kstep, vC[0]); PG8_STAGE(PG8_SB(1, 1), cB + hstep + kstep, voffB);
        PG8_WAIT_V(6); PG8_BAR;
    }
    for (;;) {
        const bool has_next = S.next(ui + 1, nxt);
        if (has_next) S.a_voff(nxt, ui + 1, tid, K, vN); else { vN[0][0] = vC[0][0]; vN[0][1] = vC[0][1]; vN[1][0] = vC[1][0]; vN[1][1] = vC[1][1]; }
        const char* nA = has_next ? nxt.a : cA; const char* nB = has_next ? nxt.b : cB;
        for (int t = 0; t < nt; t += 2) {
            const bool last = (t == nt - 2);
            unsigned v2[2][2]; v2[0][0] = last ? vN[0][0] : vC[0][0]; v2[0][1] = last ? vN[0][1] : vC[0][1]; v2[1][0] = last ? vN[1][0] : vC[1][0]; v2[1][1] = last ? vN[1][1] : vC[1][1];
            const char* a1 = cA + (size_t)(t + 1) * kstep;
            const char* a2 = last ? nA : cA + (size_t)(t + 2) * kstep; const char* b2 = last ? nB : cB + (size_t)(t + 2) * kstep;
            const char* a3 = a2 + kstep; const char* b3 = b2 + kstep;
            if (last && has_next) S.a_ready(nxt);
            if constexpr (SP2) {
            PG8_LDB(B0, 0, 0); PG8_LDB(B1, 0, 1); PG8_SCHED; PG8_LDA(At, 0, 0); PG8_STAGE(PG8_SA(1, 1), a1, vC[1]);
            PG8_WAIT_V(8); PG8_WAIT_L(0); PG8_BAR; PG8_MMA(0, 0, At, B0); PG8_MMA(0, 1, At, B1); PG8_BAR; PG8_SCHED;
            PG8_LDA(At, 0, 1); PG8_STAGE(PG8_SB(0, 0), b2, voffB); PG8_STAGE(PG8_SB(0, 1), b2 + hstep, voffB); PG8_STAGE(PG8_SA(0, 0), a2, v2[0]);
            PG8_WAIT_V(8); PG8_WAIT_L(0); PG8_BAR; PG8_MMA(1, 0, At, B0); PG8_MMA(1, 1, At, B1); PG8_BAR; PG8_SCHED;
            PG8_LDB(B0, 1, 0); PG8_LDB(B1, 1, 1); PG8_SCHED; PG8_LDA(At, 1, 0); PG8_STAGE(PG8_SA(0, 1), a2, v2[1]);
            PG8_WAIT_V(8); PG8_WAIT_L(0); PG8_BAR; PG8_MMA(0, 0, At, B0); PG8_MMA(0, 1, At, B1); PG8_BAR; PG8_SCHED;
            PG8_LDA(At, 1, 1); PG8_STAGE(PG8_SB(1, 0), b3, voffB); PG8_STAGE(PG8_SB(1, 1), b3 + hstep, voffB); PG8_STAGE(PG8_SA(1, 0), a3, v2[0]);
            PG8_WAIT_V(8); PG8_WAIT_L(0); PG8_BAR; PG8_MMA(1, 0, At, B0); PG8_MMA(1, 1, At, B1); PG8_BAR; PG8_SCHED;
            } else {
            PG8_LDB(B0, 0, 0); PG8_SCHED; PG8_LDA(At, 0, 0); PG8_STAGE(PG8_SA(1, 1), a1, vC[1]);
            PG8_WAIT_L(8); PG8_BAR; PG8_WAIT_L(0); PG8_MMA(0, 0, At, B0); PG8_BAR; PG8_SCHED;
            PG8_LDB(B1, 0, 1); PG8_STAGE(PG8_SB(0, 0), b2, voffB);
            PG8_BAR; PG8_WAIT_L(0); PG8_MMA(0, 1, At, B1); PG8_BAR;
            PG8_LDA(At, 0, 1); PG8_STAGE(PG8_SA(0, 0), a2, v2[0]);
            PG8_BAR; PG8_WAIT_L(0); PG8_MMA(1, 0, At, B0); PG8_BAR; PG8_SCHED;
            PG8_STAGE(PG8_SB(0, 1), b2 + hstep, voffB);
            PG8_WAIT_V(6); PG8_BAR; PG8_MMA(1, 1, At, B1); PG8_BAR;
            PG8_LDB(B0, 1, 0); PG8_SCHED; PG8_LDA(At, 1, 0); PG8_STAGE(PG8_SA(0, 1), a2, v2[1]);
            PG8_WAIT_L(8); PG8_BAR; PG8_WAIT_L(0); PG8_MMA(0, 0, At, B0); PG8_BAR; PG8_SCHED;
            PG8_LDB(B1, 1, 1); PG8_STAGE(PG8_SB(1, 0), b3, voffB);
            PG8_BAR; PG8_WAIT_L(0); PG8_MMA(0, 1, At, B1); PG8_BAR;
            PG8_LDA(At, 1, 1); PG8_STAGE(PG8_SA(1, 0), a3, v2[0]);
            PG8_BAR; PG8_WAIT_L(0); PG8_MMA(1, 0, At, B0); PG8_BAR; PG8_SCHED;
            PG8_STAGE(PG8_SB(1, 1), b3 + hstep, voffB);
            PG8_WAIT_V(6); PG8_BAR; PG8_MMA(1, 1, At, B1); PG8_BAR;
            }
        }
        if constexpr (ALIGN_EPI) { if (wr == 0) PG8_BAR; }
        if constexpr (!Epi::AFTER_DRAIN) { E(acc, cur, wr, wc, fr, fq); S.done(cur); }
        if (!has_next) break;
#pragma unroll
        for (int a = 0; a < 2; ++a)
#pragma unroll
            for (int b = 0; b < 2; ++b)
#pragma unroll
                for (int m = 0; m < 4; ++m)
#pragma unroll
                    for (int n = 0; n < 2; ++n) acc[a][b][m][n] = (f32x4){0.f, 0.f, 0.f, 0.f};
        cur = nxt; cA = nA; cB = nB; ++ui; vC[0][0] = vN[0][0]; vC[0][1] = vN[0][1]; vC[1][0] = vN[1][0]; vC[1][1] = vN[1][1];
        if constexpr (ALIGN_EPI) { if (wr == 1) PG8_BAR; }
    }
    PG8_WAIT_V(0);
    if constexpr (!ALIGN_EPI) { if (wr == 0) PG8_BAR; }
    PG8_BAR;
    if constexpr (Epi::AFTER_DRAIN) { E.fused(acc, cur, wr, wc, fr, fq, lds, wid, lane); S.done(cur); }
#undef PG8_SA
#undef PG8_SB
#undef PG8_STAGE
#undef PG8_LDA
#undef PG8_LDB
#undef PG8_MMA
#undef PG8_WAIT_V
#undef PG8_WAIT_L
#undef PG8_BAR
#undef PG8_SCHED
}

__device__ __forceinline__ u32x4 pack8(const f32x4 v0, const f32x4 v1) { u32x4 w; w.x = cvt_pk_bf16(v0[0], v0[1]); w.y = cvt_pk_bf16(v0[2], v0[3]); w.z = cvt_pk_bf16(v1[0], v1[1]); w.w = cvt_pk_bf16(v1[2], v1[3]); return w; }
__device__ __forceinline__ f32x4 sig4(const f32x4 v) { return (f32x4){fsig(v[0]), fsig(v[1]), fsig(v[2]), fsig(v[3])}; }

struct EpiProj {
    static constexpr bool PERM = true, AFTER_DRAIN = false;
    const float* rstd; bf16_t *vglu, *qb, *kvb, *sgc, *sga; float qscale;
    __device__ __forceinline__ void operator()(const f32x4 (&acc)[2][2][4][2], const Unit& u, int wr, int wc, int fr, int fq) const {
        const int pn = __builtin_amdgcn_readfirstlane(u.pn); const int coff = wc * 32 + 8 * fq; const int row0 = u.pm * BM + wr * 64 + fr;
#pragma unroll
        for (int ai = 0; ai < 2; ++ai)
#pragma unroll
            for (int m = 0; m < 4; ++m) {
                const int r = row0 + ai * HALF + m * 16; const float s = rstd[r];
                const f32x4 a0 = acc[ai][0][m][0] * s, a1 = acc[ai][0][m][1] * s, b0 = acc[ai][1][m][0] * s, b1 = acc[ai][1][m][1] * s;
                if (pn < 4) {
                    *(u32x4*)(vglu + (size_t)r * CC + 128 * pn + coff) = pack8(a0 * sig4(b0), a1 * sig4(b1));
                } else if (pn < 6) {
                    bf16_t* qp = qb + (size_t)r * QD + 256 * (pn - 4) + coff;
                    *(u32x4*)qp = pack8(a0 * qscale, a1 * qscale); *(u32x4*)(qp + HALF) = pack8(b0 * qscale, b1 * qscale);
                } else if (pn == 6) {
                    bf16_t* kp = kvb + (size_t)r * 256 + coff;
                    *(u32x4*)kp = pack8(a0, a1); *(u32x4*)(kp + HALF) = pack8(b0, b1);
                } else {
                    const size_t o = (size_t)r * D + 128 * (pn - 7) + coff;
                    *(u32x4*)(sgc + o) = pack8(sig4(a0), sig4(a1)); *(u32x4*)(sga + o) = pack8(sig4(b0), sig4(b1));
                }
            }
    }
};
template <bool ADD> struct EpiGate {
    static constexpr bool PERM = true, AFTER_DRAIN = false;
    const bf16_t* G; bf16_t* O;
    __device__ __forceinline__ void operator()(const f32x4 (&acc)[2][2][4][2], const Unit& u, int wr, int wc, int fr, int fq) const {
        const int row0 = u.pm * BM + wr * 64 + fr, col0 = u.pn * BM + wc * 32 + 8 * fq;
#pragma unroll
        for (int ai = 0; ai < 2; ++ai)
#pragma unroll
            for (int m = 0; m < 4; ++m) {
                const size_t o = (size_t)(row0 + ai * HALF + m * 16) * D + col0;
#pragma unroll
                for (int bj = 0; bj < 2; ++bj) {
                    const u32x4 g = *(const u32x4*)(G + o + bj * HALF);
                    f32x4 v0 = acc[ai][bj][m][0] * (f32x4){bf_lo(g.x), bf_hi(g.x), bf_lo(g.y), bf_hi(g.y)};
                    f32x4 v1 = acc[ai][bj][m][1] * (f32x4){bf_lo(g.z), bf_hi(g.z), bf_lo(g.w), bf_hi(g.w)};
                    if (ADD) { const u32x4 p = *(const u32x4*)(O + o + bj * HALF);
                        v0 += (f32x4){bf_lo(p.x), bf_hi(p.x), bf_lo(p.y), bf_hi(p.y)}; v1 += (f32x4){bf_lo(p.z), bf_hi(p.z), bf_lo(p.w), bf_hi(p.w)}; }
                    *(u32x4*)(O + o + bj * HALF) = pack8(v0, v1);
                }
                if (m & 1) asm volatile("" ::: "memory");
            }
    }
};
struct EpiResid {
    static constexpr bool PERM = false, AFTER_DRAIN = false;
    const float* X; float* H;
    __device__ __forceinline__ void operator()(const f32x4 (&acc)[2][2][4][2], const Unit& u, int wr, int wc, int fr, int fq) const {
        const int row0 = u.pm * BM + wr * 64 + fr, col0 = u.pn * BM + wc * 32 + 4 * fq;
#pragma unroll
        for (int ai = 0; ai < 2; ++ai)
#pragma unroll
            for (int m = 0; m < 4; ++m) {
                const size_t o = (size_t)(row0 + ai * HALF + m * 16) * D + col0;
#pragma unroll
                for (int bj = 0; bj < 2; ++bj)
#pragma unroll
                    for (int n = 0; n < 2; ++n) *(f32x4*)(H + o + bj * HALF + n * 16) = *(const f32x4*)(X + o + bj * HALF + n * 16) + acc[ai][bj][m][n];
                if (m & 1) asm volatile("" ::: "memory");
            }
    }
};
}


constexpr size_t MiB = 1u << 20;
constexpr size_t WS_CTL = 0, CTL_BYTES = 1 * MiB;
constexpr size_t WS_WT_IN = 2 * MiB;
constexpr size_t WS_WT_CO = 10 * MiB, WS_WT_AO = 11 * MiB;
constexpr size_t WS_WT_OUT = 12 * MiB;
constexpr size_t WS_WT_GU = 16 * MiB;
constexpr size_t WS_WT_D = 80 * MiB;
constexpr size_t WS_RSTD1 = 112 * MiB;
constexpr size_t WS_TOKE = 113 * MiB;
constexpr size_t WS_TOKR = 113 * MiB + 512 * 1024;
constexpr size_t WS_LTOK = 114 * MiB, WS_LRS = 118 * MiB, WS_LW = 122 * MiB;
constexpr size_t WS_XB = 128 * MiB;
constexpr size_t WS_MERGED = WS_XB;
constexpr size_t WS_VGLU = 192 * MiB;
constexpr size_t WS_QB = 224 * MiB;
constexpr size_t WS_HB = 192 * MiB;
constexpr size_t WS_KVB = 256 * MiB;
constexpr size_t WS_SGC = 272 * MiB, WS_SGA = 336 * MiB;
constexpr size_t WS_Y = 256 * MiB;
constexpr size_t WS_CACT = 400 * MiB, WS_ATT = 432 * MiB;
constexpr size_t WS_HMID = 400 * MiB;
constexpr size_t WS_END = 472 * MiB;
constexpr int CAP = 32768;
constexpr int NSLOT = 2 * T + NE * 256;
static_assert(WS_Y + (size_t)NSLOT * D * 2 <= WS_CACT && WS_HMID + (size_t)NSLOT * DFF * 2 <= WS_END, "d_ws map");
constexpr int CW_BAR = 4096, CW_CNT = 16384;
constexpr int RING_BYTES = 131072, LDS_BYTES = 147456, MISC_OFF = LDS_BYTES - 128;
constexpr int MOE_TBL_OFF = RING_BYTES, MOE_MAXU = 8;
constexpr int MOE_UT_OFF = MOE_TBL_OFF + MOE_MAXU * 1024, MOE_NBP_OFF = MOE_UT_OFF + MOE_MAXU * 16, MOE_CNT_OFF = MOE_NBP_OFF + 160;
static_assert(MOE_CNT_OFF + 128 <= MISC_OFF, "LDS map");

#define XB_TMO      128
#define XB_XCNT(j)  (256  + 64 * (j))
#define XB_XSUB(j)  (1280 + 64 * (j))
#define XB_XGEN(j)  (2304 + 64 * (j))
#define XB_TOP      3328
#define XB_TOPGEN   3392
#define XCD_BAR_WORDS 3456
#define XB_SPIN_CAP (1u << 18)

__device__ __forceinline__ unsigned xb_ld(unsigned* p)              { return __hip_atomic_load(p, __ATOMIC_RELAXED, __HIP_MEMORY_SCOPE_AGENT); }
__device__ __forceinline__ unsigned xb_add(unsigned* p, unsigned v) { return __hip_atomic_fetch_add(p, v, __ATOMIC_RELAXED, __HIP_MEMORY_SCOPE_AGENT); }
__device__ __forceinline__ unsigned xb_xcc_id() { return (unsigned)__builtin_amdgcn_s_getreg((3 << 11) | 20) & 0xFu; }
#define XB_SPIN(cond, bar) do { unsigned _sp = 0; while (cond) { __builtin_amdgcn_s_sleep(1); \
    if ((++_sp & 255u) == 0u) { if (xb_ld(&(bar)[XB_TMO])) break; if (_sp > XB_SPIN_CAP) { atomicAdd(&(bar)[XB_TMO], 1u); break; } } } } while (0)

struct XcdBarrier { unsigned* bar; unsigned x; volatile LAS unsigned* st; bool leader; };

__device__ __forceinline__ XcdBarrier xcd_barrier_post(unsigned* bar, volatile LAS unsigned* st, bool wave0) {
    XcdBarrier b; b.bar = bar; b.x = xb_xcc_id(); b.st = st; b.leader = wave0;
    if (wave0 && __builtin_amdgcn_mbcnt_hi(~0u, __builtin_amdgcn_mbcnt_lo(~0u, 0u)) == 0u) (void)xb_add(&bar[XB_XCNT(b.x)], 1u);
    return b;
}
__device__ __forceinline__ void xcd_barrier_complete(unsigned* bar, unsigned x, unsigned& nloc, unsigned& nx) {
    const unsigned G = gridDim.x * gridDim.y * gridDim.z;
    unsigned sum, cnt, mine, sp = 0u;
    for (;;) {
        sum = 0u; cnt = 0u; mine = 0u;
#pragma unroll
        for (unsigned j = 0; j < 16; ++j) { const unsigned c = xb_ld(&bar[XB_XCNT(j)]); sum += c; cnt += (c > 0u) ? 1u : 0u; mine = (j == x) ? c : mine; }
        if (sum == G) break;
        __builtin_amdgcn_s_sleep(1);
        if ((++sp & 255u) == 0u) { if (xb_ld(&bar[XB_TMO])) break; if (sp > XB_SPIN_CAP) { atomicAdd(&bar[XB_TMO], 1u); break; } }
    }
    nloc = mine > 0u ? mine : 1u; nx = cnt > 0u ? cnt : 1u;
}
__device__ __forceinline__ void xcd_barrier(const XcdBarrier& b) {
    asm volatile("s_waitcnt vmcnt(0)" ::: "memory");
    __syncthreads();
    if (b.leader && __builtin_amdgcn_mbcnt_hi(~0u, __builtin_amdgcn_mbcnt_lo(~0u, 0u)) == 0u) {
        unsigned* bar = b.bar;
        __builtin_amdgcn_s_waitcnt(0);
        unsigned nloc = b.st[0], nx = b.st[1];
        if (nloc == 0u) { xcd_barrier_complete(bar, b.x, nloc, nx); b.st[0] = nloc; b.st[1] = nx; }
        const unsigned old = xb_add(&bar[XB_XSUB(b.x)], 1u);
        const unsigned gen = old / nloc;
        if (old + 1u == (gen + 1u) * nloc) {
            __builtin_amdgcn_fence(__ATOMIC_RELEASE, "agent");
            asm volatile("s_waitcnt vmcnt(0)" ::: "memory");
            const unsigned og = xb_add(&bar[XB_TOP], 1u);
            const unsigned tg = og / nx;
            if (og + 1u == (tg + 1u) * nx) xb_add(&bar[XB_TOPGEN], 1u);
            else XB_SPIN(xb_ld(&bar[XB_TOPGEN]) == tg, bar);
            __builtin_amdgcn_fence(__ATOMIC_ACQUIRE, "agent");
            xb_add(&bar[XB_XGEN(b.x)], 1u);
            asm volatile("s_waitcnt vmcnt(0)" ::: "memory");
        } else {
            XB_SPIN(xb_ld(&bar[XB_XGEN(b.x)]) == gen, bar);
            __builtin_amdgcn_fence(__ATOMIC_ACQUIRE, "agent");
            asm volatile("s_waitcnt vmcnt(0)" ::: "memory");
        }
    }
    __syncthreads();
}

struct Params {
    const float *x, *g_mix, *w_in, *w_dw, *b_dw, *ln_g, *ln_b, *sinks, *w_conv_out, *w_attn_out, *w_out, *g_ffn,
                *w_group, *b_group, *w_expert, *b_expert, *w_gate, *w_up, *w_down, *g_final;
    float* out; unsigned char* ws;
};

__device__ __forceinline__ void p0_transpose_item(const float* W, int ld, int srccol, int k0, const float* gain, bf16_t* WT, int K, int dstrow, LAS float* scr, int lane) {
    const int ksub = lane >> 3, n4 = (lane & 7) * 4;
    f32x4 v[8];
#pragma unroll
    for (int i = 0; i < 8; ++i) v[i] = *(const f32x4*)(W + (size_t)(k0 + 8 * i + ksub) * ld + srccol + n4);
    if (gain) {
#pragma unroll
        for (int i = 0; i < 8; ++i) v[i] *= gain[k0 + 8 * i + ksub]; }
#pragma unroll
    for (int i = 0; i < 8; ++i) { LAS float* d = scr + (8 * i + ksub) * 33 + n4; d[0] = v[i][0]; d[1] = v[i][1]; d[2] = v[i][2]; d[3] = v[i][3]; }
    asm volatile("s_waitcnt lgkmcnt(0)" ::: "memory");
    const int c = lane & 7;
#pragma unroll
    for (int j = 0; j < 4; ++j) { const int n = (lane >> 3) + 8 * j; const LAS float* s = scr + (8 * c) * 33 + n;
        u32x4 o; o.x = cvt_pk_bf16(s[0 * 33], s[1 * 33]); o.y = cvt_pk_bf16(s[2 * 33], s[3 * 33]); o.z = cvt_pk_bf16(s[4 * 33], s[5 * 33]); o.w = cvt_pk_bf16(s[6 * 33], s[7 * 33]);
        *(u32x4*)(WT + (size_t)(dstrow + n) * K + k0 + 8 * c) = o; }
    asm volatile("s_waitcnt lgkmcnt(0)" ::: "memory");
}
__device__ __forceinline__ int win_srccol(int np) {
    const int pn = np >> 8, bj = (np >> 7) & 1, o = np & 127;
    if (pn < 4) return (bj ? 512 : 0) + 128 * pn + o;
    if (pn < 6) return 1024 + 256 * (pn - 4) + 128 * bj + o;
    if (pn == 6) return (bj ? 1664 : 1536) + o;
    return (bj ? 2816 : 1792) + 128 * (pn - 7) + o;
}
__device__ __forceinline__ void p0_prologue(const Params& p, LAS unsigned char* lds, const int wave_s) {
    unsigned char* ws = p.ws;
    const int tidx = opaque_tid(wave_s), lane = tidx & 63, wave = tidx >> 6;
    LAS float* scr = (LAS float*)(lds + wave * 16384);
    const int gw = blockIdx.x * (NT / 64) + wave, NGW = gridDim.x * (NT / 64);
    bf16_t* wt_in = (bf16_t*)(ws + WS_WT_IN); bf16_t* wt_co = (bf16_t*)(ws + WS_WT_CO); bf16_t* wt_ao = (bf16_t*)(ws + WS_WT_AO); bf16_t* wt_out = (bf16_t*)(ws + WS_WT_OUT);
    constexpr int I_IN = (D / 64) * (INC / 32), I_CO = (CC / 64) * (D / 32), I_AO = (QD / 64) * (D / 32), I_OUT = (D / 64) * (D / 32);
    constexpr int NITEMS = I_IN + I_CO + I_AO + I_OUT;
    for (int it = gw; it < NITEMS; it += NGW) {
        int r = it;
        if (r < I_IN) { const int nblk = INC / 32, kb = r / nblk, nb = r % nblk; p0_transpose_item(p.w_in, INC, win_srccol(32 * nb), 64 * kb, p.g_mix, wt_in, D, 32 * nb, scr, lane); continue; } r -= I_IN;
        if (r < I_CO) { const int nblk = D / 32, kb = r / nblk, nb = r % nblk; p0_transpose_item(p.w_conv_out, D, 32 * nb, 64 * kb, nullptr, wt_co, CC, 32 * nb, scr, lane); continue; } r -= I_CO;
        if (r < I_AO) { const int nblk = D / 32, kb = r / nblk, nb = r % nblk; p0_transpose_item(p.w_attn_out, D, 32 * nb, 64 * kb, nullptr, wt_ao, QD, 32 * nb, scr, lane); continue; } r -= I_AO;
        { const int nblk = D / 32, kb = r / nblk, nb = r % nblk; p0_transpose_item(p.w_out, D, 32 * nb, 64 * kb, nullptr, wt_out, D, 32 * nb, scr, lane); }
    }
    bf16_t* xb = (bf16_t*)(ws + WS_XB); float* rstd1 = (float*)(ws + WS_RSTD1);
    for (int m = gw; m < T; m += NGW) {
        const f32x4* xr = (const f32x4*)(p.x + (size_t)m * D) + lane;
        f32x4 v[4]; float s = 0.f;
#pragma unroll
        for (int j = 0; j < 4; ++j) { v[j] = xr[64 * j]; s += (v[j][0] * v[j][0] + v[j][1] * v[j][1]) + (v[j][2] * v[j][2] + v[j][3] * v[j][3]); }
        s = wave_sum(s);
        if (lane == 0) rstd1[m] = rsqrtf(s * (1.f / D) + EPS);
        u32x2* o = (u32x2*)(xb + (size_t)m * D) + lane;
#pragma unroll
        for (int j = 0; j < 4; ++j) { u32x2 w; w.x = cvt_pk_bf16(v[j][0], v[j][1]); w.y = cvt_pk_bf16(v[j][2], v[j][3]); o[64 * j] = w; }
    }
}

template <int N> __device__ __forceinline__ void red_step(float (&v)[16], int lane, int k) {
#pragma unroll
    for (int a = 0; a < N / 2; ++a) { const bool up = (lane & k) != 0; const float send = up ? v[a] : v[a + N / 2], keep = up ? v[a + N / 2] : v[a]; v[a] = keep + __shfl_xor(send, k); }
}
constexpr int CONV_ROWS = 64 + CW - 1;
__device__ __forceinline__ void conv_phase(const Params& p, const bf16_t* vglu, bf16_t* cact, LAS unsigned char* lds, const int wave_s) {
    const int tid = opaque_tid(wave_s), lane = tid & 63, wid = tid >> 6, cp = tid & 255, th = tid >> 8, wq = wid & 3;
    float w0[CW], w1[CW];
#pragma unroll
    for (int j = 0; j < CW; ++j) { w0[j] = p.w_dw[j * CC + 2 * cp]; w1[j] = p.w_dw[j * CC + 2 * cp + 1]; }
    const float bi0 = p.b_dw[2 * cp], bi1 = p.b_dw[2 * cp + 1], lg0 = p.ln_g[2 * cp], lg1 = p.ln_g[2 * cp + 1], lb0 = p.ln_b[2 * cp], lb1 = p.ln_b[2 * cp + 1];
    LAS unsigned char* Vs = lds;
    LAS float* red = (LAS float*)(lds + CONV_ROWS * 1024);
    for (int cb = blockIdx.x; cb < T / 64; cb += gridDim.x) {
        const int t0 = cb * 64, seq0 = (t0 / SEQ) * SEQ;
        __syncthreads();
        for (int c = tid; c < CONV_ROWS * 64; c += NT) {
            const int row = c >> 6, ch = c & 63, pos = t0 - (CW - 1) + row; u32x4 v = {0u, 0u, 0u, 0u};
            if (pos >= seq0) v = *(const u32x4*)(vglu + (size_t)pos * CC + ch * 8);
            *(LAS u32x4*)(Vs + row * 1024 + ch * 16) = v; }
        __syncthreads();
#pragma unroll 1
        for (int grp = 0; grp < 4; ++grp) {
            float y[8][2]; const int tok0 = 32 * th + 8 * grp;
#pragma unroll
            for (int i = 0; i < 8; ++i) { float y0 = bi0, y1 = bi1; const LAS unsigned char* base = Vs + (tok0 + i) * 1024 + cp * 4;
#pragma unroll
                for (int j = 0; j < CW; ++j) { const unsigned pr = *(const LAS unsigned*)(base + j * 1024); y0 = fmaf(w0[j], bf_lo(pr), y0); y1 = fmaf(w1[j], bf_hi(pr), y1); }
                y[i][0] = y0; y[i][1] = y1; }
            float v[16];
#pragma unroll
            for (int i = 0; i < 8; ++i) { v[i] = y[i][0] + y[i][1]; v[8 + i] = y[i][0] * y[i][0] + y[i][1] * y[i][1]; }
            red_step<16>(v, lane, 32); red_step<8>(v, lane, 16); red_step<4>(v, lane, 8); red_step<2>(v, lane, 4);
            float tot = v[0]; tot += __shfl_xor(tot, 2); tot += __shfl_xor(tot, 1);
            const int idx = ((lane >> 5) & 1) * 8 + ((lane >> 4) & 1) * 4 + ((lane >> 3) & 1) * 2 + ((lane >> 2) & 1);
            LAS float* rb = red + (grp & 1) * 128;
            if ((lane & 3) == 0) rb[(th * 4 + wq) * 16 + idx] = tot;
            __syncthreads();
#pragma unroll
            for (int i = 0; i < 8; ++i) {
                float S = 0.f, Q = 0.f;
#pragma unroll
                for (int q = 0; q < 4; ++q) { S += rb[(th * 4 + q) * 16 + i]; Q += rb[(th * 4 + q) * 16 + 8 + i]; }
                const float mean = S * (1.f / CC), var = Q * (1.f / CC) - mean * mean, rstd = rsqrtf(fmaxf(var, 0.f) + EPS);
                float z0 = (y[i][0] - mean) * rstd * lg0 + lb0, z1 = (y[i][1] - mean) * rstd * lg1 + lb1;
                z0 *= fsig(z0); z1 *= fsig(z1);
                *(unsigned*)(cact + (size_t)(t0 + tok0 + i) * CC + 2 * cp) = cvt_pk_bf16(z0, z1);
            }
        }
    }
}

__device__ __forceinline__ int crow(int r, int hi) { return (r & 3) + 8 * (r >> 2) + 4 * hi; }
constexpr int ATT_KS = 144, ATT_VT = 400, ATT_VT_OFF = 192 * ATT_KS;
__device__ __forceinline__ void attn_phase(const Params& p, const bf16_t* qb, const bf16_t* kvb, bf16_t* att, LAS unsigned char* lds, const int wave_s) {
    const int tid = opaque_tid(wave_s), lane = tid & 63, wid = __builtin_amdgcn_readfirstlane(tid >> 6), r32 = lane & 31, hi = lane >> 5, g = wid & 3, w2 = wid >> 2;
    LAS unsigned char* Ks = lds; LAS unsigned char* Vt = lds + ATT_VT_OFF;
    for (int u = blockIdx.x; u < (T / 64) * 2; u += gridDim.x) {
        const int qblk = u >> 1, kvh = u & 1, t0 = qblk * 64, seq0 = (t0 / SEQ) * SEQ, kpos0 = t0 - 128, h = kvh * 4 + g;
        __syncthreads();
        for (int c = tid; c < 192 * 8; c += NT) {
            const int row = c >> 3, ch = c & 7, pos = kpos0 + row; u32x4 kk = {0u, 0u, 0u, 0u}, vv = {0u, 0u, 0u, 0u};
            if (pos >= seq0) { const bf16_t* src = kvb + (size_t)pos * 256 + kvh * HD + ch * 8; kk = *(const u32x4*)src; vv = *(const u32x4*)(src + 128); }
            *(LAS u32x4*)(Ks + row * ATT_KS + ch * 16) = kk;
            LAS bf16_t* vt = (LAS bf16_t*)(Vt + (ch * 8) * ATT_VT) + row;
            vt[0 * (ATT_VT / 2)] = (bf16_t)(vv.x & 0xffffu); vt[1 * (ATT_VT / 2)] = (bf16_t)(vv.x >> 16); vt[2 * (ATT_VT / 2)] = (bf16_t)(vv.y & 0xffffu); vt[3 * (ATT_VT / 2)] = (bf16_t)(vv.y >> 16);
            vt[4 * (ATT_VT / 2)] = (bf16_t)(vv.z & 0xffffu); vt[5 * (ATT_VT / 2)] = (bf16_t)(vv.z >> 16); vt[6 * (ATT_VT / 2)] = (bf16_t)(vv.w & 0xffffu); vt[7 * (ATT_VT / 2)] = (bf16_t)(vv.w >> 16);
        }
        __syncthreads();
        const int tw = t0 + 32 * w2;
        bf16x8 qf[4]; { const bf16_t* qp = qb + (size_t)(tw + r32) * QD + h * HD + hi * 8;
#pragma unroll
            for (int ks = 0; ks < 4; ++ks) qf[ks] = *(const bf16x8*)(qp + ks * 16); }
        f32x16 pt[5];
#pragma unroll
        for (int jj = 0; jj < 5; ++jj) { f32x16 a = {0.f, 0.f, 0.f, 0.f, 0.f, 0.f, 0.f, 0.f, 0.f, 0.f, 0.f, 0.f, 0.f, 0.f, 0.f, 0.f};
            const LAS unsigned char* kp = Ks + (32 * (w2 + jj) + r32) * ATT_KS + hi * 16;
#pragma unroll
            for (int ks = 0; ks < 4; ++ks) { const bf16x8 kf = *(const LAS bf16x8*)(kp + ks * 32); a = __builtin_amdgcn_mfma_f32_32x32x16_bf16(kf, qf[ks], a, 0, 0, 0); }
            pt[jj] = a; __builtin_amdgcn_sched_barrier(0); }
        const float slope2 = exp2f(-(float)(h + 1)) * LOG2E, sink2 = p.sinks[h] * LOG2E;
        const int kmin = seq0 - (tw - 128); const int r32o = opaque_i(r32), hio = opaque_i(hi);
        float m = sink2;
#pragma unroll
        for (int jj = 0; jj < 5; ++jj)
#pragma unroll
            for (int r = 0; r < 16; ++r) { const int kw = 32 * jj + crow(r, hio), rel = 128 + r32o - kw; const bool valid = (kw > r32o) && (kw <= r32o + 128) && (kw >= kmin);
                const float s = valid ? pt[jj][r] - slope2 * (float)rel : -INFINITY; pt[jj][r] = s; m = fmaxf(m, s); }
        m = fmaxf(m, __shfl_xor(m, 32));
        float l = 0.f;
#pragma unroll
        for (int jj = 0; jj < 5; ++jj)
#pragma unroll
            for (int r = 0; r < 16; ++r) { const float e = __builtin_amdgcn_exp2f(pt[jj][r] - m); pt[jj][r] = e; l += e; }
        l += __shfl_xor(l, 32); l += __builtin_amdgcn_exp2f(sink2 - m);
        f32x16 o0 = {0.f, 0.f, 0.f, 0.f, 0.f, 0.f, 0.f, 0.f, 0.f, 0.f, 0.f, 0.f, 0.f, 0.f, 0.f, 0.f}, o1 = o0;
#pragma unroll
        for (int jj = 0; jj < 5; ++jj)
#pragma unroll
            for (int s2 = 0; s2 < 2; ++s2) {
                u32x4 pw; pw.x = cvt_pk_bf16(pt[jj][8 * s2 + 0], pt[jj][8 * s2 + 1]); pw.y = cvt_pk_bf16(pt[jj][8 * s2 + 2], pt[jj][8 * s2 + 3]);
                pw.z = cvt_pk_bf16(pt[jj][8 * s2 + 4], pt[jj][8 * s2 + 5]); pw.w = cvt_pk_bf16(pt[jj][8 * s2 + 6], pt[jj][8 * s2 + 7]);
                const bf16x8 pf = __builtin_bit_cast(bf16x8, pw);
                const LAS unsigned char* vp = Vt + r32 * ATT_VT + (32 * (w2 + jj) + 16 * s2 + 4 * hi) * 2;
                const u32x2 a0 = *(const LAS u32x2*)vp, a1 = *(const LAS u32x2*)(vp + 16), b0 = *(const LAS u32x2*)(vp + 32 * ATT_VT), b1 = *(const LAS u32x2*)(vp + 32 * ATT_VT + 16);
                const bf16x8 vf0 = __builtin_bit_cast(bf16x8, (u32x4){a0.x, a0.y, a1.x, a1.y}), vf1 = __builtin_bit_cast(bf16x8, (u32x4){b0.x, b0.y, b1.x, b1.y});
                o0 = __builtin_amdgcn_mfma_f32_32x32x16_bf16(vf0, pf, o0, 0, 0, 0); o1 = __builtin_amdgcn_mfma_f32_32x32x16_bf16(vf1, pf, o1, 0, 0, 0);
                __builtin_amdgcn_sched_barrier(0);
            }
        const float inv = 1.f / l;
        bf16_t* op = att + (size_t)(tw + r32) * QD + h * HD + 4 * hi;
#pragma unroll
        for (int rg = 0; rg < 4; ++rg) {
            u32x2 w0, w1; w0.x = cvt_pk_bf16(o0[4 * rg] * inv, o0[4 * rg + 1] * inv); w0.y = cvt_pk_bf16(o0[4 * rg + 2] * inv, o0[4 * rg + 3] * inv);
            w1.x = cvt_pk_bf16(o1[4 * rg] * inv, o1[4 * rg + 1] * inv); w1.y = cvt_pk_bf16(o1[4 * rg + 2] * inv, o1[4 * rg + 3] * inv);
            *(u32x2*)(op + 8 * rg) = w0; *(u32x2*)(op + 32 + 8 * rg) = w1; }
    }
}


__device__ __forceinline__ void p0_moe_weights(const Params& p, LAS unsigned char* lds, const int wave_s) {
    unsigned char* ws = p.ws;
    const int tidx = opaque_tid(wave_s), lane = tidx & 63, wave = tidx >> 6;
    LAS float* scr = (LAS float*)(lds + wave * 16384);
    const int gw = blockIdx.x * (NT / 64) + wave, NGW = gridDim.x * (NT / 64);
    bf16_t* wt_gu = (bf16_t*)(ws + WS_WT_GU); bf16_t* wt_d = (bf16_t*)(ws + WS_WT_D);
    constexpr int I_GU = (D / 64) * (1024 / 32), I_D = (DFF / 64) * (D / 32);
    for (int it = gw; it < NE * (I_GU + I_D); it += NGW) {
        const int e = it / (I_GU + I_D); int r = it % (I_GU + I_D);
        if (r < I_GU) { const int kb = r >> 5, nb = r & 31, np = 32 * nb, pn = np >> 8, bj = (np >> 7) & 1, o = np & 127;
            const float* W = (bj ? p.w_up : p.w_gate) + (size_t)e * D * DFF;
            p0_transpose_item(W, DFF, 128 * pn + o, 64 * kb, p.g_ffn, wt_gu + (size_t)e * 1024 * D, D, np, scr, lane); }
        else { r -= I_GU; const int kb = r >> 5, nb = r & 31;
            p0_transpose_item(p.w_down + (size_t)e * DFF * D, D, 32 * nb, 64 * kb, nullptr, wt_d + (size_t)e * D * DFF, DFF, 32 * nb, scr, lane); }
    }
}

constexpr int RT_WAVE = (64 * 36 + 32 * 32 + 32 * 4) * 4;
__device__ __forceinline__ void route_phase_fast(const Params& p, const float* H, bf16_t* hb, int* toke, int* tokr, int* ltok, float* lrs, float* lw, unsigned* gcount,
                                                 LAS unsigned char* lds, const int wave_s) {
    const int tid = opaque_tid(wave_s), lane = tid & 63, kq = wave_s & 3, tg = wave_s >> 2, r32 = lane & 31, hi = lane >> 5;
    LAS float* tile = (LAS float*)(lds + wave_s * RT_WAVE); LAS float* Wl = tile + 64 * 36; LAS float* Wgl = Wl + 32 * 32;
    LAS unsigned* hist = (LAS unsigned*)(lds + 8 * RT_WAVE);
    for (int task = blockIdx.x; task < T / 128; task += gridDim.x) {
        const int tok0 = task * 128 + tg * 64;
        if (tid < 32) hist[tid] = 0u;
        f32x16 acc0 = {0.f, 0.f, 0.f, 0.f, 0.f, 0.f, 0.f, 0.f, 0.f, 0.f, 0.f, 0.f, 0.f, 0.f, 0.f, 0.f}, acc1 = acc0;
        f32x4 ag = {0.f, 0.f, 0.f, 0.f}; float ss = 0.f;
        f32x4 hr[8], wr[4], wgr = {0.f, 0.f, 0.f, 0.f}; float gk[4], ggr = 0.f;
        const int rsub = lane >> 3, c4 = (lane & 7) * 4;
#define RT_LOAD(ch) do { const int k0_ = kq * 256 + (ch) * 32; \
            _Pragma("unroll") for (int i = 0; i < 8; ++i) hr[i] = *(const f32x4*)(H + (size_t)(tok0 + 8 * i + rsub) * D + k0_ + c4); \
            _Pragma("unroll") for (int i = 0; i < 4; ++i) { const int i4 = i * 64 + lane; wr[i] = *(const f32x4*)(p.w_expert + (size_t)k0_ * NE + i4 * 4); gk[i] = p.g_ffn[k0_ + (i4 >> 3)]; } \
            if (lane < 32) { wgr = *(const f32x4*)(p.w_group + (size_t)(k0_ + lane) * NG); ggr = p.g_ffn[k0_ + lane]; } } while (0)
        RT_LOAD(0);
#pragma unroll 1
        for (int ch = 0; ch < 8; ++ch) {
            const int k0 = kq * 256 + ch * 32;
#pragma unroll
            for (int i = 0; i < 8; ++i) { const int row = 8 * i + rsub; u32x2 w; w.x = cvt_pk_bf16(hr[i][0], hr[i][1]); w.y = cvt_pk_bf16(hr[i][2], hr[i][3]);
                *(u32x2*)(hb + (size_t)(tok0 + row) * D + k0 + c4) = w; *(LAS f32x4*)(tile + row * 36 + c4) = hr[i]; }
#pragma unroll
            for (int i = 0; i < 4; ++i) *(LAS f32x4*)(Wl + (i * 64 + lane) * 4) = wr[i] * gk[i];
            if (lane < 32) *(LAS f32x4*)(Wgl + lane * 4) = wgr * ggr;
            if (ch + 1 < 8) RT_LOAD(ch + 1);
            float bv[16];
#pragma unroll
            for (int s2 = 0; s2 < 16; ++s2) bv[s2] = Wl[(16 * hi + s2) * 32 + r32];
#pragma unroll
            for (int tt = 0; tt < 2; ++tt) {
                f32x4 a4[4];
#pragma unroll
                for (int q = 0; q < 4; ++q) a4[q] = *(const LAS f32x4*)(tile + (32 * tt + r32) * 36 + 16 * hi + 4 * q);
#pragma unroll
                for (int s2 = 0; s2 < 16; ++s2) { if (tt == 0) acc0 = __builtin_amdgcn_mfma_f32_32x32x2f32(a4[s2 >> 2][s2 & 3], bv[s2], acc0, 0, 0, 0);
                                                  else acc1 = __builtin_amdgcn_mfma_f32_32x32x2f32(a4[s2 >> 2][s2 & 3], bv[s2], acc1, 0, 0, 0); }
            }
#pragma unroll
            for (int k4 = 0; k4 < 8; ++k4) { const f32x4 hv = *(const LAS f32x4*)(tile + lane * 36 + 4 * k4);
#pragma unroll
                for (int q = 0; q < 4; ++q) { const f32x4 wg = *(const LAS f32x4*)(Wgl + (4 * k4 + q) * 4); ag += wg * hv[q]; ss = fmaf(hv[q], hv[q], ss); } }
        }
#undef RT_LOAD
#pragma unroll
        for (int r = 0; r < 16; ++r) { const int cr = (r & 3) + 8 * (r >> 2) + 4 * hi; tile[cr * 37 + 4 + r32] = acc0[r]; tile[(32 + cr) * 37 + 4 + r32] = acc1[r]; }
        tile[lane * 37 + 0] = ag[0]; tile[lane * 37 + 1] = ag[1]; tile[lane * 37 + 2] = ag[2]; tile[lane * 37 + 3] = ag[3]; tile[lane * 37 + 36] = ss;
        __syncthreads();
        int ea = 0, eb = 0; unsigned ra = 0u, rb = 0u; float w1 = 0.f, w2 = 0.f, rstd = 0.f;
        if (kq == 0) {
            float lg[NG + NE]; float s2 = 0.f;
#pragma unroll
            for (int e = 0; e < NG + NE; ++e) lg[e] = 0.f;
#pragma unroll
            for (int q = 0; q < 4; ++q) { const LAS float* pt = (const LAS float*)(lds + (tg * 4 + q) * RT_WAVE) + lane * 37;
#pragma unroll
                for (int e = 0; e < NG + NE; ++e) lg[e] += pt[e];
                s2 += pt[36]; }
            rstd = rsqrtf(s2 * (1.f / D) + EPS);
            float gl[NG]; float gmax = -INFINITY; int gsel = 0;
#pragma unroll
            for (int g = 0; g < NG; ++g) { gl[g] = lg[g] * rstd + p.b_group[g]; if (gl[g] > gmax) { gmax = gl[g]; gsel = g; } }
            float gden = 0.f;
#pragma unroll
            for (int g = 0; g < NG; ++g) gden += __expf(gl[g] - gmax);
            const float pg = 1.f / gden;
            float v1 = -INFINITY, v2 = -INFINITY; int i1 = 0, i2 = 0;
#pragma unroll
            for (int g = 0; g < NG; ++g) if (g == gsel) {
#pragma unroll
                for (int j = 0; j < EPG; ++j) { const float val = lg[4 + g * EPG + j] * rstd + p.b_expert[g * EPG + j];
                    if (val > v1) { v2 = v1; i2 = i1; v1 = val; i1 = j; } else if (val > v2) { v2 = val; i2 = j; } }
            }
            const float e2 = __expf(v2 - v1); w1 = pg / (1.f + e2); w2 = pg * e2 / (1.f + e2);
            ea = gsel * EPG + i1; eb = gsel * EPG + i2;
            ra = __hip_atomic_fetch_add(hist + ea, 1u, __ATOMIC_RELAXED, __HIP_MEMORY_SCOPE_WORKGROUP);
            rb = __hip_atomic_fetch_add(hist + eb, 1u, __ATOMIC_RELAXED, __HIP_MEMORY_SCOPE_WORKGROUP);
        }
        __syncthreads();
        if (tid < 32) hist[32 + tid] = __hip_atomic_fetch_add(gcount + tid, hist[tid], __ATOMIC_RELAXED, __HIP_MEMORY_SCOPE_AGENT);
        __syncthreads();
        if (kq == 0) {
            const int tok = tok0 + lane; const unsigned pa = hist[32 + ea] + ra, pb = hist[32 + eb] + rb;
            ltok[(size_t)ea * CAP + pa] = tok; lrs[(size_t)ea * CAP + pa] = rstd; lw[(size_t)ea * CAP + pa] = w1;
            ltok[(size_t)eb * CAP + pb] = tok; lrs[(size_t)eb * CAP + pb] = rstd; lw[(size_t)eb * CAP + pb] = w2;
            toke[2 * tok] = ea; toke[2 * tok + 1] = eb; tokr[2 * tok] = (int)pa; tokr[2 * tok + 1] = (int)pb;
        }
        __syncthreads();
    }
}

__device__ __forceinline__ void moe_build_map(const unsigned* gcount, LAS unsigned char* lds, int tid) {
    LAS int* nbp = (LAS int*)(lds + MOE_NBP_OFF); LAS int* cnt = (LAS int*)(lds + MOE_CNT_OFF);
    __syncthreads();
    if (tid == 0) { int acc = 0;
        for (int e = 0; e < NE; ++e) { const int c = (int)__hip_atomic_load(gcount + e, __ATOMIC_RELAXED, __HIP_MEMORY_SCOPE_AGENT); cnt[e] = c; nbp[e] = acc; acc += (c + 255) >> 8; }
        nbp[NE] = acc; }
    __syncthreads();
}
__device__ __forceinline__ void moe_build_units(const int* ltok, LAS unsigned char* lds, int G, int c, int tid, bool gather) {
    const LAS int* nbp = (const LAS int*)(lds + MOE_NBP_OFF); const LAS int* cnt = (const LAS int*)(lds + MOE_CNT_OFF);
    LAS int* ut = (LAS int*)(lds + MOE_UT_OFF); LAS unsigned* tbl = (LAS unsigned*)(lds + MOE_TBL_OFF);
    const int nunits = nbp[NE] * 4;
    for (int i = 0; i < MOE_MAXU; ++i) {
        const int L = i * G + c; if (L >= nunits) break;
        const int blk = L >> 2; int e = 0;
        for (int j = 1; j < NE; ++j) if (blk >= nbp[j]) e = j;
        const int rb = blk - nbp[e];
        if (tid == 0) { ut[4 * i] = e; ut[4 * i + 1] = blk; ut[4 * i + 2] = L & 3; ut[4 * i + 3] = rb * 256; }
        if (gather && tid < 256) { const int rank = rb * 256 + tid; tbl[i * 256 + tid] = rank < cnt[e] ? (unsigned)ltok[(size_t)e * CAP + rank] * (unsigned)(D * 2) : 0u; }
    }
    __syncthreads();
}
namespace pg8 {
struct MoeSched {
    const LAS int* ut; const LAS unsigned* tbl; const LAS int* nbp; const char* A; const char* Bt; int G, c, K; bool gather;
    __device__ __forceinline__ bool next(int i, Unit& u) const {
        const int nunits = __builtin_amdgcn_readfirstlane(nbp[NE]) * 4;
        if (i >= MOE_MAXU || i * G + c >= nunits) return false;
        const int e = __builtin_amdgcn_readfirstlane(ut[4 * i]), blk = __builtin_amdgcn_readfirstlane(ut[4 * i + 1]), pn = __builtin_amdgcn_readfirstlane(ut[4 * i + 2]), r0 = __builtin_amdgcn_readfirstlane(ut[4 * i + 3]);
        u.pm = blk; u.pn = pn; u.aux = e; u.rank0 = r0;
        u.a = gather ? A : A + (size_t)blk * 256 * K * 2;
        u.b = Bt + ((size_t)e * 1024 + (size_t)pn * 256) * K * 2;
        return true;
    }
    __device__ __forceinline__ void a_voff(const Unit&, int ui, int tid, int K_, unsigned (&v)[2][2]) const {
#pragma unroll
        for (int i = 0; i < 2; ++i) { int R, C; stage_rc(tid * 16 + i * 8192, R, C);
            if (gather) { v[0][i] = tbl[ui * 256 + R] + (unsigned)C * 2u; v[1][i] = tbl[ui * 256 + HALF + R] + (unsigned)C * 2u; }
            else { v[0][i] = (unsigned)(R * K_ + C) * 2u; v[1][i] = (unsigned)((HALF + R) * K_ + C) * 2u; } }
    }
    __device__ __forceinline__ void a_ready(const Unit&) const {}
    __device__ __forceinline__ void done(const Unit&) const {}
};
struct EpiSwiglu {
    static constexpr bool PERM = true, AFTER_DRAIN = false;
    const float* lrs; const LAS int* cnt; bf16_t* hmid;
    __device__ __forceinline__ void operator()(const f32x4 (&acc)[2][2][4][2], const Unit& u, int wr, int wc, int fr, int fq) const {
        const int e = u.aux, n = __builtin_amdgcn_readfirstlane(cnt[e]); const int coff = wc * 32 + 8 * fq;
#pragma unroll
        for (int ai = 0; ai < 2; ++ai)
#pragma unroll
            for (int m = 0; m < 4; ++m) {
                const int ri = ai * HALF + wr * 64 + m * 16 + fr, rank = u.rank0 + ri; const float s = rank < n ? lrs[(size_t)e * CAP + rank] : 0.f;
                const f32x4 a0 = acc[ai][0][m][0] * s, a1 = acc[ai][0][m][1] * s, b0 = acc[ai][1][m][0] * s, b1 = acc[ai][1][m][1] * s;
                *(u32x4*)(hmid + (size_t)(u.pm * 256 + ri) * DFF + 128 * u.pn + coff) = pack8(a0 * sig4(a0) * b0, a1 * sig4(a1) * b1);
            }
    }
};
struct EpiDown {
    static constexpr bool PERM = true, AFTER_DRAIN = false;
    const float* lw; const LAS int* cnt; bf16_t* y;
    __device__ __forceinline__ void operator()(const f32x4 (&acc)[2][2][4][2], const Unit& u, int wr, int wc, int fr, int fq) const {
        const int e = u.aux, n = __builtin_amdgcn_readfirstlane(cnt[e]); const int col0 = u.pn * BM + wc * 32 + 8 * fq;
#pragma unroll
        for (int ai = 0; ai < 2; ++ai)
#pragma unroll
            for (int m = 0; m < 4; ++m) {
                const int ri = ai * HALF + wr * 64 + m * 16 + fr, rank = u.rank0 + ri; const float s = rank < n ? lw[(size_t)e * CAP + rank] : 0.f;
                bf16_t* yp = y + (size_t)(u.pm * 256 + ri) * D + col0;
                *(u32x4*)yp = pack8(acc[ai][0][m][0] * s, acc[ai][0][m][1] * s); *(u32x4*)(yp + HALF) = pack8(acc[ai][1][m][0] * s, acc[ai][1][m][1] * s);
            }
    }
};
}

__device__ __forceinline__ void final_phase(const Params& p, const float* H, const bf16_t* y, const int* toke, const int* tokr, LAS unsigned char* lds, const int wave_s) {
    const int tidx = opaque_tid(wave_s), lane = tidx & 63, gw = blockIdx.x * (NT / 64) + (tidx >> 6), NGW = gridDim.x * (NT / 64);
    const LAS int* nbp = (const LAS int*)(lds + MOE_NBP_OFF);
    for (int m = gw; m < T; m += NGW) {
        const int ea = toke[2 * m], eb = toke[2 * m + 1];
        const size_t sa = (size_t)nbp[ea] * 256 + tokr[2 * m], sb = (size_t)nbp[eb] * 256 + tokr[2 * m + 1];
        const f32x4* xr = (const f32x4*)(H + (size_t)m * D) + lane; const u32x2* ya = (const u32x2*)(y + sa * D) + lane; const u32x2* yb = (const u32x2*)(y + sb * D) + lane;
        f32x4 v[4]; float s = 0.f;
#pragma unroll
        for (int j = 0; j < 4; ++j) { const u32x2 a = ya[64 * j], b = yb[64 * j];
            v[j] = xr[64 * j] + (f32x4){bf_lo(a.x), bf_hi(a.x), bf_lo(a.y), bf_hi(a.y)} + (f32x4){bf_lo(b.x), bf_hi(b.x), bf_lo(b.y), bf_hi(b.y)};
            s += (v[j][0] * v[j][0] + v[j][1] * v[j][1]) + (v[j][2] * v[j][2] + v[j][3] * v[j][3]); }
        const float rstd = rsqrtf(wave_sum(s) * (1.f / D) + EPS);
        f32x4* o = (f32x4*)(p.out + (size_t)m * D) + lane;
#pragma unroll
        for (int j = 0; j < 4; ++j) o[64 * j] = v[j] * rstd * ((const f32x4*)p.g_final)[lane + 64 * j];
    }
}


__global__ void __launch_bounds__(NT, 2) k_all(Params p) {
    extern __shared__ __attribute__((aligned(16))) unsigned char lds_raw[];
    LAS unsigned char* lds = (LAS unsigned char*)lds_raw;
    volatile LAS unsigned* MISC = (volatile LAS unsigned*)(lds + MISC_OFF);
    const int wave_s = __builtin_amdgcn_readfirstlane((int)threadIdx.x >> 6);
    if (threadIdx.x < 32) MISC[threadIdx.x] = 0u;
    __syncthreads();
    unsigned char* ws = p.ws;
    unsigned* ctl = (unsigned*)(ws + WS_CTL);
    XcdBarrier bar = xcd_barrier_post(ctl + CW_BAR, MISC, wave_s == 0);
    const int G = gridDim.x;

    bf16_t* wt_in = (bf16_t*)(ws + WS_WT_IN); bf16_t* wt_co = (bf16_t*)(ws + WS_WT_CO); bf16_t* wt_ao = (bf16_t*)(ws + WS_WT_AO); bf16_t* wt_out = (bf16_t*)(ws + WS_WT_OUT);
    bf16_t* xb = (bf16_t*)(ws + WS_XB); bf16_t* merged = (bf16_t*)(ws + WS_MERGED); float* rstd1 = (float*)(ws + WS_RSTD1);
    bf16_t* vglu = (bf16_t*)(ws + WS_VGLU); bf16_t* qb = (bf16_t*)(ws + WS_QB); bf16_t* kvb = (bf16_t*)(ws + WS_KVB);
    bf16_t* sgc = (bf16_t*)(ws + WS_SGC); bf16_t* sga = (bf16_t*)(ws + WS_SGA); bf16_t* cact = (bf16_t*)(ws + WS_CACT); bf16_t* att = (bf16_t*)(ws + WS_ATT);
    float* H = p.out;

#ifndef ENABLE
#define ENABLE 0xff
#endif
#ifndef REPEAT
#define REPEAT 0
#endif
#define REP(k) _Pragma("unroll") for (int rep_ = 0; rep_ < 1 + ((REPEAT >> (k)) & 1); ++rep_)
    asm volatile("; PHASE_MARK 0");
    REP(0) if (ENABLE & 1) { p0_prologue(p, lds, wave_s); p0_moe_weights(p, lds, wave_s); }
    xcd_barrier(bar);
    asm volatile("; PHASE_MARK 1");
    REP(1) if (ENABLE & 2) { pg8::DenseSched S; S.init(xb, wt_in, T, INC, D, G, (int)blockIdx.x);
      pg8::EpiProj E{rstd1, vglu, qb, kvb, sgc, sga, 0.125f * LOG2E};
      pg8::gemm_phase<pg8::EpiProj, pg8::DenseSched, true, true>(lds, D, S, E, wave_s); }
    xcd_barrier(bar);
    asm volatile("; PHASE_MARK 2");
    REP(2) if (ENABLE & 4) conv_phase(p, vglu, cact, lds, wave_s);
    asm volatile("; PHASE_MARK 3");
    REP(3) if (ENABLE & 8) attn_phase(p, qb, kvb, att, lds, wave_s);
    xcd_barrier(bar);
    REP(4) {
    asm volatile("; PHASE_MARK 4");
    if (ENABLE & 16) { pg8::DenseSched S; S.init(cact, wt_co, T, D, CC, G, (int)blockIdx.x);
      pg8::EpiGate<false> E{sgc, merged};
      pg8::gemm_phase<pg8::EpiGate<false>, pg8::DenseSched, true, true>(lds, CC, S, E, wave_s); }
    asm volatile("; PHASE_MARK 5");
    if (ENABLE & 16) { pg8::DenseSched S; S.init(att, wt_ao, T, D, QD, G, (int)blockIdx.x);
      pg8::EpiGate<true> E{sga, merged};
      pg8::gemm_phase<pg8::EpiGate<true>, pg8::DenseSched, true, true>(lds, QD, S, E, wave_s); }
    }
    xcd_barrier(bar);
    asm volatile("; PHASE_MARK 6");
    REP(5) if (ENABLE & 32) { pg8::DenseSched S; S.init(merged, wt_out, T, D, D, G, (int)blockIdx.x);
      pg8::EpiResid E{p.x, H};
      pg8::gemm_phase<pg8::EpiResid, pg8::DenseSched, true, true>(lds, D, S, E, wave_s); }
    xcd_barrier(bar);
    bf16_t* hb = (bf16_t*)(ws + WS_HB); bf16_t* hmid = (bf16_t*)(ws + WS_HMID); bf16_t* y = (bf16_t*)(ws + WS_Y);
    int* toke = (int*)(ws + WS_TOKE); int* tokr = (int*)(ws + WS_TOKR); int* ltok = (int*)(ws + WS_LTOK); float* lrs = (float*)(ws + WS_LRS); float* lw = (float*)(ws + WS_LW);
    unsigned* gcount = ctl + CW_CNT;
    asm volatile("; PHASE_MARK 7");
    route_phase_fast(p, H, hb, toke, tokr, ltok, lrs, lw, gcount, lds, wave_s);
    xcd_barrier(bar);
    asm volatile("; PHASE_MARK 8");
    REP(8) { const int tid = opaque_tid(wave_s);
      moe_build_map(gcount, lds, tid); moe_build_units(ltok, lds, G, (int)blockIdx.x, tid, true);
      pg8::MoeSched S{(const LAS int*)(lds + MOE_UT_OFF), (const LAS unsigned*)(lds + MOE_TBL_OFF), (const LAS int*)(lds + MOE_NBP_OFF), (const char*)hb, (const char*)(ws + WS_WT_GU), G, (int)blockIdx.x, D, true};
      pg8::EpiSwiglu E{lrs, (const LAS int*)(lds + MOE_CNT_OFF), hmid};
      pg8::gemm_phase<pg8::EpiSwiglu, pg8::MoeSched, true, true>(lds, D, S, E, wave_s); }
    xcd_barrier(bar);
    asm volatile("; PHASE_MARK 9");
    REP(9) { const int tid = opaque_tid(wave_s);
      moe_build_map(gcount, lds, tid); moe_build_units(ltok, lds, G, (int)blockIdx.x, tid, false);
      pg8::MoeSched S{(const LAS int*)(lds + MOE_UT_OFF), (const LAS unsigned*)(lds + MOE_TBL_OFF), (const LAS int*)(lds + MOE_NBP_OFF), (const char*)hmid, (const char*)(ws + WS_WT_D), G, (int)blockIdx.x, DFF, false};
      pg8::EpiDown E{lw, (const LAS int*)(lds + MOE_CNT_OFF), y};
      pg8::gemm_phase<pg8::EpiDown, pg8::MoeSched, true, true>(lds, DFF, S, E, wave_s); }
    xcd_barrier(bar);
    asm volatile("; PHASE_MARK 10");
    { const int tid = opaque_tid(wave_s); moe_build_map(gcount, lds, tid); }
    final_phase(p, H, y, toke, tokr, lds, wave_s);
}

extern "C" void kernel_launch(void* const* d_in, const int* in_sizes, int n_in, void* d_out, int out_size, void* d_ws, size_t ws_size, hipStream_t stream) {
    static int grid = 0;
    if (grid == 0) {
        if (n_in != 20 || in_sizes[0] != T * D || out_size != T * D || ws_size < WS_END) {
            fprintf(stderr, "kernel_launch: unexpected shapes (n_in %d, in0 %d, out %d, ws %zu); nothing launched\n", n_in, n_in > 0 ? in_sizes[0] : -1, out_size, ws_size); grid = -1; return; }
        int dev = 0, cus = 0, per_cu = 0;
        if (hipGetDevice(&dev) != hipSuccess || hipDeviceGetAttribute(&cus, hipDeviceAttributeMultiprocessorCount, dev) != hipSuccess) { grid = -1; return; }
        if (hipFuncSetAttribute((const void*)k_all, hipFuncAttributeMaxDynamicSharedMemorySize, LDS_BYTES) != hipSuccess) { fprintf(stderr, "kernel_launch: hipFuncSetAttribute failed\n"); grid = -1; return; }
        if (hipOccupancyMaxActiveBlocksPerMultiprocessor(&per_cu, (const void*)k_all, NT, LDS_BYTES) != hipSuccess || per_cu < 1)
            fprintf(stderr, "kernel_launch: note: occupancy query reports %d workgroups per CU\n", per_cu);
        (void)hipGetLastError();
        grid = cus;
    }
    if (grid < 0) return;
    if (hipMemsetAsync((char*)d_ws + WS_CTL, 0, CTL_BYTES, stream) != hipSuccess) return;
    Params p{};
    const float** pp = (const float**)&p;
    for (int i = 0; i < 20; ++i) pp[i] = (const float*)d_in[i];
    p.out = (float*)d_out; p.ws = (unsigned char*)d_ws;
    hipLaunchKernelGGL(k_all, dim3(grid), dim3(NT), LDS_BYTES, stream, p);
}
```

```cpp
#include <hip/hip_runtime.h>
#include <cstdio>
#include <cstdint>

constexpr int T = 32768, D = 1024, SEQ = 4096;
constexpr int CC = 512, CW = 31, NH = 8, HD = 64, QD = 512, KVD = 128, INC = 3840;
constexpr int NE = 32, NG = 4, EPG = 8, DFF = 512;
constexpr float EPS = 1e-6f;
constexpr int NT = 512;
constexpr float LOG2E = 1.4426950408889634f;

#define GAS __attribute__((address_space(1)))
#define LAS __attribute__((address_space(3)))
typedef unsigned short bf16_t;
typedef short bf16x8 __attribute__((ext_vector_type(8)));
typedef float f32x4 __attribute__((ext_vector_type(4)));
typedef float f32x16 __attribute__((ext_vector_type(16)));
typedef unsigned u32x4 __attribute__((ext_vector_type(4)));
typedef unsigned u32x2 __attribute__((ext_vector_type(2)));

__device__ __forceinline__ int lane_id_v() { int l; asm volatile("v_mbcnt_lo_u32_b32 %0, -1, 0\n\tv_mbcnt_hi_u32_b32 %0, -1, %0" : "=v"(l)); return l; }
__device__ __forceinline__ int opaque_tid(int wave_s) { return wave_s * 64 + lane_id_v(); }
__device__ __forceinline__ int opaque_i(int v) { asm volatile("" : "+v"(v)); return v; }
__device__ __forceinline__ float wave_sum(float v) {
#pragma unroll
    for (int o = 1; o < 64; o <<= 1) v += __shfl_xor(v, o);
    return v;
}
__device__ __forceinline__ float sigmoidf_(float v) { return 1.f / (1.f + __expf(-v)); }
__device__ __forceinline__ float fsig(float v) { return __builtin_amdgcn_rcpf(1.f + __builtin_amdgcn_exp2f(-LOG2E * v)); }
__device__ __forceinline__ unsigned cvt_pk_bf16(float lo, float hi) { unsigned r; asm volatile("v_cvt_pk_bf16_f32 %0, %1, %2" : "=v"(r) : "v"(lo), "v"(hi)); return r; }
__device__ __forceinline__ float bf_lo(unsigned w) { return __uint_as_float(w << 16); }
__device__ __forceinline__ float bf_hi(unsigned w) { return __uint_as_float(w & 0xffff0000u); }

namespace pg8 {
#define PG8_LAS __attribute__((address_space(3)))
constexpr int BM = 256, BK = 64, HALF = 128, HTB = HALF * BK * 2  , STAGE_BYTES = 8 * HTB, NXCD = 8, WGM = 8;

__host__ __device__ __forceinline__ int lds_byte(int r, int c) { const int st = (r >> 4) * 2 + (c >> 5), rr = r & 15, cc = c & 31, ob = rr * 64 + cc * 2; return st * 1024 + (ob ^ (((ob >> 9) & 1) << 5)); }
__host__ __device__ __forceinline__ void stage_rc(int b, int& R, int& C) { const int st = b / 1024, sb = b % 1024, swz = sb ^ (((sb >> 9) & 1) << 5); R = (st >> 1) * 16 + swz / 64; C = (st & 1) * 32 + (swz % 64) / 2; }
__host__ __device__ __forceinline__ int perm32(int rho) { const int n = rho >> 4, i = rho & 15; return 8 * (i >> 2) + 4 * n + (i & 3); }

struct Unit { int pm, pn; const char* a; const char* b; int aux, rank0; };

struct StaticOrder {
    int nM, nN, nwg, G, c;
    __host__ __device__ void init(int M, int N, int G_, int c_) { nM = M / BM; nN = N / BM; nwg = nM * nN; G = G_; c = c_; }
    __host__ __device__ bool next_mn(int i, int& pm, int& pn) const {
        const long L = (long)i * G + c; if (L >= nwg) return false;
        int wgid = (int)L; { const int q = nwg / NXCD, r = nwg % NXCD, xcd = wgid % NXCD, off = wgid / NXCD; wgid = (xcd < r ? xcd * (q + 1) : r * (q + 1) + (xcd - r) * q) + off; }
        const int nig = WGM * nN, gid = wgid / nig, fm = gid * WGM, gsz = (nM - fm) < WGM ? (nM - fm) : WGM;
        pm = fm + ((wgid % nig) % gsz); pn = (wgid % nig) / gsz; return true;
    }
};
struct DenseSched {
    StaticOrder so; const char* A; const char* Bt; size_t tstep;
    __device__ __forceinline__ void init(const bf16_t* A_, const bf16_t* Bt_, int M, int N, int K, int G, int c) { so.init(M, N, G, c); A = (const char*)A_; Bt = (const char*)Bt_; tstep = (size_t)BM * K * 2; }
    __device__ __forceinline__ bool next(int i, Unit& u) const { if (!so.next_mn(i, u.pm, u.pn)) return false; u.a = A + (size_t)u.pm * tstep; u.b = Bt + (size_t)u.pn * tstep; u.aux = 0; u.rank0 = 0; return true; }
    __device__ __forceinline__ void a_voff(const Unit&, int, int tid, int K, unsigned (&v)[2][2]) const {
#pragma unroll
        for (int i = 0; i < 2; ++i) { int R, C; stage_rc(tid * 16 + i * 8192, R, C); v[0][i] = (unsigned)(R * K + C) * 2u; v[1][i] = (unsigned)((HALF + R) * K + C) * 2u; } }
    __device__ __forceinline__ void a_ready(const Unit&) const {}
    __device__ __forceinline__ void done(const Unit&) const {}
};

template <class Epi, class Sched, bool ALIGN_EPI = false, bool SP2 = false>
__device__ __forceinline__ void gemm_phase(PG8_LAS unsigned char* lds, const int K_, const Sched& S, const Epi& E, const int wave_s) {
    const int tid_ = opaque_tid(wave_s); const int tid = tid_, wid = __builtin_amdgcn_readfirstlane(tid >> 6), lane = tid & 63, wr = wid >> 2, wc = wid & 3, fr = lane & 15, fq = lane >> 4;
    const int K = K_, nt = K / BK;
    unsigned voffB[2]; unsigned vC[2][2], vN[2][2];
#pragma unroll
    for (int i = 0; i < 2; ++i) { int R, C; stage_rc(tid * 16 + i * 8192, R, C); const int Rb = Epi::PERM ? ((R & ~31) + perm32(R & 31)) : R;
        voffB[i] = (unsigned)(Rb * K + C) * 2u; }
    const size_t kstep = (size_t)(BK * 2);
    const size_t hstep = (size_t)HALF * K * 2;
    const unsigned ldsw = (unsigned)wid * 1024u;
    const int aoff = lds_byte(wr * 64 + fr, fq * 8), boff = lds_byte(wc * 32 + fr, fq * 8);
#define PG8_SA(b, h) (((b) * 2 + (h)) * HTB)
#define PG8_SB(b, h) ((4 + (b) * 2 + (h)) * HTB)
#define PG8_STAGE(bufoff, gbase, voff) do { _Pragma("unroll") for (int _i = 0; _i < 2; ++_i) \
        __builtin_amdgcn_global_load_lds((const unsigned*)((const char*)(gbase) + (voff)[_i]), (PG8_LAS unsigned*)(lds + (bufoff) + ldsw + _i * 8192), 16, 0, 0); } while (0)
#define PG8_LDA(dst, b, h) do { _Pragma("unroll") for (int m = 0; m < 4; ++m) _Pragma("unroll") for (int k = 0; k < 2; ++k) dst[m][k] = *(const PG8_LAS bf16x8*)(lds + PG8_SA(b, h) + aoff + m * 2048 + k * 1024); } while (0)
#define PG8_LDB(dst, b, h) do { _Pragma("unroll") for (int n = 0; n < 2; ++n) _Pragma("unroll") for (int k = 0; k < 2; ++k) dst[n][k] = *(const PG8_LAS bf16x8*)(lds + PG8_SB(b, h) + boff + n * 2048 + k * 1024); } while (0)
#define PG8_MMA(ai, bj, At, Bt) do { __builtin_amdgcn_s_setprio(1); _Pragma("unroll") for (int m = 0; m < 4; ++m) _Pragma("unroll") for (int n = 0; n < 2; ++n) _Pragma("unroll") for (int k = 0; k < 2; ++k) \
        acc[ai][bj][m][n] = __builtin_amdgcn_mfma_f32_16x16x32_bf16(Bt[n][k], At[m][k], acc[ai][bj][m][n], 0, 0, 0); __builtin_amdgcn_s_setprio(0); } while (0)
#define PG8_WAIT_V(n) asm volatile("s_waitcnt vmcnt(" #n ")" ::: "memory")
#define PG8_WAIT_L(n) asm volatile("s_waitcnt lgkmcnt(" #n ")" ::: "memory")
#define PG8_BAR __builtin_amdgcn_s_barrier()
#define PG8_SCHED __builtin_amdgcn_sched_barrier(0)
    Unit cur, nxt; int ui = 0;
    if (!S.next(0, cur)) return;
    S.a_voff(cur, 0, tid, K, vC);
    f32x4 acc[2][2][4][2];
#pragma unroll
    for (int a = 0; a < 2; ++a)
#pragma unroll
        for (int b = 0; b < 2; ++b)
#pragma unroll
            for (int m = 0; m < 4; ++m)
#pragma unroll
                for (int n = 0; n < 2; ++n) acc[a][b][m][n] = (f32x4){0.f, 0.f, 0.f, 0.f};
    bf16x8 At[4][2], B0[2][2], B1[2][2];
    const char* cA = cur.a; const char* cB = cur.b;
    S.a_ready(cur);
    if constexpr (SP2) {
        PG8_STAGE(PG8_SB(0, 0), cB, voffB); PG8_STAGE(PG8_SB(0, 1), cB + hstep, voffB); PG8_STAGE(PG8_SA(0, 0), cA, vC[0]); PG8_STAGE(PG8_SA(0, 1), cA, vC[1]);
        if (wr == 1) PG8_BAR;
        PG8_WAIT_V(2); PG8_BAR;
        PG8_STAGE(PG8_SB(1, 0), cB + kstep, voffB); PG8_STAGE(PG8_SA(1, 0), cA + kstep, vC[0]); PG8_STAGE(PG8_SB(1, 1), cB + hstep + kstep, voffB);
        PG8_WAIT_V(6); PG8_BAR;
    } else {
        PG8_STAGE(PG8_SB(0, 0), cB, voffB); PG8_STAGE(PG8_SA(0, 0), cA, vC[0]); PG8_STAGE(PG8_SB(0, 1), cB + hstep, voffB); PG8_STAGE(PG8_SA(0, 1), cA, vC[1]);
        if (wr == 1) PG8_BAR;
        PG8_WAIT_V(4); PG8_BAR;
        PG8_STAGE(PG8_SB(1, 0), cB + kstep, voffB); PG8_STAGE(PG8_SA(1, 0), cA + kstep, vC[0]); PG8_STAGE(PG8_SB(1, 1), cB + hstep + kstep, voffB);
        PG8_WAIT_V(6); PG8_BAR;
    }
    for (;;) {
        const bool has_next = S.next(ui + 1, nxt);
        if (has_next) S.a_voff(nxt, ui + 1, tid, K, vN); else { vN[0][0] = vC[0][0]; vN[0][1] = vC[0][1]; vN[1][0] = vC[1][0]; vN[1][1] = vC[1][1]; }
        const char* nA = has_next ? nxt.a : cA; const char* nB = has_next ? nxt.b : cB;
        for (int t = 0; t < nt; t += 2) {
            const bool last = (t == nt - 2);
            unsigned v2[2][2]; v2[0][0] = last ? vN[0][0] : vC[0][0]; v2[0][1] = last ? vN[0][1] : vC[0][1]; v2[1][0] = last ? vN[1][0] : vC[1][0]; v2[1][1] = last ? vN[1][1] : vC[1][1];
            const char* a1 = cA + (size_t)(t + 1) * kstep;
            const char* a2 = last ? nA : cA + (size_t)(t + 2) * kstep; const char* b2 = last ? nB : cB + (size_t)(t + 2) * kstep;
            const char* a3 = a2 + kstep; const char* b3 = b2 + kstep;
            if (last && has_next) S.a_ready(nxt);
            if constexpr (Epi::MIDK > 0) { if (t == Epi::MIDK) E.mid(acc, cur, wr, wc, fr, fq); }
            if constexpr (SP2) {
            PG8_LDB(B0, 0, 0); PG8_LDB(B1, 0, 1); PG8_SCHED; PG8_LDA(At, 0, 0); PG8_STAGE(PG8_SA(1, 1), a1, vC[1]);
            PG8_WAIT_V(8); PG8_WAIT_L(0); PG8_BAR; PG8_MMA(0, 0, At, B0); PG8_MMA(0, 1, At, B1); PG8_BAR; PG8_SCHED;
            PG8_LDA(At, 0, 1); PG8_STAGE(PG8_SB(0, 0), b2, voffB); PG8_STAGE(PG8_SB(0, 1), b2 + hstep, voffB); PG8_STAGE(PG8_SA(0, 0), a2, v2[0]);
            PG8_WAIT_V(8); PG8_WAIT_L(0); PG8_BAR; PG8_MMA(1, 0, At, B0); PG8_MMA(1, 1, At, B1); PG8_BAR; PG8_SCHED;
            PG8_LDB(B0, 1, 0); PG8_LDB(B1, 1, 1); PG8_SCHED; PG8_LDA(At, 1, 0); PG8_STAGE(PG8_SA(0, 1), a2, v2[1]);
            PG8_WAIT_V(8); PG8_WAIT_L(0); PG8_BAR; PG8_MMA(0, 0, At, B0); PG8_MMA(0, 1, At, B1); PG8_BAR; PG8_SCHED;
            PG8_LDA(At, 1, 1); PG8_STAGE(PG8_SB(1, 0), b3, voffB); PG8_STAGE(PG8_SB(1, 1), b3 + hstep, voffB); PG8_STAGE(PG8_SA(1, 0), a3, v2[0]);
            PG8_WAIT_V(8); PG8_WAIT_L(0); PG8_BAR; PG8_MMA(1, 0, At, B0); PG8_MMA(1, 1, At, B1); PG8_BAR; PG8_SCHED;
            } else {
            PG8_LDB(B0, 0, 0); PG8_SCHED; PG8_LDA(At, 0, 0); PG8_STAGE(PG8_SA(1, 1), a1, vC[1]);
            PG8_WAIT_L(8); PG8_BAR; PG8_WAIT_L(0); PG8_MMA(0, 0, At, B0); PG8_BAR; PG8_SCHED;
            PG8_LDB(B1, 0, 1); PG8_STAGE(PG8_SB(0, 0), b2, voffB);
            PG8_BAR; PG8_WAIT_L(0); PG8_MMA(0, 1, At, B1); PG8_BAR;
            PG8_LDA(At, 0, 1); PG8_STAGE(PG8_SA(0, 0), a2, v2[0]);
            PG8_BAR; PG8_WAIT_L(0); PG8_MMA(1, 0, At, B0); PG8_BAR; PG8_SCHED;
            PG8_STAGE(PG8_SB(0, 1), b2 + hstep, voffB);
            PG8_WAIT_V(6); PG8_BAR; PG8_MMA(1, 1, At, B1); PG8_BAR;
            PG8_LDB(B0, 1, 0); PG8_SCHED; PG8_LDA(At, 1, 0); PG8_STAGE(PG8_SA(0, 1), a2, v2[1]);
            PG8_WAIT_L(8); PG8_BAR; PG8_WAIT_L(0); PG8_MMA(0, 0, At, B0); PG8_BAR; PG8_SCHED;
            PG8_LDB(B1, 1, 1); PG8_STAGE(PG8_SB(1, 0), b3, voffB);
            PG8_BAR; PG8_WAIT_L(0); PG8_MMA(0, 1, At, B1); PG8_BAR;
            PG8_LDA(At, 1, 1); PG8_STAGE(PG8_SA(1, 0), a3, v2[0]);
            PG8_BAR; PG8_WAIT_L(0); PG8_MMA(1, 0, At, B0); PG8_BAR; PG8_SCHED;
            PG8_STAGE(PG8_SB(1, 1), b3 + hstep, voffB);
            PG8_WAIT_V(6); PG8_BAR; PG8_MMA(1, 1, At, B1); PG8_BAR;
            }
        }
        if constexpr (ALIGN_EPI) { if (wr == 0) PG8_BAR; }
        if constexpr (!Epi::AFTER_DRAIN) { E(acc, cur, wr, wc, fr, fq); S.done(cur); }
        if (!has_next) break;
#pragma unroll
        for (int a = 0; a < 2; ++a)
#pragma unroll
            for (int b = 0; b < 2; ++b)
#pragma unroll
                for (int m = 0; m < 4; ++m)
#pragma unroll
                    for (int n = 0; n < 2; ++n) acc[a][b][m][n] = (f32x4){0.f, 0.f, 0.f, 0.f};
        cur = nxt; cA = nA; cB = nB; ++ui; vC[0][0] = vN[0][0]; vC[0][1] = vN[0][1]; vC[1][0] = vN[1][0]; vC[1][1] = vN[1][1];
        if constexpr (ALIGN_EPI) { if (wr == 1) PG8_BAR; }
    }
    PG8_WAIT_V(0);
    if constexpr (!ALIGN_EPI) { if (wr == 0) PG8_BAR; }
    PG8_BAR;
    if constexpr (Epi::AFTER_DRAIN) { E.fused(acc, cur, wr, wc, fr, fq, lds, wid, lane); S.done(cur); }
#undef PG8_SA
#undef PG8_SB
#undef PG8_STAGE
#undef PG8_LDA
#undef PG8_LDB
#undef PG8_MMA
#undef PG8_WAIT_V
#undef PG8_WAIT_L
#undef PG8_BAR
#undef PG8_SCHED
}

__device__ __forceinline__ u32x4 pack8(const f32x4 v0, const f32x4 v1) { u32x4 w; w.x = cvt_pk_bf16(v0[0], v0[1]); w.y = cvt_pk_bf16(v0[2], v0[3]); w.z = cvt_pk_bf16(v1[0], v1[1]); w.w = cvt_pk_bf16(v1[2], v1[3]); return w; }
__device__ __forceinline__ f32x4 sig4(const f32x4 v) { return (f32x4){fsig(v[0]), fsig(v[1]), fsig(v[2]), fsig(v[3])}; }

struct EpiProj {
    static constexpr bool PERM = true, AFTER_DRAIN = false; static constexpr int MIDK = 0;
    const float* rstd; bf16_t *vglu, *qb, *kvb, *sgc, *sga; float qscale;
    __device__ __forceinline__ void operator()(const f32x4 (&acc)[2][2][4][2], const Unit& u, int wr, int wc, int fr, int fq) const {
        const int pn = __builtin_amdgcn_readfirstlane(u.pn); const int coff = wc * 32 + 8 * fq; const int row0 = u.pm * BM + wr * 64 + fr;
#pragma unroll
        for (int ai = 0; ai < 2; ++ai)
#pragma unroll
            for (int m = 0; m < 4; ++m) {
                const int r = row0 + ai * HALF + m * 16; const float s = rstd[r];
                const f32x4 a0 = acc[ai][0][m][0] * s, a1 = acc[ai][0][m][1] * s, b0 = acc[ai][1][m][0] * s, b1 = acc[ai][1][m][1] * s;
                if (pn < 4) {
                    *(u32x4*)(vglu + (size_t)r * CC + 128 * pn + coff) = pack8(a0 * sig4(b0), a1 * sig4(b1));
                } else if (pn < 6) {
                    bf16_t* qp = qb + (size_t)r * QD + 256 * (pn - 4) + coff;
                    *(u32x4*)qp = pack8(a0 * qscale, a1 * qscale); *(u32x4*)(qp + HALF) = pack8(b0 * qscale, b1 * qscale);
                } else if (pn == 6) {
                    bf16_t* kp = kvb + (size_t)r * 256 + coff;
                    *(u32x4*)kp = pack8(a0, a1); *(u32x4*)(kp + HALF) = pack8(b0, b1);
                } else {
                    const size_t o = (size_t)r * D + 128 * (pn - 7) + coff;
                    const f32x4 s0 = sig4(b0), s1 = sig4(b1);
                    *(u32x4*)(sgc + o) = pack8(sig4(a0) / s0, sig4(a1) / s1); *(u32x4*)(sga + o) = pack8(s0, s1);
                }
            }
    }
};
struct EpiMerge {
    static constexpr bool PERM = true, AFTER_DRAIN = false; static constexpr int MIDK = 8;
    const bf16_t* R; const bf16_t* G; bf16_t* O;
    __device__ __forceinline__ void mid(f32x4 (&acc)[2][2][4][2], const Unit& u, int wr, int wc, int fr, int fq) const {
        const char* Rb = (const char*)R + (size_t)u.pm * BM * D * 2;
        const unsigned ob = (unsigned)((wr * 64 + opaque_i(fr)) * D + u.pn * BM + wc * 32 + 8 * fq) * 2u;
#pragma unroll
        for (int ai = 0; ai < 2; ++ai)
#pragma unroll
            for (int m = 0; m < 4; ++m) {
#pragma unroll
                for (int bj = 0; bj < 2; ++bj) { const u32x4 g = *(const u32x4*)(Rb + (ob + (unsigned)(((ai * HALF + m * 16) * D + bj * HALF) * 2)));
                    acc[ai][bj][m][0] *= (f32x4){bf_lo(g.x), bf_hi(g.x), bf_lo(g.y), bf_hi(g.y)}; acc[ai][bj][m][1] *= (f32x4){bf_lo(g.z), bf_hi(g.z), bf_lo(g.w), bf_hi(g.w)}; }
                if (m == 3) asm volatile("" ::: "memory");
            }
    }
    __device__ __forceinline__ void operator()(const f32x4 (&acc)[2][2][4][2], const Unit& u, int wr, int wc, int fr, int fq) const {
        const int row0 = u.pm * BM + wr * 64 + opaque_i(fr), col0 = u.pn * BM + wc * 32 + 8 * fq;
#pragma unroll
        for (int ai = 0; ai < 2; ++ai)
#pragma unroll
            for (int m = 0; m < 4; ++m) {
                const size_t o = (size_t)(row0 + ai * HALF + m * 16) * D + col0;
#pragma unroll
                for (int bj = 0; bj < 2; ++bj) { const u32x4 g = *(const u32x4*)(G + o + bj * HALF);
                    *(u32x4*)(O + o + bj * HALF) = pack8(acc[ai][bj][m][0] * (f32x4){bf_lo(g.x), bf_hi(g.x), bf_lo(g.y), bf_hi(g.y)}, acc[ai][bj][m][1] * (f32x4){bf_lo(g.z), bf_hi(g.z), bf_lo(g.w), bf_hi(g.w)}); }
                if (m & 1) asm volatile("" ::: "memory");
            }
    }
};
struct EpiResid {
    static constexpr bool PERM = false, AFTER_DRAIN = false; static constexpr int MIDK = 0;
    const float* X; float* H;
    __device__ __forceinline__ void operator()(const f32x4 (&acc)[2][2][4][2], const Unit& u, int wr, int wc, int fr, int fq) const {
        const int row0 = u.pm * BM + wr * 64 + fr, col0 = u.pn * BM + wc * 32 + 4 * fq;
#pragma unroll
        for (int ai = 0; ai < 2; ++ai)
#pragma unroll
            for (int m = 0; m < 4; ++m) {
                const size_t o = (size_t)(row0 + ai * HALF + m * 16) * D + col0;
#pragma unroll
                for (int bj = 0; bj < 2; ++bj)
#pragma unroll
                    for (int n = 0; n < 2; ++n) *(f32x4*)(H + o + bj * HALF + n * 16) = *(const f32x4*)(X + o + bj * HALF + n * 16) + acc[ai][bj][m][n];
                if (m & 1) asm volatile("" ::: "memory");
            }
    }
};
}


constexpr size_t MiB = 1u << 20;
constexpr size_t WS_CTL = 0, CTL_BYTES = 1 * MiB;
constexpr size_t WS_WT_IN = 2 * MiB;
constexpr size_t WS_WT_MIX = 10 * MiB;
constexpr size_t WS_WT_OUT = 12 * MiB;
constexpr size_t WS_WT_GU = 16 * MiB;
constexpr size_t WS_WT_D = 80 * MiB;
constexpr size_t WS_RSTD1 = 112 * MiB;
constexpr size_t WS_TOKE = 113 * MiB;
constexpr size_t WS_TOKR = 113 * MiB + 512 * 1024;
constexpr size_t WS_LTOK = 114 * MiB, WS_LRS = 118 * MiB, WS_LW = 122 * MiB;
constexpr size_t WS_XB = 128 * MiB;
constexpr size_t WS_MERGED = WS_XB;
constexpr size_t WS_VGLU = 192 * MiB;
constexpr size_t WS_QB = 224 * MiB;
constexpr size_t WS_HB = 192 * MiB;
constexpr size_t WS_KVB = 256 * MiB;
constexpr size_t WS_SGC = 272 * MiB, WS_SGA = 336 * MiB;
constexpr size_t WS_Y = 256 * MiB;
constexpr size_t WS_MIX = 400 * MiB;
constexpr size_t WS_HMID = 400 * MiB;
constexpr size_t WS_END = 472 * MiB;
constexpr int CAP = 32768;
constexpr int NSLOT = 2 * T + NE * 256;
static_assert(WS_Y + (size_t)NSLOT * D * 2 <= WS_MIX && WS_HMID + (size_t)NSLOT * DFF * 2 <= WS_END, "d_ws map");
constexpr int CW_BAR = 4096, CW_CNT = 16384;
constexpr int RING_BYTES = 131072, LDS_BYTES = 147456, MISC_OFF = LDS_BYTES - 128;
constexpr int MOE_TBL_OFF = RING_BYTES, MOE_MAXU = 8;
constexpr int MOE_UT_OFF = MOE_TBL_OFF + MOE_MAXU * 1024, MOE_NBP_OFF = MOE_UT_OFF + MOE_MAXU * 16, MOE_CNT_OFF = MOE_NBP_OFF + 160;
static_assert(MOE_CNT_OFF + 128 <= MISC_OFF, "LDS map");

#define XB_TMO      128
#define XB_XCNT(j)  (256  + 64 * (j))
#define XB_XSUB(j)  (1280 + 64 * (j))
#define XB_XGEN(j)  (2304 + 64 * (j))
#define XB_TOP      3328
#define XB_TOPGEN   3392
#define XCD_BAR_WORDS 3456
#define XB_SPIN_CAP (1u << 18)

__device__ __forceinline__ unsigned xb_ld(unsigned* p)              { return __hip_atomic_load(p, __ATOMIC_RELAXED, __HIP_MEMORY_SCOPE_AGENT); }
__device__ __forceinline__ unsigned xb_add(unsigned* p, unsigned v) { return __hip_atomic_fetch_add(p, v, __ATOMIC_RELAXED, __HIP_MEMORY_SCOPE_AGENT); }
__device__ __forceinline__ unsigned xb_xcc_id() { return (unsigned)__builtin_amdgcn_s_getreg((3 << 11) | 20) & 0xFu; }
#define XB_SPIN(cond, bar) do { unsigned _sp = 0; while (cond) { __builtin_amdgcn_s_sleep(1); \
    if ((++_sp & 255u) == 0u) { if (xb_ld(&(bar)[XB_TMO])) break; if (_sp > XB_SPIN_CAP) { atomicAdd(&(bar)[XB_TMO], 1u); break; } } } } while (0)

struct XcdBarrier { unsigned* bar; unsigned x; volatile LAS unsigned* st; bool leader; };

__device__ __forceinline__ XcdBarrier xcd_barrier_post(unsigned* bar, volatile LAS unsigned* st, bool wave0) {
    XcdBarrier b; b.bar = bar; b.x = xb_xcc_id(); b.st = st; b.leader = wave0;
    if (wave0 && lane_id_v() == 0) (void)xb_add(&bar[XB_XCNT(b.x)], 1u);
    return b;
}
__device__ __forceinline__ void xcd_barrier_complete(unsigned* bar, unsigned x, unsigned& nloc, unsigned& nx) {
    const unsigned G = gridDim.x * gridDim.y * gridDim.z;
    unsigned sum, cnt, mine, sp = 0u;
    for (;;) {
        sum = 0u; cnt = 0u; mine = 0u;
#pragma unroll
        for (unsigned j = 0; j < 16; ++j) { const unsigned c = xb_ld(&bar[XB_XCNT(j)]); sum += c; cnt += (c > 0u) ? 1u : 0u; mine = (j == x) ? c : mine; }
        if (sum == G) break;
        __builtin_amdgcn_s_sleep(1);
        if ((++sp & 255u) == 0u) { if (xb_ld(&bar[XB_TMO])) break; if (sp > XB_SPIN_CAP) { atomicAdd(&bar[XB_TMO], 1u); break; } }
    }
    nloc = mine > 0u ? mine : 1u; nx = cnt > 0u ? cnt : 1u;
}
__device__ __forceinline__ void xcd_barrier(const XcdBarrier& b) {
    asm volatile("s_waitcnt vmcnt(0)" ::: "memory");
    __syncthreads();
    if (b.leader && lane_id_v() == 0) {
        unsigned* bar = b.bar;
        __builtin_amdgcn_s_waitcnt(0);
        unsigned nloc = b.st[0], nx = b.st[1];
        if (nloc == 0u) { xcd_barrier_complete(bar, b.x, nloc, nx); b.st[0] = nloc; b.st[1] = nx; }
        const unsigned old = xb_add(&bar[XB_XSUB(b.x)], 1u);
        const unsigned gen = old / nloc;
        if (old + 1u == (gen + 1u) * nloc) {
            __builtin_amdgcn_fence(__ATOMIC_RELEASE, "agent");
            asm volatile("s_waitcnt vmcnt(0)" ::: "memory");
            const unsigned og = xb_add(&bar[XB_TOP], 1u);
            const unsigned tg = og / nx;
            if (og + 1u == (tg + 1u) * nx) xb_add(&bar[XB_TOPGEN], 1u);
            else XB_SPIN(xb_ld(&bar[XB_TOPGEN]) == tg, bar);
            __builtin_amdgcn_fence(__ATOMIC_ACQUIRE, "agent");
            xb_add(&bar[XB_XGEN(b.x)], 1u);
            asm volatile("s_waitcnt vmcnt(0)" ::: "memory");
        } else {
            XB_SPIN(xb_ld(&bar[XB_XGEN(b.x)]) == gen, bar);
            __builtin_amdgcn_fence(__ATOMIC_ACQUIRE, "agent");
            asm volatile("s_waitcnt vmcnt(0)" ::: "memory");
        }
    }
    __syncthreads();
}

struct Params {
    const float *x, *g_mix, *w_in, *w_dw, *b_dw, *ln_g, *ln_b, *sinks, *w_conv_out, *w_attn_out, *w_out, *g_ffn,
                *w_group, *b_group, *w_expert, *b_expert, *w_gate, *w_up, *w_down, *g_final;
    float* out; unsigned char* ws;
};
typedef const __attribute__((address_space(4))) Params CParams;

__device__ __forceinline__ void p0_transpose_item(const float* W, int ld, int srccol, int k0, const float* gain, bf16_t* WT, int K, int dstrow, LAS float* scr, int lane) {
    const int ksub = lane >> 3, n4 = (lane & 7) * 4;
    f32x4 v[8];
#pragma unroll
    for (int i = 0; i < 8; ++i) v[i] = *(const f32x4*)(W + (size_t)(k0 + 8 * i + ksub) * ld + srccol + n4);
    if (gain) {
#pragma unroll
        for (int i = 0; i < 8; ++i) v[i] *= gain[k0 + 8 * i + ksub]; }
#pragma unroll
    for (int i = 0; i < 8; ++i) { LAS float* d = scr + (8 * i + ksub) * 33 + n4; d[0] = v[i][0]; d[1] = v[i][1]; d[2] = v[i][2]; d[3] = v[i][3]; }
    asm volatile("s_waitcnt lgkmcnt(0)" ::: "memory");
    const int c = lane & 7;
#pragma unroll
    for (int j = 0; j < 4; ++j) { const int n = (lane >> 3) + 8 * j; const LAS float* s = scr + (8 * c) * 33 + n;
        u32x4 o; o.x = cvt_pk_bf16(s[0 * 33], s[1 * 33]); o.y = cvt_pk_bf16(s[2 * 33], s[3 * 33]); o.z = cvt_pk_bf16(s[4 * 33], s[5 * 33]); o.w = cvt_pk_bf16(s[6 * 33], s[7 * 33]);
        *(u32x4*)(WT + (size_t)(dstrow + n) * K + k0 + 8 * c) = o; }
    asm volatile("s_waitcnt lgkmcnt(0)" ::: "memory");
}
__device__ __forceinline__ int win_srccol(int np) {
    const int pn = np >> 8, bj = (np >> 7) & 1, o = np & 127;
    if (pn < 4) return (bj ? 512 : 0) + 128 * pn + o;
    if (pn < 6) return 1024 + 256 * (pn - 4) + 128 * bj + o;
    if (pn == 6) return (bj ? 1664 : 1536) + o;
    return (bj ? 2816 : 1792) + 128 * (pn - 7) + o;
}
__device__ __forceinline__ void p0_prologue(CParams& p, LAS unsigned char* lds, const int wave_s) {
    unsigned char* ws = p.ws;
    const int tidx = opaque_tid(wave_s), lane = tidx & 63, wave = tidx >> 6;
    LAS float* scr = (LAS float*)(lds + wave * 16384);
    const int gw = blockIdx.x * (NT / 64) + wave, NGW = gridDim.x * (NT / 64);
    bf16_t* wt_in = (bf16_t*)(ws + WS_WT_IN); bf16_t* wt_mix = (bf16_t*)(ws + WS_WT_MIX); bf16_t* wt_out = (bf16_t*)(ws + WS_WT_OUT);
    constexpr int I_IN = (D / 64) * (INC / 32), I_CO = (CC / 64) * (D / 32), I_AO = (QD / 64) * (D / 32), I_OUT = (D / 64) * (D / 32);
    constexpr int NITEMS = I_IN + I_CO + I_AO + I_OUT;
    for (int it = gw; it < NITEMS; it += NGW) {
        int r = it;
        if (r < I_IN) { const int nblk = INC / 32, kb = r / nblk, nb = r % nblk; p0_transpose_item(p.w_in, INC, win_srccol(32 * nb), 64 * kb, p.g_mix, wt_in, D, 32 * nb, scr, lane); continue; } r -= I_IN;
        if (r < I_CO) { const int nblk = D / 32, kb = r / nblk, nb = r % nblk; p0_transpose_item(p.w_conv_out, D, 32 * nb, 64 * kb, nullptr, wt_mix, D, 32 * nb, scr, lane); continue; } r -= I_CO;
        if (r < I_AO) { const int nblk = D / 32, kb = r / nblk, nb = r % nblk; p0_transpose_item(p.w_attn_out, D, 32 * nb, 64 * kb, nullptr, wt_mix + CC, D, 32 * nb, scr, lane); continue; } r -= I_AO;
        { const int nblk = D / 32, kb = r / nblk, nb = r % nblk; p0_transpose_item(p.w_out, D, 32 * nb, 64 * kb, nullptr, wt_out, D, 32 * nb, scr, lane); }
    }
    bf16_t* xb = (bf16_t*)(ws + WS_XB); float* rstd1 = (float*)(ws + WS_RSTD1);
    for (int m = gw; m < T; m += NGW) {
        const f32x4* xr = (const f32x4*)(p.x + (size_t)m * D) + lane;
        f32x4 v[4]; float s = 0.f;
#pragma unroll
        for (int j = 0; j < 4; ++j) { v[j] = xr[64 * j]; s += (v[j][0] * v[j][0] + v[j][1] * v[j][1]) + (v[j][2] * v[j][2] + v[j][3] * v[j][3]); }
        s = wave_sum(s);
        if (lane == 0) rstd1[m] = rsqrtf(s * (1.f / D) + EPS);
        u32x2* o = (u32x2*)(xb + (size_t)m * D) + lane;
#pragma unroll
        for (int j = 0; j < 4; ++j) { u32x2 w; w.x = cvt_pk_bf16(v[j][0], v[j][1]); w.y = cvt_pk_bf16(v[j][2], v[j][3]); o[64 * j] = w; }
    }
}

template <int N> __device__ __forceinline__ void red_step(float (&v)[16], int lane, int k) {
#pragma unroll
    for (int a = 0; a < N / 2; ++a) { const bool up = (lane & k) != 0; const float send = up ? v[a] : v[a + N / 2], keep = up ? v[a + N / 2] : v[a]; v[a] = keep + __shfl_xor(send, k); }
}
constexpr int CONV_ROWS = 64 + CW - 1;
__device__ __forceinline__ void conv_phase(CParams& p, const bf16_t* vglu, bf16_t* cact, LAS unsigned char* lds, const int wave_s) {
    const int tid = opaque_tid(wave_s), lane = tid & 63, wid = tid >> 6, cp = tid & 255, th = tid >> 8, wq = wid & 3;
    float w0[CW], w1[CW];
#pragma unroll
    for (int j = 0; j < CW; ++j) { w0[j] = p.w_dw[j * CC + 2 * cp]; w1[j] = p.w_dw[j * CC + 2 * cp + 1]; }
    const float bi0 = p.b_dw[2 * cp], bi1 = p.b_dw[2 * cp + 1], lg0 = p.ln_g[2 * cp], lg1 = p.ln_g[2 * cp + 1], lb0 = p.ln_b[2 * cp], lb1 = p.ln_b[2 * cp + 1];
    LAS unsigned char* Vs = lds;
    LAS float* red = (LAS float*)(lds + CONV_ROWS * 1024);
    for (int cb = blockIdx.x; cb < T / 64; cb += gridDim.x) {
        const int t0 = cb * 64, seq0 = (t0 / SEQ) * SEQ;
        __syncthreads();
        for (int c = tid; c < CONV_ROWS * 64; c += NT) {
            const int row = c >> 6, ch = c & 63, pos = t0 - (CW - 1) + row; u32x4 v = {0u, 0u, 0u, 0u};
            if (pos >= seq0) v = *(const u32x4*)(vglu + (size_t)pos * CC + ch * 8);
            *(LAS u32x4*)(Vs + row * 1024 + ch * 16) = v; }
        __syncthreads();
#pragma unroll 1
        for (int grp = 0; grp < 4; ++grp) {
            float y[8][2]; const int tok0 = 32 * th + 8 * grp;
#pragma unroll
            for (int i = 0; i < 8; ++i) { y[i][0] = bi0; y[i][1] = bi1; }
            { const LAS unsigned char* base = Vs + tok0 * 1024 + cp * 4;
#pragma unroll
                for (int r = 0; r < 8 + CW - 1; ++r) { const unsigned pr = *(const LAS unsigned*)(base + r * 1024); const float lo = bf_lo(pr), hi2 = bf_hi(pr);
#pragma unroll
                    for (int i = 0; i < 8; ++i) { const int j = r - i; if (j >= 0 && j < CW) { y[i][0] = fmaf(w0[j], lo, y[i][0]); y[i][1] = fmaf(w1[j], hi2, y[i][1]); } } } }
            float v[16];
#pragma unroll
            for (int i = 0; i < 8; ++i) { v[i] = y[i][0] + y[i][1]; v[8 + i] = y[i][0] * y[i][0] + y[i][1] * y[i][1]; }
            red_step<16>(v, lane, 32); red_step<8>(v, lane, 16); red_step<4>(v, lane, 8); red_step<2>(v, lane, 4);
            float tot = v[0]; tot += __shfl_xor(tot, 2); tot += __shfl_xor(tot, 1);
            const int idx = ((lane >> 5) & 1) * 8 + ((lane >> 4) & 1) * 4 + ((lane >> 3) & 1) * 2 + ((lane >> 2) & 1);
            LAS float* rb = red + (grp & 1) * 128;
            if ((lane & 3) == 0) rb[(th * 4 + wq) * 16 + idx] = tot;
            __syncthreads();
#pragma unroll
            for (int i = 0; i < 8; ++i) {
                float S = 0.f, Q = 0.f;
#pragma unroll
                for (int q = 0; q < 4; ++q) { S += rb[(th * 4 + q) * 16 + i]; Q += rb[(th * 4 + q) * 16 + 8 + i]; }
                const float mean = S * (1.f / CC), var = Q * (1.f / CC) - mean * mean, rstd = rsqrtf(fmaxf(var, 0.f) + EPS);
                float z0 = (y[i][0] - mean) * rstd * lg0 + lb0, z1 = (y[i][1] - mean) * rstd * lg1 + lb1;
                z0 *= fsig(z0); z1 *= fsig(z1);
                *(unsigned*)(cact + (size_t)(t0 + tok0 + i) * D + 2 * cp) = cvt_pk_bf16(z0, z1);
            }
        }
    }
}

__device__ __forceinline__ int crow(int r, int hi) { return (r & 3) + 8 * (r >> 2) + 4 * hi; }
constexpr int ATT_KS = 144, ATT_VT = 400, ATT_VT_OFF = 192 * ATT_KS;
__device__ __forceinline__ void attn_phase(CParams& p, const bf16_t* qb, const bf16_t* kvb, bf16_t* att, LAS unsigned char* lds, const int wave_s) {
    const int tid = opaque_tid(wave_s), lane = tid & 63, wid = __builtin_amdgcn_readfirstlane(tid >> 6), r32 = lane & 31, hi = lane >> 5, g = wid & 3, w2 = wid >> 2;
    LAS unsigned char* Ks = lds; LAS unsigned char* Vt = lds + ATT_VT_OFF;
    for (int u = blockIdx.x; u < (T / 64) * 2; u += gridDim.x) {
        const int qblk = u >> 1, kvh = u & 1, t0 = qblk * 64, seq0 = (t0 / SEQ) * SEQ, kpos0 = t0 - 128, h = kvh * 4 + g;
        __syncthreads();
        for (int c = tid; c < 192 * 8; c += NT) {
            const int row = c >> 3, ch = c & 7, pos = kpos0 + row; u32x4 kk = {0u, 0u, 0u, 0u}, vv = {0u, 0u, 0u, 0u};
            if (pos >= seq0) { const bf16_t* src = kvb + (size_t)pos * 256 + kvh * HD + ch * 8; kk = *(const u32x4*)src; vv = *(const u32x4*)(src + 128); }
            *(LAS u32x4*)(Ks + row * ATT_KS + ch * 16) = kk;
            LAS bf16_t* vt = (LAS bf16_t*)(Vt + (ch * 8) * ATT_VT) + row;
            vt[0 * (ATT_VT / 2)] = (bf16_t)(vv.x & 0xffffu); vt[1 * (ATT_VT / 2)] = (bf16_t)(vv.x >> 16); vt[2 * (ATT_VT / 2)] = (bf16_t)(vv.y & 0xffffu); vt[3 * (ATT_VT / 2)] = (bf16_t)(vv.y >> 16);
            vt[4 * (ATT_VT / 2)] = (bf16_t)(vv.z & 0xffffu); vt[5 * (ATT_VT / 2)] = (bf16_t)(vv.z >> 16); vt[6 * (ATT_VT / 2)] = (bf16_t)(vv.w & 0xffffu); vt[7 * (ATT_VT / 2)] = (bf16_t)(vv.w >> 16);
        }
        __syncthreads();
        const int tw = t0 + 32 * w2;
        bf16x8 qf[4]; { const bf16_t* qp = qb + (size_t)(tw + r32) * QD + h * HD + hi * 8;
#pragma unroll
            for (int ks = 0; ks < 4; ++ks) qf[ks] = *(const bf16x8*)(qp + ks * 16); }
        f32x16 pt[5];
#pragma unroll
        for (int jj = 0; jj < 5; ++jj) { f32x16 a = {0.f, 0.f, 0.f, 0.f, 0.f, 0.f, 0.f, 0.f, 0.f, 0.f, 0.f, 0.f, 0.f, 0.f, 0.f, 0.f};
            const LAS unsigned char* kp = Ks + (32 * (w2 + jj) + r32) * ATT_KS + hi * 16;
#pragma unroll
            for (int ks = 0; ks < 4; ++ks) { const bf16x8 kf = *(const LAS bf16x8*)(kp + ks * 32); a = __builtin_amdgcn_mfma_f32_32x32x16_bf16(kf, qf[ks], a, 0, 0, 0); }
            pt[jj] = a; __builtin_amdgcn_sched_barrier(0); }
        const float slope2 = exp2f(-(float)(h + 1)) * LOG2E, sink2 = p.sinks[h] * LOG2E;
        const int kmin = seq0 - (tw - 128); const int r32o = opaque_i(r32), hio = opaque_i(hi);
        float m = sink2;
#pragma unroll
        for (int jj = 0; jj < 5; ++jj)
#pragma unroll
            for (int r = 0; r < 16; ++r) { const int kw = 32 * jj + crow(r, hio), rel = 128 + r32o - kw; const bool valid = (kw > r32o) && (kw <= r32o + 128) && (kw >= kmin);
                const float s = valid ? pt[jj][r] - slope2 * (float)rel : -INFINITY; pt[jj][r] = s; m = fmaxf(m, s); }
        m = fmaxf(m, __shfl_xor(m, 32));
        float l = 0.f;
#pragma unroll
        for (int jj = 0; jj < 5; ++jj)
#pragma unroll
            for (int r = 0; r < 16; ++r) { const float e = __builtin_amdgcn_exp2f(pt[jj][r] - m); pt[jj][r] = e; l += e; }
        l += __shfl_xor(l, 32); l += __builtin_amdgcn_exp2f(sink2 - m);
        f32x16 o0 = {0.f, 0.f, 0.f, 0.f, 0.f, 0.f, 0.f, 0.f, 0.f, 0.f, 0.f, 0.f, 0.f, 0.f, 0.f, 0.f}, o1 = o0;
#pragma unroll
        for (int jj = 0; jj < 5; ++jj)
#pragma unroll
            for (int s2 = 0; s2 < 2; ++s2) {
                u32x4 pw; pw.x = cvt_pk_bf16(pt[jj][8 * s2 + 0], pt[jj][8 * s2 + 1]); pw.y = cvt_pk_bf16(pt[jj][8 * s2 + 2], pt[jj][8 * s2 + 3]);
                pw.z = cvt_pk_bf16(pt[jj][8 * s2 + 4], pt[jj][8 * s2 + 5]); pw.w = cvt_pk_bf16(pt[jj][8 * s2 + 6], pt[jj][8 * s2 + 7]);
                const bf16x8 pf = __builtin_bit_cast(bf16x8, pw);
                const LAS unsigned char* vp = Vt + r32 * ATT_VT + (32 * (w2 + jj) + 16 * s2 + 4 * hi) * 2;
                const u32x2 a0 = *(const LAS u32x2*)vp, a1 = *(const LAS u32x2*)(vp + 16), b0 = *(const LAS u32x2*)(vp + 32 * ATT_VT), b1 = *(const LAS u32x2*)(vp + 32 * ATT_VT + 16);
                const bf16x8 vf0 = __builtin_bit_cast(bf16x8, (u32x4){a0.x, a0.y, a1.x, a1.y}), vf1 = __builtin_bit_cast(bf16x8, (u32x4){b0.x, b0.y, b1.x, b1.y});
                o0 = __builtin_amdgcn_mfma_f32_32x32x16_bf16(vf0, pf, o0, 0, 0, 0); o1 = __builtin_amdgcn_mfma_f32_32x32x16_bf16(vf1, pf, o1, 0, 0, 0);
                __builtin_amdgcn_sched_barrier(0);
            }
        const float inv = 1.f / l;
        bf16_t* op = att + (size_t)(tw + r32) * D + h * HD + 4 * hi;
#pragma unroll
        for (int rg = 0; rg < 4; ++rg) {
            u32x2 w0, w1; w0.x = cvt_pk_bf16(o0[4 * rg] * inv, o0[4 * rg + 1] * inv); w0.y = cvt_pk_bf16(o0[4 * rg + 2] * inv, o0[4 * rg + 3] * inv);
            w1.x = cvt_pk_bf16(o1[4 * rg] * inv, o1[4 * rg + 1] * inv); w1.y = cvt_pk_bf16(o1[4 * rg + 2] * inv, o1[4 * rg + 3] * inv);
            *(u32x2*)(op + 8 * rg) = w0; *(u32x2*)(op + 32 + 8 * rg) = w1; }
    }
}


__device__ __forceinline__ void p0_moe_weights(CParams& p, LAS unsigned char* lds, const int wave_s) {
    unsigned char* ws = p.ws;
    const int tidx = opaque_tid(wave_s), lane = tidx & 63, wave = tidx >> 6;
    LAS float* scr = (LAS float*)(lds + wave * 16384);
    const int gw = blockIdx.x * (NT / 64) + wave, NGW = gridDim.x * (NT / 64);
    bf16_t* wt_gu = (bf16_t*)(ws + WS_WT_GU); bf16_t* wt_d = (bf16_t*)(ws + WS_WT_D);
    constexpr int I_GU = (D / 64) * (1024 / 32), I_D = (DFF / 64) * (D / 32);
    for (int it = gw; it < NE * (I_GU + I_D); it += NGW) {
        const int e = it / (I_GU + I_D); int r = it % (I_GU + I_D);
        if (r < I_GU) { const int kb = r >> 5, nb = r & 31, np = 32 * nb, pn = np >> 8, bj = (np >> 7) & 1, o = np & 127;
            const float* W = (bj ? p.w_up : p.w_gate) + (size_t)e * D * DFF;
            p0_transpose_item(W, DFF, 128 * pn + o, 64 * kb, p.g_ffn, wt_gu + (size_t)e * 1024 * D, D, np, scr, lane); }
        else { r -= I_GU; const int kb = r >> 5, nb = r & 31;
            p0_transpose_item(p.w_down + (size_t)e * DFF * D, D, 32 * nb, 64 * kb, nullptr, wt_d + (size_t)e * D * DFF, DFF, 32 * nb, scr, lane); }
    }
}

constexpr int RT_WAVE = (64 * 36 + 32 * 32 + 32 * 4) * 4;
__device__ __forceinline__ void route_phase_fast(CParams& p, const float* H, bf16_t* hb, int* toke, int* tokr, int* ltok, float* lrs, float* lw, unsigned* gcount,
                                                 LAS unsigned char* lds, const int wave_s) {
    const int tid = opaque_tid(wave_s), lane = tid & 63, kq = wave_s & 3, tg = wave_s >> 2, r32 = lane & 31, hi = lane >> 5;
    LAS float* tile = (LAS float*)(lds + wave_s * RT_WAVE); LAS float* Wl = tile + 64 * 36; LAS float* Wgl = Wl + 32 * 32;
    LAS unsigned* hist = (LAS unsigned*)(lds + 8 * RT_WAVE);
    for (int task = blockIdx.x; task < T / 128; task += gridDim.x) {
        const int tok0 = task * 128 + tg * 64;
        if (tid < 32) hist[tid] = 0u;
        f32x16 acc0 = {0.f, 0.f, 0.f, 0.f, 0.f, 0.f, 0.f, 0.f, 0.f, 0.f, 0.f, 0.f, 0.f, 0.f, 0.f, 0.f}, acc1 = acc0;
        f32x4 ag = {0.f, 0.f, 0.f, 0.f}; float ss = 0.f;
        f32x4 hr[8], wr[4], wgr = {0.f, 0.f, 0.f, 0.f}; float gk[4], ggr = 0.f;
        const int rsub = lane >> 3, c4 = (lane & 7) * 4; const unsigned hoff = (unsigned)(rsub * D + c4) * 4u;
#define RT_LOAD(ch) do { const int k0_ = kq * 256 + (ch) * 32; \
            const char* hb_ = (const char*)(H + (size_t)tok0 * D + k0_); \
            _Pragma("unroll") for (int i = 0; i < 8; ++i) hr[i] = *(const f32x4*)(hb_ + (hoff + (unsigned)(8 * i * D * 4))); \
            _Pragma("unroll") for (int i = 0; i < 4; ++i) { const int i4 = i * 64 + lane; wr[i] = *(const f32x4*)(p.w_expert + (size_t)k0_ * NE + i4 * 4); gk[i] = p.g_ffn[k0_ + (i4 >> 3)]; } \
            if (lane < 32) { wgr = *(const f32x4*)(p.w_group + (size_t)(k0_ + lane) * NG); ggr = p.g_ffn[k0_ + lane]; } } while (0)
        RT_LOAD(0);
#pragma unroll 1
        for (int ch = 0; ch < 8; ++ch) {
            const int k0 = kq * 256 + ch * 32;
#pragma unroll
            for (int i = 0; i < 8; ++i) { const int row = 8 * i + rsub; u32x2 w; w.x = cvt_pk_bf16(hr[i][0], hr[i][1]); w.y = cvt_pk_bf16(hr[i][2], hr[i][3]);
                *(u32x2*)((char*)(hb + (size_t)tok0 * D + k0) + ((hoff >> 1) + (unsigned)(8 * i * D * 2))) = w; *(LAS f32x4*)(tile + row * 36 + c4) = hr[i]; }
#pragma unroll
            for (int i = 0; i < 4; ++i) *(LAS f32x4*)(Wl + (i * 64 + lane) * 4) = wr[i] * gk[i];
            if (lane < 32) *(LAS f32x4*)(Wgl + lane * 4) = wgr * ggr;
            if (ch + 1 < 8) RT_LOAD(ch + 1);
            float bv[16];
#pragma unroll
            for (int s2 = 0; s2 < 16; ++s2) bv[s2] = Wl[(16 * hi + s2) * 32 + r32];
#pragma unroll
            for (int tt = 0; tt < 2; ++tt) {
                f32x4 a4[4];
#pragma unroll
                for (int q = 0; q < 4; ++q) a4[q] = *(const LAS f32x4*)(tile + (32 * tt + r32) * 36 + 16 * hi + 4 * q);
#pragma unroll
                for (int s2 = 0; s2 < 16; ++s2) { if (tt == 0) acc0 = __builtin_amdgcn_mfma_f32_32x32x2f32(a4[s2 >> 2][s2 & 3], bv[s2], acc0, 0, 0, 0);
                                                  else acc1 = __builtin_amdgcn_mfma_f32_32x32x2f32(a4[s2 >> 2][s2 & 3], bv[s2], acc1, 0, 0, 0); }
            }
#pragma unroll
            for (int k4 = 0; k4 < 8; ++k4) { const f32x4 hv = *(const LAS f32x4*)(tile + lane * 36 + 4 * k4);
#pragma unroll
                for (int q = 0; q < 4; ++q) { const f32x4 wg = *(const LAS f32x4*)(Wgl + (4 * k4 + q) * 4); ag += wg * hv[q]; ss = fmaf(hv[q], hv[q], ss); } }
        }
#undef RT_LOAD
#pragma unroll
        for (int r = 0; r < 16; ++r) { const int cr = (r & 3) + 8 * (r >> 2) + 4 * hi; tile[cr * 37 + 4 + r32] = acc0[r]; tile[(32 + cr) * 37 + 4 + r32] = acc1[r]; }
        tile[lane * 37 + 0] = ag[0]; tile[lane * 37 + 1] = ag[1]; tile[lane * 37 + 2] = ag[2]; tile[lane * 37 + 3] = ag[3]; tile[lane * 37 + 36] = ss;
        __syncthreads();
        int ea = 0, eb = 0; unsigned ra = 0u, rb = 0u; float w1 = 0.f, w2 = 0.f, rstd = 0.f;
        if (kq == 0) {
            float lg[NG + NE]; float s2 = 0.f;
#pragma unroll
            for (int e = 0; e < NG + NE; ++e) lg[e] = 0.f;
#pragma unroll
            for (int q = 0; q < 4; ++q) { const LAS float* pt = (const LAS float*)(lds + (tg * 4 + q) * RT_WAVE) + lane * 37;
#pragma unroll
                for (int e = 0; e < NG + NE; ++e) lg[e] += pt[e];
                s2 += pt[36]; }
            rstd = rsqrtf(s2 * (1.f / D) + EPS);
            float gl[NG]; float gmax = -INFINITY; int gsel = 0;
#pragma unroll
            for (int g = 0; g < NG; ++g) { gl[g] = lg[g] * rstd + p.b_group[g]; if (gl[g] > gmax) { gmax = gl[g]; gsel = g; } }
            float gden = 0.f;
#pragma unroll
            for (int g = 0; g < NG; ++g) gden += __expf(gl[g] - gmax);
            const float pg = 1.f / gden;
            float v1 = -INFINITY, v2 = -INFINITY; int i1 = 0, i2 = 0;
#pragma unroll
            for (int g = 0; g < NG; ++g) if (g == gsel) {
#pragma unroll
                for (int j = 0; j < EPG; ++j) { const float val = lg[4 + g * EPG + j] * rstd + p.b_expert[g * EPG + j];
                    if (val > v1) { v2 = v1; i2 = i1; v1 = val; i1 = j; } else if (val > v2) { v2 = val; i2 = j; } }
            }
            const float e2 = __expf(v2 - v1); w1 = pg / (1.f + e2); w2 = pg * e2 / (1.f + e2);
            ea = gsel * EPG + i1; eb = gsel * EPG + i2;
            ra = __hip_atomic_fetch_add(hist + ea, 1u, __ATOMIC_RELAXED, __HIP_MEMORY_SCOPE_WORKGROUP);
            rb = __hip_atomic_fetch_add(hist + eb, 1u, __ATOMIC_RELAXED, __HIP_MEMORY_SCOPE_WORKGROUP);
        }
        __syncthreads();
        { const int t2 = opaque_i(tid); if (t2 < 32) hist[32 + t2] = __hip_atomic_fetch_add(gcount + t2, hist[t2], __ATOMIC_RELAXED, __HIP_MEMORY_SCOPE_AGENT); }
        __syncthreads();
        if (kq == 0) {
            const int tok = tok0 + lane; const unsigned pa = hist[32 + ea] + ra, pb = hist[32 + eb] + rb;
            ltok[(size_t)ea * CAP + pa] = tok; lrs[(size_t)ea * CAP + pa] = rstd; lw[(size_t)ea * CAP + pa] = w1;
            ltok[(size_t)eb * CAP + pb] = tok; lrs[(size_t)eb * CAP + pb] = rstd; lw[(size_t)eb * CAP + pb] = w2;
            toke[2 * tok] = ea; toke[2 * tok + 1] = eb; tokr[2 * tok] = (int)pa; tokr[2 * tok + 1] = (int)pb;
        }
        __syncthreads();
    }
}

__device__ __forceinline__ void moe_build_map(const unsigned* gcount, LAS unsigned char* lds, int tid) {
    LAS int* nbp = (LAS int*)(lds + MOE_NBP_OFF); LAS int* cnt = (LAS int*)(lds + MOE_CNT_OFF);
    __syncthreads();
    if (tid < 64) {
        const int c = tid < NE ? (int)__hip_atomic_load(gcount + (tid & 31), __ATOMIC_RELAXED, __HIP_MEMORY_SCOPE_AGENT) : 0;
        int x = (c + 255) >> 8;
#pragma unroll
        for (int o = 1; o < 32; o <<= 1) { const int t = __shfl_up(x, o); if ((tid & 63) >= o) x += t; }
        if (tid < NE) { cnt[tid] = c; nbp[tid + 1] = x; }
        if (tid == 0) nbp[0] = 0;
    }
    __syncthreads();
}
__device__ __forceinline__ void moe_unit_of(int i, int G, int c, int& blk, int& pn) {
    if ((G & 31) == 0) { const int w = c >> 3; blk = i * (G >> 2) + (c & 7) * (G >> 5) + (w >> 2); pn = w & 3; }
    else { const int L = i * G + c; blk = L >> 2; pn = L & 3; }
}
__device__ __forceinline__ void moe_build_units(const int* ltok, LAS unsigned char* lds, int G, int c, int tid, bool gather) {
    const LAS int* nbp = (const LAS int*)(lds + MOE_NBP_OFF); const LAS int* cnt = (const LAS int*)(lds + MOE_CNT_OFF);
    LAS int* ut = (LAS int*)(lds + MOE_UT_OFF); LAS unsigned* tbl = (LAS unsigned*)(lds + MOE_TBL_OFF);
    const int nunits = nbp[NE] * 4;
    for (int i = 0; i < MOE_MAXU; ++i) {
        int blk, pnn; moe_unit_of(i, G, c, blk, pnn); if (blk * 4 >= nunits) continue;
        int e = 0;
        for (int j = 1; j < NE; ++j) if (blk >= nbp[j]) e = j;
        const int rb = blk - nbp[e];
        if (tid == 0) { ut[4 * i] = e; ut[4 * i + 1] = blk; ut[4 * i + 2] = pnn; ut[4 * i + 3] = rb * 256; }
        if (gather && tid < 256) { const int rank = rb * 256 + tid; tbl[i * 256 + tid] = rank < cnt[e] ? (unsigned)ltok[(size_t)e * CAP + rank] * (unsigned)(D * 2) : 0u; }
    }
    __syncthreads();
}
namespace pg8 {
struct MoeSched {
    const LAS int* ut; const LAS unsigned* tbl; const LAS int* nbp; const char* A; const char* Bt; int G, c, K; bool gather;
    __device__ __forceinline__ bool next(int i, Unit& u) const {
        const int nunits = __builtin_amdgcn_readfirstlane(nbp[NE]) * 4;
        if (i >= MOE_MAXU) return false;
        { int blk_, pn_; moe_unit_of(i, G, c, blk_, pn_); if (blk_ * 4 >= nunits) return false; }
        const int e = __builtin_amdgcn_readfirstlane(ut[4 * i]), blk = __builtin_amdgcn_readfirstlane(ut[4 * i + 1]), pn = __builtin_amdgcn_readfirstlane(ut[4 * i + 2]), r0 = __builtin_amdgcn_readfirstlane(ut[4 * i + 3]);
        u.pm = blk; u.pn = pn; u.aux = e; u.rank0 = r0;
        u.a = gather ? A : A + (size_t)blk * 256 * K * 2;
        u.b = Bt + ((size_t)e * 1024 + (size_t)pn * 256) * K * 2;
        return true;
    }
    __device__ __forceinline__ void a_voff(const Unit&, int ui, int tid, int K_, unsigned (&v)[2][2]) const {
#pragma unroll
        for (int i = 0; i < 2; ++i) { int R, C; stage_rc(tid * 16 + i * 8192, R, C);
            if (gather) { v[0][i] = tbl[ui * 256 + R] + (unsigned)C * 2u; v[1][i] = tbl[ui * 256 + HALF + R] + (unsigned)C * 2u; }
            else { v[0][i] = (unsigned)(R * K_ + C) * 2u; v[1][i] = (unsigned)((HALF + R) * K_ + C) * 2u; } }
    }
    __device__ __forceinline__ void a_ready(const Unit&) const {}
    __device__ __forceinline__ void done(const Unit&) const {}
};
struct EpiSwiglu {
    static constexpr bool PERM = true, AFTER_DRAIN = false; static constexpr int MIDK = 0;
    const float* lrs; const LAS int* cnt; bf16_t* hmid;
    __device__ __forceinline__ void operator()(const f32x4 (&acc)[2][2][4][2], const Unit& u, int wr, int wc, int fr, int fq) const {
        const int e = u.aux, n = __builtin_amdgcn_readfirstlane(cnt[e]); const int coff = wc * 32 + 8 * fq;
#pragma unroll
        for (int ai = 0; ai < 2; ++ai)
#pragma unroll
            for (int m = 0; m < 4; ++m) {
                const int ri = ai * HALF + wr * 64 + m * 16 + fr, rank = u.rank0 + ri; const float s = rank < n ? lrs[(size_t)e * CAP + rank] : 0.f;
                const f32x4 a0 = acc[ai][0][m][0] * s, a1 = acc[ai][0][m][1] * s, b0 = acc[ai][1][m][0] * s, b1 = acc[ai][1][m][1] * s;
                *(u32x4*)(hmid + (size_t)(u.pm * 256 + ri) * DFF + 128 * u.pn + coff) = pack8(a0 * sig4(a0) * b0, a1 * sig4(a1) * b1);
            }
    }
};
struct EpiDown {
    static constexpr bool PERM = true, AFTER_DRAIN = false; static constexpr int MIDK = 0;
    const float* lw; const LAS int* cnt; bf16_t* y;
    __device__ __forceinline__ void operator()(const f32x4 (&acc)[2][2][4][2], const Unit& u, int wr, int wc, int fr, int fq) const {
        const int e = u.aux, n = __builtin_amdgcn_readfirstlane(cnt[e]); const int col0 = u.pn * BM + wc * 32 + 8 * fq;
#pragma unroll
        for (int ai = 0; ai < 2; ++ai)
#pragma unroll
            for (int m = 0; m < 4; ++m) {
                const int ri = ai * HALF + wr * 64 + m * 16 + fr, rank = u.rank0 + ri; const float s = rank < n ? lw[(size_t)e * CAP + rank] : 0.f;
                bf16_t* yp = y + (size_t)(u.pm * 256 + ri) * D + col0;
                *(u32x4*)yp = pack8(acc[ai][0][m][0] * s, acc[ai][0][m][1] * s); *(u32x4*)(yp + HALF) = pack8(acc[ai][1][m][0] * s, acc[ai][1][m][1] * s);
            }
    }
};
}

__device__ __forceinline__ void final_phase(CParams& p, const float* H, const bf16_t* y, const int* toke, const int* tokr, float* outp, LAS unsigned char* lds, const int wave_s) {
    const int tidx = opaque_tid(wave_s), lane = tidx & 63, gw = blockIdx.x * (NT / 64) + (tidx >> 6), NGW = gridDim.x * (NT / 64);
    const LAS int* nbp = (const LAS int*)(lds + MOE_NBP_OFF);
    for (int m = gw; m < T; m += NGW) {
        const int ea = toke[2 * m], eb = toke[2 * m + 1];
        const size_t sa = (size_t)nbp[ea] * 256 + tokr[2 * m], sb = (size_t)nbp[eb] * 256 + tokr[2 * m + 1];
        const f32x4* xr = (const f32x4*)(H + (size_t)m * D) + lane; const u32x2* ya = (const u32x2*)(y + sa * D) + lane; const u32x2* yb = (const u32x2*)(y + sb * D) + lane;
        f32x4 v[4]; float s = 0.f;
#pragma unroll
        for (int j = 0; j < 4; ++j) { const u32x2 a = ya[64 * j], b = yb[64 * j];
            v[j] = xr[64 * j] + (f32x4){bf_lo(a.x), bf_hi(a.x), bf_lo(a.y), bf_hi(a.y)} + (f32x4){bf_lo(b.x), bf_hi(b.x), bf_lo(b.y), bf_hi(b.y)};
            s += (v[j][0] * v[j][0] + v[j][1] * v[j][1]) + (v[j][2] * v[j][2] + v[j][3] * v[j][3]); }
        const float rstd = rsqrtf(wave_sum(s) * (1.f / D) + EPS);
        f32x4* o = (f32x4*)(outp + (size_t)m * D) + lane;
#pragma unroll
        for (int j = 0; j < 4; ++j) o[64 * j] = v[j] * rstd * ((const f32x4*)p.g_final)[lane + 64 * j];
    }
}


__global__ void __launch_bounds__(NT, 2) k_all(Params p_arg) {
    CParams* pp_ = (CParams*)__builtin_amdgcn_kernarg_segment_ptr(); asm volatile("" : "+s"(pp_)); CParams& p = *pp_;
    extern __shared__ __attribute__((aligned(16))) unsigned char lds_raw[];
    LAS unsigned char* lds = (LAS unsigned char*)lds_raw;
    volatile LAS unsigned* MISC = (volatile LAS unsigned*)(lds + MISC_OFF);
    const int wave_s = __builtin_amdgcn_readfirstlane((int)threadIdx.x >> 6);
    if (threadIdx.x < 32) MISC[threadIdx.x] = 0u;
    __syncthreads();
    unsigned char* ws = p.ws;
    unsigned* ctl = (unsigned*)(ws + WS_CTL);
    XcdBarrier bar = xcd_barrier_post(ctl + CW_BAR, MISC, wave_s == 0);
    const int G = gridDim.x;

    bf16_t* wt_in = (bf16_t*)(ws + WS_WT_IN); bf16_t* wt_mix = (bf16_t*)(ws + WS_WT_MIX); bf16_t* wt_out = (bf16_t*)(ws + WS_WT_OUT);
    bf16_t* xb = (bf16_t*)(ws + WS_XB); bf16_t* merged = (bf16_t*)(ws + WS_MERGED); float* rstd1 = (float*)(ws + WS_RSTD1);
    bf16_t* vglu = (bf16_t*)(ws + WS_VGLU); bf16_t* qb = (bf16_t*)(ws + WS_QB); bf16_t* kvb = (bf16_t*)(ws + WS_KVB);
    bf16_t* sgc = (bf16_t*)(ws + WS_SGC); bf16_t* sga = (bf16_t*)(ws + WS_SGA); bf16_t* mix = (bf16_t*)(ws + WS_MIX); bf16_t* cact = mix; bf16_t* att = mix + CC;
    float* H = p.out;

#ifndef ENABLE
#define ENABLE 0xff
#endif
#ifndef REPEAT
#define REPEAT 0
#endif
#define REP(k) _Pragma("unroll") for (int rep_ = 0; rep_ < 1 + ((REPEAT >> (k)) & 1); ++rep_)
    asm volatile("; PHASE_MARK 0");
    REP(0) if (ENABLE & 1) { p0_prologue(p, lds, wave_s); p0_moe_weights(p, lds, wave_s); }
    xcd_barrier(bar);
    asm volatile("; PHASE_MARK 1");
    REP(1) if (ENABLE & 2) { pg8::DenseSched S; S.init(xb, wt_in, T, INC, D, G, (int)blockIdx.x);
      pg8::EpiProj E{rstd1, vglu, qb, kvb, sgc, sga, 0.125f * LOG2E};
      pg8::gemm_phase<pg8::EpiProj, pg8::DenseSched, true, true>(lds, D, S, E, wave_s); }
    xcd_barrier(bar);
    asm volatile("; PHASE_MARK 2");
    REP(2) if (ENABLE & 4) conv_phase(p, vglu, cact, lds, wave_s);
    asm volatile("; PHASE_MARK 3");
    REP(3) if (ENABLE & 8) attn_phase(p, qb, kvb, att, lds, wave_s);
    xcd_barrier(bar);
    asm volatile("; PHASE_MARK 4");
    REP(4) if (ENABLE & 16) { pg8::DenseSched S; S.init(mix, wt_mix, T, D, D, G, (int)blockIdx.x);
      pg8::EpiMerge E{sgc, sga, merged};
      pg8::gemm_phase<pg8::EpiMerge, pg8::DenseSched, true, true>(lds, D, S, E, wave_s); }
    xcd_barrier(bar);
    asm volatile("; PHASE_MARK 6");
    REP(5) if (ENABLE & 32) { pg8::DenseSched S; S.init(merged, wt_out, T, D, D, G, (int)blockIdx.x);
      pg8::EpiResid E{p.x, H};
      pg8::gemm_phase<pg8::EpiResid, pg8::DenseSched, true, true>(lds, D, S, E, wave_s); }
    xcd_barrier(bar);
    bf16_t* hb = (bf16_t*)(ws + WS_HB); bf16_t* hmid = (bf16_t*)(ws + WS_HMID); bf16_t* y = (bf16_t*)(ws + WS_Y);
    int* toke = (int*)(ws + WS_TOKE); int* tokr = (int*)(ws + WS_TOKR); int* ltok = (int*)(ws + WS_LTOK); float* lrs = (float*)(ws + WS_LRS); float* lw = (float*)(ws + WS_LW);
    unsigned* gcount = ctl + CW_CNT;
    asm volatile("; PHASE_MARK 7");
    if ((REPEAT >> 7) & 1) { unsigned char* sc = ws + WS_XB;
        route_phase_fast(p, H, hb, (int*)(sc), (int*)(sc + 1 * MiB), (int*)(sc + 2 * MiB), (float*)(sc + 6 * MiB), (float*)(sc + 10 * MiB), gcount + 64, lds, wave_s); }
    route_phase_fast(p, H, hb, toke, tokr, ltok, lrs, lw, gcount, lds, wave_s);
    xcd_barrier(bar);
    asm volatile("; PHASE_MARK 8");
    REP(8) { const int tid = opaque_tid(wave_s);
      moe_build_map(gcount, lds, tid); moe_build_units(ltok, lds, G, (int)blockIdx.x, tid, true);
      pg8::MoeSched S{(const LAS int*)(lds + MOE_UT_OFF), (const LAS unsigned*)(lds + MOE_TBL_OFF), (const LAS int*)(lds + MOE_NBP_OFF), (const char*)hb, (const char*)(ws + WS_WT_GU), G, (int)blockIdx.x, D, true};
      pg8::EpiSwiglu E{lrs, (const LAS int*)(lds + MOE_CNT_OFF), hmid};
      pg8::gemm_phase<pg8::EpiSwiglu, pg8::MoeSched, true, true>(lds, D, S, E, wave_s); }
    xcd_barrier(bar);
    asm volatile("; PHASE_MARK 9");
    REP(9) { const int tid = opaque_tid(wave_s);
      moe_build_map(gcount, lds, tid); moe_build_units(ltok, lds, G, (int)blockIdx.x, tid, false);
      pg8::MoeSched S{(const LAS int*)(lds + MOE_UT_OFF), (const LAS unsigned*)(lds + MOE_TBL_OFF), (const LAS int*)(lds + MOE_NBP_OFF), (const char*)hmid, (const char*)(ws + WS_WT_D), G, (int)blockIdx.x, DFF, false};
      pg8::EpiDown E{lw, (const LAS int*)(lds + MOE_CNT_OFF), y};
      pg8::gemm_phase<pg8::EpiDown, pg8::MoeSched, true, true>(lds, DFF, S, E, wave_s); }
    xcd_barrier(bar);
    asm volatile("; PHASE_MARK 10");
    { const int tid = opaque_tid(wave_s); moe_build_map(gcount, lds, tid); }
    if ((REPEAT >> 10) & 1) final_phase(p, H, y, toke, tokr, (float*)(ws + WS_XB), lds, wave_s);
    final_phase(p, H, y, toke, tokr, p.out, lds, wave_s);
}

extern "C" void kernel_launch(void* const* d_in, const int* in_sizes, int n_in, void* d_out, int out_size, void* d_ws, size_t ws_size, hipStream_t stream) {
    static int grid = 0;
    if (grid == 0) {
        if (n_in != 20 || in_sizes[0] != T * D || out_size != T * D || ws_size < WS_END) {
            fprintf(stderr, "kernel_launch: unexpected shapes (n_in %d, in0 %d, out %d, ws %zu); nothing launched\n", n_in, n_in > 0 ? in_sizes[0] : -1, out_size, ws_size); grid = -1; return; }
        int dev = 0, cus = 0, per_cu = 0;
        if (hipGetDevice(&dev) != hipSuccess || hipDeviceGetAttribute(&cus, hipDeviceAttributeMultiprocessorCount, dev) != hipSuccess) { grid = -1; return; }
        if (hipFuncSetAttribute((const void*)k_all, hipFuncAttributeMaxDynamicSharedMemorySize, LDS_BYTES) != hipSuccess) { fprintf(stderr, "kernel_launch: hipFuncSetAttribute failed\n"); grid = -1; return; }
        if (hipOccupancyMaxActiveBlocksPerMultiprocessor(&per_cu, (const void*)k_all, NT, LDS_BYTES) != hipSuccess || per_cu < 1)
            fprintf(stderr, "kernel_launch: note: occupancy query reports %d workgroups per CU\n", per_cu);
        (void)hipGetLastError();
        grid = cus;
    }
    if (grid < 0) return;
    if (hipMemsetAsync((char*)d_ws + WS_CTL, 0, CTL_BYTES, stream) != hipSuccess) return;
    Params p{};
    const float** pp = (const float**)&p;
    for (int i = 0; i < 20; ++i) pp[i] = (const float*)d_in[i];
    p.out = (float*)d_out; p.ws = (unsigned char*)d_ws;
    hipLaunchKernelGGL(k_all, dim3(grid), dim3(NT), LDS_BYTES, stream, p);
}
```

```cpp
#include <hip/hip_runtime.h>
#include <cstdio>
#include <cstdint>

constexpr int T = 32768, D = 1024, SEQ = 4096;
constexpr int CC = 512, CW = 31, NH = 8, HD = 64, QD = 512, KVD = 128, INC = 3840;
constexpr int NE = 32, NG = 4, EPG = 8, DFF = 512;
constexpr float EPS = 1e-6f;
constexpr int NT = 512;
constexpr float LOG2E = 1.4426950408889634f;

#define GAS __attribute__((address_space(1)))
#define LAS __attribute__((address_space(3)))
typedef unsigned short bf16_t;
typedef short bf16x8 __attribute__((ext_vector_type(8)));
typedef float f32x4 __attribute__((ext_vector_type(4)));
typedef float f32x16 __attribute__((ext_vector_type(16)));
typedef unsigned u32x4 __attribute__((ext_vector_type(4)));
typedef unsigned u32x2 __attribute__((ext_vector_type(2)));

__device__ __forceinline__ int lane_id_v() { int l; asm volatile("v_mbcnt_lo_u32_b32 %0, -1, 0\n\tv_mbcnt_hi_u32_b32 %0, -1, %0" : "=v"(l)); return l; }
__device__ __forceinline__ int opaque_tid(int wave_s) { return wave_s * 64 + lane_id_v(); }
__device__ __forceinline__ int opaque_i(int v) { asm volatile("" : "+v"(v)); return v; }
__device__ __forceinline__ float wave_sum(float v) {
#pragma unroll
    for (int o = 1; o < 64; o <<= 1) v += __shfl_xor(v, o);
    return v;
}
__device__ __forceinline__ float sigmoidf_(float v) { return 1.f / (1.f + __expf(-v)); }
__device__ __forceinline__ float fsig(float v) { return __builtin_amdgcn_rcpf(1.f + __builtin_amdgcn_exp2f(-LOG2E * v)); }
__device__ __forceinline__ unsigned cvt_pk_bf16(float lo, float hi) { unsigned r; asm volatile("v_cvt_pk_bf16_f32 %0, %1, %2" : "=v"(r) : "v"(lo), "v"(hi)); return r; }
__device__ __forceinline__ float bf_lo(unsigned w) { return __uint_as_float(w << 16); }
__device__ __forceinline__ float bf_hi(unsigned w) { return __uint_as_float(w & 0xffff0000u); }

namespace pg8 {
#define PG8_LAS __attribute__((address_space(3)))
constexpr int BM = 256, BK = 64, HALF = 128, HTB = HALF * BK * 2  , STAGE_BYTES = 8 * HTB, NXCD = 8, WGM = 8;

__host__ __device__ __forceinline__ int lds_byte(int r, int c) { const int st = (r >> 4) * 2 + (c >> 5), rr = r & 15, cc = c & 31, ob = rr * 64 + cc * 2; return st * 1024 + (ob ^ (((ob >> 9) & 1) << 5)); }
__host__ __device__ __forceinline__ void stage_rc(int b, int& R, int& C) { const int st = b / 1024, sb = b % 1024, swz = sb ^ (((sb >> 9) & 1) << 5); R = (st >> 1) * 16 + swz / 64; C = (st & 1) * 32 + (swz % 64) / 2; }
__host__ __device__ __forceinline__ int perm32(int rho) { const int n = rho >> 4, i = rho & 15; return 8 * (i >> 2) + 4 * n + (i & 3); }

struct Unit { int pm, pn; const char* a; const char* b; int aux, rank0; };

struct StaticOrder {
    int nM, nN, nwg, G, c;
    __host__ __device__ void init(int M, int N, int G_, int c_) { nM = M / BM; nN = N / BM; nwg = nM * nN; G = G_; c = c_; }
    __host__ __device__ bool next_mn(int i, int& pm, int& pn) const {
        const long L = (long)i * G + c; if (L >= nwg) return false;
        int wgid = (int)L; { const int q = nwg / NXCD, r = nwg % NXCD, xcd = wgid % NXCD, off = wgid / NXCD; wgid = (xcd < r ? xcd * (q + 1) : r * (q + 1) + (xcd - r) * q) + off; }
        const int nig = WGM * nN, gid = wgid / nig, fm = gid * WGM, gsz = (nM - fm) < WGM ? (nM - fm) : WGM;
        pm = fm + ((wgid % nig) % gsz); pn = (wgid % nig) / gsz; return true;
    }
};
struct DenseSched {
    StaticOrder so; const char* A; const char* Bt; size_t tstep;
    __device__ __forceinline__ void init(const bf16_t* A_, const bf16_t* Bt_, int M, int N, int K, int G, int c) { so.init(M, N, G, c); A = (const char*)A_; Bt = (const char*)Bt_; tstep = (size_t)BM * K * 2; }
    __device__ __forceinline__ bool next(int i, Unit& u) const { if (!so.next_mn(i, u.pm, u.pn)) return false; u.a = A + (size_t)u.pm * tstep; u.b = Bt + (size_t)u.pn * tstep; u.aux = 0; u.rank0 = 0; return true; }
    __device__ __forceinline__ void a_voff(const Unit&, int, int tid, int K, unsigned (&v)[2][2]) const {
#pragma unroll
        for (int i = 0; i < 2; ++i) { int R, C; stage_rc(tid * 16 + i * 8192, R, C); v[0][i] = (unsigned)(R * K + C) * 2u; v[1][i] = (unsigned)((HALF + R) * K + C) * 2u; } }
    __device__ __forceinline__ void a_ready(const Unit&) const {}
    __device__ __forceinline__ void done(const Unit&) const {}
};

template <class Epi, class Sched, bool ALIGN_EPI = false, bool SP2 = false>
__device__ __forceinline__ void gemm_phase(PG8_LAS unsigned char* lds, const int K_, const Sched& S, const Epi& E, const int wave_s) {
    const int tid_ = opaque_tid(wave_s); const int tid = tid_, wid = __builtin_amdgcn_readfirstlane(tid >> 6), lane = tid & 63, wr = wid >> 2, wc = wid & 3, fr = lane & 15, fq = lane >> 4;
    const int K = K_, nt = K / BK;
    unsigned voffB[2]; unsigned vC[2][2], vN[2][2];
#pragma unroll
    for (int i = 0; i < 2; ++i) { int R, C; stage_rc(tid * 16 + i * 8192, R, C); const int Rb = Epi::PERM ? ((R & ~31) + perm32(R & 31)) : R;
        voffB[i] = (unsigned)(Rb * K + C) * 2u; }
    const size_t kstep = (size_t)(BK * 2);
    const size_t hstep = (size_t)HALF * K * 2;
    const unsigned ldsw = (unsigned)wid * 1024u;
    const int aoff = lds_byte(wr * 64 + fr, fq * 8), boff = lds_byte(wc * 32 + fr, fq * 8);
#define PG8_SA(b, h) (((b) * 2 + (h)) * HTB)
#define PG8_SB(b, h) ((4 + (b) * 2 + (h)) * HTB)
#define PG8_STAGE(bufoff, gbase, voff) do { _Pragma("unroll") for (int _i = 0; _i < 2; ++_i) \
        __builtin_amdgcn_global_load_lds((const unsigned*)((const char*)(gbase) + (voff)[_i]), (PG8_LAS unsigned*)(lds + (bufoff) + ldsw + _i * 8192), 16, 0, 0); } while (0)
#define PG8_LDA(dst, b, h) do { _Pragma("unroll") for (int m = 0; m < 4; ++m) _Pragma("unroll") for (int k = 0; k < 2; ++k) dst[m][k] = *(const PG8_LAS bf16x8*)(lds + PG8_SA(b, h) + aoff + m * 2048 + k * 1024); } while (0)
#define PG8_LDB(dst, b, h) do { _Pragma("unroll") for (int n = 0; n < 2; ++n) _Pragma("unroll") for (int k = 0; k < 2; ++k) dst[n][k] = *(const PG8_LAS bf16x8*)(lds + PG8_SB(b, h) + boff + n * 2048 + k * 1024); } while (0)
#define PG8_MMA(ai, bj, At, Bt) do { __builtin_amdgcn_s_setprio(1); _Pragma("unroll") for (int m = 0; m < 4; ++m) _Pragma("unroll") for (int n = 0; n < 2; ++n) _Pragma("unroll") for (int k = 0; k < 2; ++k) \
        acc[ai][bj][m][n] = __builtin_amdgcn_mfma_f32_16x16x32_bf16(Bt[n][k], At[m][k], acc[ai][bj][m][n], 0, 0, 0); __builtin_amdgcn_s_setprio(0); } while (0)
#define PG8_WAIT_V(n) asm volatile("s_waitcnt vmcnt(" #n ")" ::: "memory")
#define PG8_WAIT_L(n) asm volatile("s_waitcnt lgkmcnt(" #n ")" ::: "memory")
#define PG8_BAR __builtin_amdgcn_s_barrier()
#define PG8_SCHED __builtin_amdgcn_sched_barrier(0)
    Unit cur, nxt; int ui = 0;
    if (!S.next(0, cur)) return;
    S.a_voff(cur, 0, tid, K, vC);
    f32x4 acc[2][2][4][2];
#pragma unroll
    for (int a = 0; a < 2; ++a)
#pragma unroll
        for (int b = 0; b < 2; ++b)
#pragma unroll
            for (int m = 0; m < 4; ++m)
#pragma unroll
                for (int n = 0; n < 2; ++n) acc[a][b][m][n] = (f32x4){0.f, 0.f, 0.f, 0.f};
    bf16x8 At[4][2], B0[2][2], B1[2][2];
    const char* cA = cur.a; const char* cB = cur.b;
    S.a_ready(cur);
    if constexpr (SP2) {
        PG8_STAGE(PG8_SB(0, 0), cB, voffB); PG8_STAGE(PG8_SB(0, 1), cB + hstep, voffB); PG8_STAGE(PG8_SA(0, 0), cA, vC[0]); PG8_STAGE(PG8_SA(0, 1), cA, vC[1]);
        if (wr == 1) PG8_BAR;
        PG8_WAIT_V(2); PG8_BAR;
        PG8_STAGE(PG8_SB(1, 0), cB + kstep, voffB); PG8_STAGE(PG8_SA(1, 0), cA + kstep, vC[0]); PG8_STAGE(PG8_SB(1, 1), cB + hstep + kstep, voffB);
        PG8_WAIT_V(6); PG8_BAR;
    } else {
        PG8_STAGE(PG8_SB(0, 0), cB, voffB); PG8_STAGE(PG8_SA(0, 0), cA, vC[0]); PG8_STAGE(PG8_SB(0, 1), cB + hstep, voffB); PG8_STAGE(PG8_SA(0, 1), cA, vC[1]);
        if (wr == 1) PG8_BAR;
        PG8_WAIT_V(4); PG8_BAR;
        PG8_STAGE(PG8_SB(1, 0), cB + kstep, voffB); PG8_STAGE(PG8_SA(1, 0), cA + kstep, vC[0]); PG8_STAGE(PG8_SB(1, 1), cB + hstep + kstep, voffB);
        PG8_WAIT_V(6); PG8_BAR;
    }
    for (;;) {
        const bool has_next = S.next(ui + 1, nxt);
        if (has_next) S.a_voff(nxt, ui + 1, tid, K, vN); else { vN[0][0] = vC[0][0]; vN[0][1] = vC[0][1]; vN[1][0] = vC[1][0]; vN[1][1] = vC[1][1]; }
        const char* nA = has_next ? nxt.a : cA; const char* nB = has_next ? nxt.b : cB;
        for (int t = 0; t < nt; t += 2) {
            const bool last = (t == nt - 2);
            unsigned v2[2][2]; v2[0][0] = last ? vN[0][0] : vC[0][0]; v2[0][1] = last ? vN[0][1] : vC[0][1]; v2[1][0] = last ? vN[1][0] : vC[1][0]; v2[1][1] = last ? vN[1][1] : vC[1][1];
            const char* a1 = cA + (size_t)(t + 1) * kstep;
            const char* a2 = last ? nA : cA + (size_t)(t + 2) * kstep; const char* b2 = last ? nB : cB + (size_t)(t + 2) * kstep;
            const char* a3 = a2 + kstep; const char* b3 = b2 + kstep;
            if (last && has_next) S.a_ready(nxt);
            if constexpr (Epi::MIDK > 0) { if (t == Epi::MIDK) E.mid(acc, cur, wr, wc, fr, fq); }
            if constexpr (SP2) {
            PG8_LDB(B0, 0, 0); PG8_LDB(B1, 0, 1); PG8_SCHED; PG8_LDA(At, 0, 0); PG8_STAGE(PG8_SA(1, 1), a1, vC[1]);
            PG8_WAIT_V(8); PG8_WAIT_L(0); PG8_BAR; PG8_MMA(0, 0, At, B0); PG8_MMA(0, 1, At, B1); PG8_BAR; PG8_SCHED;
            PG8_LDA(At, 0, 1); PG8_STAGE(PG8_SB(0, 0), b2, voffB); PG8_STAGE(PG8_SB(0, 1), b2 + hstep, voffB); PG8_STAGE(PG8_SA(0, 0), a2, v2[0]);
            PG8_WAIT_V(8); PG8_WAIT_L(0); PG8_BAR; PG8_MMA(1, 0, At, B0); PG8_MMA(1, 1, At, B1); PG8_BAR; PG8_SCHED;
            PG8_LDB(B0, 1, 0); PG8_LDB(B1, 1, 1); PG8_SCHED; PG8_LDA(At, 1, 0); PG8_STAGE(PG8_SA(0, 1), a2, v2[1]);
            PG8_WAIT_V(8); PG8_WAIT_L(0); PG8_BAR; PG8_MMA(0, 0, At, B0); PG8_MMA(0, 1, At, B1); PG8_BAR; PG8_SCHED;
            PG8_LDA(At, 1, 1); PG8_STAGE(PG8_SB(1, 0), b3, voffB); PG8_STAGE(PG8_SB(1, 1), b3 + hstep, voffB); PG8_STAGE(PG8_SA(1, 0), a3, v2[0]);
            PG8_WAIT_V(8); PG8_WAIT_L(0); PG8_BAR; PG8_MMA(1, 0, At, B0); PG8_MMA(1, 1, At, B1); PG8_BAR; PG8_SCHED;
            } else {
            PG8_LDB(B0, 0, 0); PG8_SCHED; PG8_LDA(At, 0, 0); PG8_STAGE(PG8_SA(1, 1), a1, vC[1]);
            PG8_WAIT_L(8); PG8_BAR; PG8_WAIT_L(0); PG8_MMA(0, 0, At, B0); PG8_BAR; PG8_SCHED;
            PG8_LDB(B1, 0, 1); PG8_STAGE(PG8_SB(0, 0), b2, voffB);
            PG8_BAR; PG8_WAIT_L(0); PG8_MMA(0, 1, At, B1); PG8_BAR;
            PG8_LDA(At, 0, 1); PG8_STAGE(PG8_SA(0, 0), a2, v2[0]);
            PG8_BAR; PG8_WAIT_L(0); PG8_MMA(1, 0, At, B0); PG8_BAR; PG8_SCHED;
            PG8_STAGE(PG8_SB(0, 1), b2 + hstep, voffB);
            PG8_WAIT_V(6); PG8_BAR; PG8_MMA(1, 1, At, B1); PG8_BAR;
            PG8_LDB(B0, 1, 0); PG8_SCHED; PG8_LDA(At, 1, 0); PG8_STAGE(PG8_SA(0, 1), a2, v2[1]);
            PG8_WAIT_L(8); PG8_BAR; PG8_WAIT_L(0); PG8_MMA(0, 0, At, B0); PG8_BAR; PG8_SCHED;
            PG8_LDB(B1, 1, 1); PG8_STAGE(PG8_SB(1, 0), b3, voffB);
            PG8_BAR; PG8_WAIT_L(0); PG8_MMA(0, 1, At, B1); PG8_BAR;
            PG8_LDA(At, 1, 1); PG8_STAGE(PG8_SA(1, 0), a3, v2[0]);
            PG8_BAR; PG8_WAIT_L(0); PG8_MMA(1, 0, At, B0); PG8_BAR; PG8_SCHED;
            PG8_STAGE(PG8_SB(1, 1), b3 + hstep, voffB);
            PG8_WAIT_V(6); PG8_BAR; PG8_MMA(1, 1, At, B1); PG8_BAR;
            }
        }
        if constexpr (ALIGN_EPI) { if (wr == 0) PG8_BAR; }
        if constexpr (!Epi::AFTER_DRAIN) { E(acc, cur, wr, wc, fr, fq); S.done(cur); }
        if (!has_next) break;
#pragma unroll
        for (int a = 0; a < 2; ++a)
#pragma unroll
            for (int b = 0; b < 2; ++b)
#pragma unroll
                for (int m = 0; m < 4; ++m)
#pragma unroll
                    for (int n = 0; n < 2; ++n) acc[a][b][m][n] = (f32x4){0.f, 0.f, 0.f, 0.f};
        cur = nxt; cA = nA; cB = nB; ++ui; vC[0][0] = vN[0][0]; vC[0][1] = vN[0][1]; vC[1][0] = vN[1][0]; vC[1][1] = vN[1][1];
        if constexpr (ALIGN_EPI) { if (wr == 1) PG8_BAR; }
    }
    PG8_WAIT_V(0);
    if constexpr (!ALIGN_EPI) { if (wr == 0) PG8_BAR; }
    PG8_BAR;
    if constexpr (Epi::AFTER_DRAIN) { E.fused(acc, cur, wr, wc, fr, fq, lds, wid, lane); S.done(cur); }
#undef PG8_SA
#undef PG8_SB
#undef PG8_STAGE
#undef PG8_LDA
#undef PG8_LDB
#undef PG8_MMA
#undef PG8_WAIT_V
#undef PG8_WAIT_L
#undef PG8_BAR
#undef PG8_SCHED
}

__device__ __forceinline__ u32x4 pack8(const f32x4 v0, const f32x4 v1) { u32x4 w; w.x = cvt_pk_bf16(v0[0], v0[1]); w.y = cvt_pk_bf16(v0[2], v0[3]); w.z = cvt_pk_bf16(v1[0], v1[1]); w.w = cvt_pk_bf16(v1[2], v1[3]); return w; }
__device__ __forceinline__ f32x4 sig4(const f32x4 v) { return (f32x4){fsig(v[0]), fsig(v[1]), fsig(v[2]), fsig(v[3])}; }

struct EpiProj {
    static constexpr bool PERM = true, AFTER_DRAIN = false; static constexpr int MIDK = 0;
    const float* rstd; bf16_t *vglu, *qb, *kvb, *sgc, *sga; float qscale;
    __device__ __forceinline__ void operator()(const f32x4 (&acc)[2][2][4][2], const Unit& u, int wr, int wc, int fr, int fq) const {
        const int pn = __builtin_amdgcn_readfirstlane(u.pn); const int coff = wc * 32 + 8 * fq; const int row0 = u.pm * BM + wr * 64 + fr;
#pragma unroll
        for (int ai = 0; ai < 2; ++ai)
#pragma unroll
            for (int m = 0; m < 4; ++m) {
                const int r = row0 + ai * HALF + m * 16; const float s = rstd[r];
                const f32x4 a0 = acc[ai][0][m][0] * s, a1 = acc[ai][0][m][1] * s, b0 = acc[ai][1][m][0] * s, b1 = acc[ai][1][m][1] * s;
                if (pn < 4) {
                    *(u32x4*)(vglu + (size_t)r * CC + 128 * pn + coff) = pack8(a0 * sig4(b0), a1 * sig4(b1));
                } else if (pn < 6) {
                    bf16_t* qp = qb + (size_t)r * QD + 256 * (pn - 4) + coff;
                    *(u32x4*)qp = pack8(a0 * qscale, a1 * qscale); *(u32x4*)(qp + HALF) = pack8(b0 * qscale, b1 * qscale);
                } else if (pn == 6) {
                    bf16_t* kp = kvb + (size_t)r * 256 + coff;
                    *(u32x4*)kp = pack8(a0, a1); *(u32x4*)(kp + HALF) = pack8(b0, b1);
                } else {
                    const size_t o = (size_t)r * D + 128 * (pn - 7) + coff;
                    const f32x4 s0 = sig4(b0), s1 = sig4(b1);
                    *(u32x4*)(sgc + o) = pack8(sig4(a0) / s0, sig4(a1) / s1); *(u32x4*)(sga + o) = pack8(s0, s1);
                }
            }
    }
};
struct EpiMerge {
    static constexpr bool PERM = true, AFTER_DRAIN = false; static constexpr int MIDK = 8;
    const bf16_t* R; const bf16_t* G; bf16_t* O;
    __device__ __forceinline__ void mid(f32x4 (&acc)[2][2][4][2], const Unit& u, int wr, int wc, int fr, int fq) const {
        const char* Rb = (const char*)R + (size_t)u.pm * BM * D * 2;
        const unsigned ob = (unsigned)((wr * 64 + opaque_i(fr)) * D + u.pn * BM + wc * 32 + 8 * fq) * 2u;
#pragma unroll
        for (int ai = 0; ai < 2; ++ai)
#pragma unroll
            for (int m = 0; m < 4; ++m) {
#pragma unroll
                for (int bj = 0; bj < 2; ++bj) { const u32x4 g = *(const u32x4*)(Rb + (ob + (unsigned)(((ai * HALF + m * 16) * D + bj * HALF) * 2)));
                    acc[ai][bj][m][0] *= (f32x4){bf_lo(g.x), bf_hi(g.x), bf_lo(g.y), bf_hi(g.y)}; acc[ai][bj][m][1] *= (f32x4){bf_lo(g.z), bf_hi(g.z), bf_lo(g.w), bf_hi(g.w)}; }
                if (m == 3) asm volatile("" ::: "memory");
            }
    }
    __device__ __forceinline__ void operator()(const f32x4 (&acc)[2][2][4][2], const Unit& u, int wr, int wc, int fr, int fq) const {
        const int row0 = u.pm * BM + wr * 64 + opaque_i(fr), col0 = u.pn * BM + wc * 32 + 8 * fq;
#pragma unroll
        for (int ai = 0; ai < 2; ++ai)
#pragma unroll
            for (int m = 0; m < 4; ++m) {
                const size_t o = (size_t)(row0 + ai * HALF + m * 16) * D + col0;
#pragma unroll
                for (int bj = 0; bj < 2; ++bj) { const u32x4 g = *(const u32x4*)(G + o + bj * HALF);
                    *(u32x4*)(O + o + bj * HALF) = pack8(acc[ai][bj][m][0] * (f32x4){bf_lo(g.x), bf_hi(g.x), bf_lo(g.y), bf_hi(g.y)}, acc[ai][bj][m][1] * (f32x4){bf_lo(g.z), bf_hi(g.z), bf_lo(g.w), bf_hi(g.w)}); }
                if (m & 1) asm volatile("" ::: "memory");
            }
    }
};
struct EpiDelta {
    static constexpr bool PERM = true, AFTER_DRAIN = false; static constexpr int MIDK = 0;
    bf16_t* O;
    __device__ __forceinline__ void operator()(const f32x4 (&acc)[2][2][4][2], const Unit& u, int wr, int wc, int fr, int fq) const {
        const int row0 = u.pm * BM + wr * 64 + fr, col0 = u.pn * BM + wc * 32 + 8 * fq;
#pragma unroll
        for (int ai = 0; ai < 2; ++ai)
#pragma unroll
            for (int m = 0; m < 4; ++m) {
                bf16_t* op = O + (size_t)(row0 + ai * HALF + m * 16) * D + col0;
                *(u32x4*)op = pack8(acc[ai][0][m][0], acc[ai][0][m][1]); *(u32x4*)(op + HALF) = pack8(acc[ai][1][m][0], acc[ai][1][m][1]);
            }
    }
};
}


constexpr size_t MiB = 1u << 20;
constexpr size_t WS_CTL = 0, CTL_BYTES = 1 * MiB;
constexpr size_t WS_WT_IN = 2 * MiB;
constexpr size_t WS_WT_MIX = 10 * MiB;
constexpr size_t WS_WT_OUT = 12 * MiB;
constexpr size_t WS_WT_GU = 16 * MiB;
constexpr size_t WS_WT_D = 80 * MiB;
constexpr size_t WS_RSTD1 = 112 * MiB;
constexpr size_t WS_TOKE = 113 * MiB;
constexpr size_t WS_TOKR = 113 * MiB + 512 * 1024;
constexpr size_t WS_LTOK = 114 * MiB, WS_LRS = 118 * MiB, WS_LW = 122 * MiB;
constexpr size_t WS_XB = 128 * MiB;
constexpr size_t WS_MERGED = WS_XB;
constexpr size_t WS_VGLU = 192 * MiB;
constexpr size_t WS_QB = 224 * MiB;
constexpr size_t WS_DELTA = 192 * MiB;
constexpr size_t WS_HB = 128 * MiB;
constexpr size_t WS_KVB = 256 * MiB;
constexpr size_t WS_SGC = 272 * MiB, WS_SGA = 336 * MiB;
constexpr size_t WS_Y = 256 * MiB;
constexpr size_t WS_MIX = 400 * MiB;
constexpr size_t WS_HMID = 400 * MiB;
constexpr size_t WS_END = 472 * MiB;
constexpr int CAP = 32768;
constexpr int NSLOT = 2 * T + NE * 256;
static_assert(WS_Y + (size_t)NSLOT * D * 2 <= WS_MIX && WS_HMID + (size_t)NSLOT * DFF * 2 <= WS_END, "d_ws map");
constexpr int CW_BAR = 4096, CW_CNT = 16384;
constexpr int RING_BYTES = 131072, LDS_BYTES = 147456, MISC_OFF = LDS_BYTES - 128;
constexpr int MOE_TBL_OFF = RING_BYTES, MOE_MAXU = 8;
constexpr int MOE_UT_OFF = MOE_TBL_OFF + MOE_MAXU * 1024, MOE_NBP_OFF = MOE_UT_OFF + MOE_MAXU * 16, MOE_CNT_OFF = MOE_NBP_OFF + 160;
static_assert(MOE_CNT_OFF + 128 <= MISC_OFF, "LDS map");

#define XB_TMO      128
#define XB_XCNT(j)  (256  + 64 * (j))
#define XB_XSUB(j)  (1280 + 64 * (j))
#define XB_XGEN(j)  (2304 + 64 * (j))
#define XB_TOP      3328
#define XB_TOPGEN   3392
#define XCD_BAR_WORDS 3456
#define XB_SPIN_CAP (1u << 18)

__device__ __forceinline__ unsigned xb_ld(unsigned* p)              { return __hip_atomic_load(p, __ATOMIC_RELAXED, __HIP_MEMORY_SCOPE_AGENT); }
__device__ __forceinline__ unsigned xb_add(unsigned* p, unsigned v) { return __hip_atomic_fetch_add(p, v, __ATOMIC_RELAXED, __HIP_MEMORY_SCOPE_AGENT); }
__device__ __forceinline__ unsigned xb_xcc_id() { return (unsigned)__builtin_amdgcn_s_getreg((3 << 11) | 20) & 0xFu; }
#define XB_SPIN(cond, bar) do { unsigned _sp = 0; while (cond) { __builtin_amdgcn_s_sleep(1); \
    if ((++_sp & 255u) == 0u) { if (xb_ld(&(bar)[XB_TMO])) break; if (_sp > XB_SPIN_CAP) { atomicAdd(&(bar)[XB_TMO], 1u); break; } } } } while (0)

struct XcdBarrier { unsigned* bar; unsigned x; volatile LAS unsigned* st; bool leader; };

__device__ __forceinline__ XcdBarrier xcd_barrier_post(unsigned* bar, volatile LAS unsigned* st, bool wave0) {
    XcdBarrier b; b.bar = bar; b.x = xb_xcc_id(); b.st = st; b.leader = wave0;
    if (wave0 && lane_id_v() == 0) (void)xb_add(&bar[XB_XCNT(b.x)], 1u);
    return b;
}
__device__ __forceinline__ void xcd_barrier_complete(unsigned* bar, unsigned x, unsigned& nloc, unsigned& nx) {
    const unsigned G = gridDim.x * gridDim.y * gridDim.z;
    unsigned sum, cnt, mine, sp = 0u;
    for (;;) {
        sum = 0u; cnt = 0u; mine = 0u;
#pragma unroll
        for (unsigned j = 0; j < 16; ++j) { const unsigned c = xb_ld(&bar[XB_XCNT(j)]); sum += c; cnt += (c > 0u) ? 1u : 0u; mine = (j == x) ? c : mine; }
        if (sum == G) break;
        __builtin_amdgcn_s_sleep(1);
        if ((++sp & 255u) == 0u) { if (xb_ld(&bar[XB_TMO])) break; if (sp > XB_SPIN_CAP) { atomicAdd(&bar[XB_TMO], 1u); break; } }
    }
    nloc = mine > 0u ? mine : 1u; nx = cnt > 0u ? cnt : 1u;
}
__device__ __forceinline__ void xcd_barrier(const XcdBarrier& b) {
    asm volatile("s_waitcnt vmcnt(0)" ::: "memory");
    __syncthreads();
    if (b.leader && lane_id_v() == 0) {
        unsigned* bar = b.bar;
        __builtin_amdgcn_s_waitcnt(0);
        unsigned nloc = b.st[0], nx = b.st[1];
        if (nloc == 0u) { xcd_barrier_complete(bar, b.x, nloc, nx); b.st[0] = nloc; b.st[1] = nx; }
        const unsigned old = xb_add(&bar[XB_XSUB(b.x)], 1u);
        const unsigned gen = old / nloc;
        if (old + 1u == (gen + 1u) * nloc) {
            __builtin_amdgcn_fence(__ATOMIC_RELEASE, "agent");
            asm volatile("s_waitcnt vmcnt(0)" ::: "memory");
            const unsigned og = xb_add(&bar[XB_TOP], 1u);
            const unsigned tg = og / nx;
            if (og + 1u == (tg + 1u) * nx) xb_add(&bar[XB_TOPGEN], 1u);
            else XB_SPIN(xb_ld(&bar[XB_TOPGEN]) == tg, bar);
            __builtin_amdgcn_fence(__ATOMIC_ACQUIRE, "agent");
            xb_add(&bar[XB_XGEN(b.x)], 1u);
            asm volatile("s_waitcnt vmcnt(0)" ::: "memory");
        } else {
            XB_SPIN(xb_ld(&bar[XB_XGEN(b.x)]) == gen, bar);
            __builtin_amdgcn_fence(__ATOMIC_ACQUIRE, "agent");
            asm volatile("s_waitcnt vmcnt(0)" ::: "memory");
        }
    }
    __syncthreads();
}

struct Params {
    const float *x, *g_mix, *w_in, *w_dw, *b_dw, *ln_g, *ln_b, *sinks, *w_conv_out, *w_attn_out, *w_out, *g_ffn,
                *w_group, *b_group, *w_expert, *b_expert, *w_gate, *w_up, *w_down, *g_final;
    float* out; unsigned char* ws;
};
typedef const __attribute__((address_space(4))) Params CParams;

__device__ __forceinline__ void p0_transpose_item(const float* W, int ld, int srccol, int k0, const float* gain, bf16_t* WT, int K, int dstrow, LAS float* scr, int lane) {
    const int ksub = lane >> 3, n4 = (lane & 7) * 4;
    f32x4 v[8];
#pragma unroll
    for (int i = 0; i < 8; ++i) v[i] = *(const f32x4*)(W + (size_t)(k0 + 8 * i + ksub) * ld + srccol + n4);
    if (gain) {
#pragma unroll
        for (int i = 0; i < 8; ++i) v[i] *= gain[k0 + 8 * i + ksub]; }
#pragma unroll
    for (int i = 0; i < 8; ++i) { LAS float* d = scr + (8 * i + ksub) * 33 + n4; d[0] = v[i][0]; d[1] = v[i][1]; d[2] = v[i][2]; d[3] = v[i][3]; }
    asm volatile("s_waitcnt lgkmcnt(0)" ::: "memory");
    const int c = lane & 7;
#pragma unroll
    for (int j = 0; j < 4; ++j) { const int n = (lane >> 3) + 8 * j; const LAS float* s = scr + (8 * c) * 33 + n;
        u32x4 o; o.x = cvt_pk_bf16(s[0 * 33], s[1 * 33]); o.y = cvt_pk_bf16(s[2 * 33], s[3 * 33]); o.z = cvt_pk_bf16(s[4 * 33], s[5 * 33]); o.w = cvt_pk_bf16(s[6 * 33], s[7 * 33]);
        *(u32x4*)(WT + (size_t)(dstrow + n) * K + k0 + 8 * c) = o; }
    asm volatile("s_waitcnt lgkmcnt(0)" ::: "memory");
}
__device__ __forceinline__ int win_srccol(int np) {
    const int pn = np >> 8, bj = (np >> 7) & 1, o = np & 127;
    if (pn < 4) return (bj ? 512 : 0) + 128 * pn + o;
    if (pn < 6) return 1024 + 256 * (pn - 4) + 128 * bj + o;
    if (pn == 6) return (bj ? 1664 : 1536) + o;
    return (bj ? 2816 : 1792) + 128 * (pn - 7) + o;
}
__device__ __forceinline__ void p0_prologue(CParams& p, LAS unsigned char* lds, const int wave_s) {
    unsigned char* ws = p.ws;
    const int tidx = opaque_tid(wave_s), lane = tidx & 63, wave = tidx >> 6;
    LAS float* scr = (LAS float*)(lds + wave * 16384);
    const int gw = blockIdx.x * (NT / 64) + wave, NGW = gridDim.x * (NT / 64);
    bf16_t* wt_in = (bf16_t*)(ws + WS_WT_IN); bf16_t* wt_mix = (bf16_t*)(ws + WS_WT_MIX); bf16_t* wt_out = (bf16_t*)(ws + WS_WT_OUT);
    constexpr int I_IN = (D / 64) * (INC / 32), I_CO = (CC / 64) * (D / 32), I_AO = (QD / 64) * (D / 32), I_OUT = (D / 64) * (D / 32);
    constexpr int NITEMS = I_IN + I_CO + I_AO + I_OUT;
    for (int it = gw; it < NITEMS; it += NGW) {
        int r = it;
        if (r < I_IN) { const int nblk = INC / 32, kb = r / nblk, nb = r % nblk; p0_transpose_item(p.w_in, INC, win_srccol(32 * nb), 64 * kb, p.g_mix, wt_in, D, 32 * nb, scr, lane); continue; } r -= I_IN;
        if (r < I_CO) { const int nblk = D / 32, kb = r / nblk, nb = r % nblk; p0_transpose_item(p.w_conv_out, D, 32 * nb, 64 * kb, nullptr, wt_mix, D, 32 * nb, scr, lane); continue; } r -= I_CO;
        if (r < I_AO) { const int nblk = D / 32, kb = r / nblk, nb = r % nblk; p0_transpose_item(p.w_attn_out, D, 32 * nb, 64 * kb, nullptr, wt_mix + CC, D, 32 * nb, scr, lane); continue; } r -= I_AO;
        { const int nblk = D / 32, kb = r / nblk, nb = r % nblk; p0_transpose_item(p.w_out, D, 32 * nb, 64 * kb, nullptr, wt_out, D, 32 * nb, scr, lane); }
    }
    bf16_t* xb = (bf16_t*)(ws + WS_XB); float* rstd1 = (float*)(ws + WS_RSTD1);
    for (int m = gw; m < T; m += NGW) {
        const f32x4* xr = (const f32x4*)(p.x + (size_t)m * D) + lane;
        f32x4 v[4]; float s = 0.f;
#pragma unroll
        for (int j = 0; j < 4; ++j) { v[j] = xr[64 * j]; s += (v[j][0] * v[j][0] + v[j][1] * v[j][1]) + (v[j][2] * v[j][2] + v[j][3] * v[j][3]); }
        s = wave_sum(s);
        if (lane == 0) rstd1[m] = rsqrtf(s * (1.f / D) + EPS);
        u32x2* o = (u32x2*)(xb + (size_t)m * D) + lane;
#pragma unroll
        for (int j = 0; j < 4; ++j) { u32x2 w; w.x = cvt_pk_bf16(v[j][0], v[j][1]); w.y = cvt_pk_bf16(v[j][2], v[j][3]); o[64 * j] = w; }
    }
}

template <int N> __device__ __forceinline__ void red_step(float (&v)[16], int lane, int k) {
#pragma unroll
    for (int a = 0; a < N / 2; ++a) { const bool up = (lane & k) != 0; const float send = up ? v[a] : v[a + N / 2], keep = up ? v[a + N / 2] : v[a]; v[a] = keep + __shfl_xor(send, k); }
}
constexpr int CONV_ROWS = 64 + CW - 1;
__device__ __forceinline__ void conv_phase(CParams& p, const bf16_t* vglu, bf16_t* cact, LAS unsigned char* lds, const int wave_s) {
    const int tid = opaque_tid(wave_s), lane = tid & 63, wid = tid >> 6, cp = tid & 255, th = tid >> 8, wq = wid & 3;
    float w0[CW], w1[CW];
#pragma unroll
    for (int j = 0; j < CW; ++j) { w0[j] = p.w_dw[j * CC + 2 * cp]; w1[j] = p.w_dw[j * CC + 2 * cp + 1]; }
    const float bi0 = p.b_dw[2 * cp], bi1 = p.b_dw[2 * cp + 1], lg0 = p.ln_g[2 * cp], lg1 = p.ln_g[2 * cp + 1], lb0 = p.ln_b[2 * cp], lb1 = p.ln_b[2 * cp + 1];
    LAS unsigned char* Vs = lds;
    LAS float* red = (LAS float*)(lds + CONV_ROWS * 1024);
    for (int cb = blockIdx.x; cb < T / 64; cb += gridDim.x) {
        const int t0 = cb * 64, seq0 = (t0 / SEQ) * SEQ;
        __syncthreads();
        for (int c = tid; c < CONV_ROWS * 64; c += NT) {
            const int row = c >> 6, ch = c & 63, pos = t0 - (CW - 1) + row; u32x4 v = {0u, 0u, 0u, 0u};
            if (pos >= seq0) v = *(const u32x4*)(vglu + (size_t)pos * CC + ch * 8);
            *(LAS u32x4*)(Vs + row * 1024 + ch * 16) = v; }
        __syncthreads();
#pragma unroll 1
        for (int grp = 0; grp < 4; ++grp) {
            float y[8][2]; const int tok0 = 32 * th + 8 * grp;
#pragma unroll
            for (int i = 0; i < 8; ++i) { y[i][0] = bi0; y[i][1] = bi1; }
            { const LAS unsigned char* base = Vs + tok0 * 1024 + cp * 4;
#pragma unroll
                for (int r = 0; r < 8 + CW - 1; ++r) { const unsigned pr = *(const LAS unsigned*)(base + r * 1024); const float lo = bf_lo(pr), hi2 = bf_hi(pr);
#pragma unroll
                    for (int i = 0; i < 8; ++i) { const int j = r - i; if (j >= 0 && j < CW) { y[i][0] = fmaf(w0[j], lo, y[i][0]); y[i][1] = fmaf(w1[j], hi2, y[i][1]); } } } }
            float v[16];
#pragma unroll
            for (int i = 0; i < 8; ++i) { v[i] = y[i][0] + y[i][1]; v[8 + i] = y[i][0] * y[i][0] + y[i][1] * y[i][1]; }
            red_step<16>(v, lane, 32); red_step<8>(v, lane, 16); red_step<4>(v, lane, 8); red_step<2>(v, lane, 4);
            float tot = v[0]; tot += __shfl_xor(tot, 2); tot += __shfl_xor(tot, 1);
            const int idx = ((lane >> 5) & 1) * 8 + ((lane >> 4) & 1) * 4 + ((lane >> 3) & 1) * 2 + ((lane >> 2) & 1);
            LAS float* rb = red + (grp & 1) * 128;
            if ((lane & 3) == 0) rb[(th * 4 + wq) * 16 + idx] = tot;
            __syncthreads();
#pragma unroll
            for (int i = 0; i < 8; ++i) {
                float S = 0.f, Q = 0.f;
#pragma unroll
                for (int q = 0; q < 4; ++q) { S += rb[(th * 4 + q) * 16 + i]; Q += rb[(th * 4 + q) * 16 + 8 + i]; }
                const float mean = S * (1.f / CC), var = Q * (1.f / CC) - mean * mean, rstd = rsqrtf(fmaxf(var, 0.f) + EPS);
                float z0 = (y[i][0] - mean) * rstd * lg0 + lb0, z1 = (y[i][1] - mean) * rstd * lg1 + lb1;
                z0 *= fsig(z0); z1 *= fsig(z1);
                *(unsigned*)(cact + (size_t)(t0 + tok0 + i) * D + 2 * cp) = cvt_pk_bf16(z0, z1);
            }
        }
    }
}

__device__ __forceinline__ int crow(int r, int hi) { return (r & 3) + 8 * (r >> 2) + 4 * hi; }
constexpr int ATT_KS = 144, ATT_VT = 400, ATT_VT_OFF = 192 * ATT_KS;
__device__ __forceinline__ void attn_phase(CParams& p, const bf16_t* qb, const bf16_t* kvb, bf16_t* att, LAS unsigned char* lds, const int wave_s) {
    const int tid = opaque_tid(wave_s), lane = tid & 63, wid = __builtin_amdgcn_readfirstlane(tid >> 6), r32 = lane & 31, hi = lane >> 5, g = wid & 3, w2 = wid >> 2;
    LAS unsigned char* Ks = lds; LAS unsigned char* Vt = lds + ATT_VT_OFF;
    for (int u = blockIdx.x; u < (T / 64) * 2; u += gridDim.x) {
        const int qblk = u >> 1, kvh = u & 1, t0 = qblk * 64, seq0 = (t0 / SEQ) * SEQ, kpos0 = t0 - 128, h = kvh * 4 + g;
        __syncthreads();
        for (int c = tid; c < 192 * 8; c += NT) {
            const int row = c >> 3, ch = c & 7, pos = kpos0 + row; u32x4 kk = {0u, 0u, 0u, 0u}, vv = {0u, 0u, 0u, 0u};
            if (pos >= seq0) { const bf16_t* src = kvb + (size_t)pos * 256 + kvh * HD + ch * 8; kk = *(const u32x4*)src; vv = *(const u32x4*)(src + 128); }
            *(LAS u32x4*)(Ks + row * ATT_KS + ch * 16) = kk;
            LAS bf16_t* vt = (LAS bf16_t*)(Vt + (ch * 8) * ATT_VT) + row;
            vt[0 * (ATT_VT / 2)] = (bf16_t)(vv.x & 0xffffu); vt[1 * (ATT_VT / 2)] = (bf16_t)(vv.x >> 16); vt[2 * (ATT_VT / 2)] = (bf16_t)(vv.y & 0xffffu); vt[3 * (ATT_VT / 2)] = (bf16_t)(vv.y >> 16);
            vt[4 * (ATT_VT / 2)] = (bf16_t)(vv.z & 0xffffu); vt[5 * (ATT_VT / 2)] = (bf16_t)(vv.z >> 16); vt[6 * (ATT_VT / 2)] = (bf16_t)(vv.w & 0xffffu); vt[7 * (ATT_VT / 2)] = (bf16_t)(vv.w >> 16);
        }
        __syncthreads();
        const int tw = t0 + 32 * w2;
        bf16x8 qf[4]; { const bf16_t* qp = qb + (size_t)(tw + r32) * QD + h * HD + hi * 8;
#pragma unroll
            for (int ks = 0; ks < 4; ++ks) qf[ks] = *(const bf16x8*)(qp + ks * 16); }
        f32x16 pt[5];
#pragma unroll
        for (int jj = 0; jj < 5; ++jj) { f32x16 a = {0.f, 0.f, 0.f, 0.f, 0.f, 0.f, 0.f, 0.f, 0.f, 0.f, 0.f, 0.f, 0.f, 0.f, 0.f, 0.f};
            const LAS unsigned char* kp = Ks + (32 * (w2 + jj) + r32) * ATT_KS + hi * 16;
#pragma unroll
            for (int ks = 0; ks < 4; ++ks) { const bf16x8 kf = *(const LAS bf16x8*)(kp + ks * 32); a = __builtin_amdgcn_mfma_f32_32x32x16_bf16(kf, qf[ks], a, 0, 0, 0); }
            pt[jj] = a; __builtin_amdgcn_sched_barrier(0); }
        const float slope2 = exp2f(-(float)(h + 1)) * LOG2E, sink2 = p.sinks[h] * LOG2E;
        const int kmin = seq0 - (tw - 128); const int r32o = opaque_i(r32), hio = opaque_i(hi);
        float m = sink2;
#pragma unroll
        for (int jj = 0; jj < 5; ++jj)
#pragma unroll
            for (int r = 0; r < 16; ++r) { const int kw = 32 * jj + crow(r, hio), rel = 128 + r32o - kw; const bool valid = (kw > r32o) && (kw <= r32o + 128) && (kw >= kmin);
                const float s = valid ? pt[jj][r] - slope2 * (float)rel : -INFINITY; pt[jj][r] = s; m = fmaxf(m, s); }
        m = fmaxf(m, __shfl_xor(m, 32));
        float l = 0.f;
#pragma unroll
        for (int jj = 0; jj < 5; ++jj)
#pragma unroll
            for (int r = 0; r < 16; ++r) { const float e = __builtin_amdgcn_exp2f(pt[jj][r] - m); pt[jj][r] = e; l += e; }
        l += __shfl_xor(l, 32); l += __builtin_amdgcn_exp2f(sink2 - m);
        f32x16 o0 = {0.f, 0.f, 0.f, 0.f, 0.f, 0.f, 0.f, 0.f, 0.f, 0.f, 0.f, 0.f, 0.f, 0.f, 0.f, 0.f}, o1 = o0;
#pragma unroll
        for (int jj = 0; jj < 5; ++jj)
#pragma unroll
            for (int s2 = 0; s2 < 2; ++s2) {
                u32x4 pw; pw.x = cvt_pk_bf16(pt[jj][8 * s2 + 0], pt[jj][8 * s2 + 1]); pw.y = cvt_pk_bf16(pt[jj][8 * s2 + 2], pt[jj][8 * s2 + 3]);
                pw.z = cvt_pk_bf16(pt[jj][8 * s2 + 4], pt[jj][8 * s2 + 5]); pw.w = cvt_pk_bf16(pt[jj][8 * s2 + 6], pt[jj][8 * s2 + 7]);
                const bf16x8 pf = __builtin_bit_cast(bf16x8, pw);
                const LAS unsigned char* vp = Vt + r32 * ATT_VT + (32 * (w2 + jj) + 16 * s2 + 4 * hi) * 2;
                const u32x2 a0 = *(const LAS u32x2*)vp, a1 = *(const LAS u32x2*)(vp + 16), b0 = *(const LAS u32x2*)(vp + 32 * ATT_VT), b1 = *(const LAS u32x2*)(vp + 32 * ATT_VT + 16);
                const bf16x8 vf0 = __builtin_bit_cast(bf16x8, (u32x4){a0.x, a0.y, a1.x, a1.y}), vf1 = __builtin_bit_cast(bf16x8, (u32x4){b0.x, b0.y, b1.x, b1.y});
                o0 = __builtin_amdgcn_mfma_f32_32x32x16_bf16(vf0, pf, o0, 0, 0, 0); o1 = __builtin_amdgcn_mfma_f32_32x32x16_bf16(vf1, pf, o1, 0, 0, 0);
                __builtin_amdgcn_sched_barrier(0);
            }
        const float inv = 1.f / l;
        bf16_t* op = att + (size_t)(tw + r32) * D + h * HD + 4 * hi;
#pragma unroll
        for (int rg = 0; rg < 4; ++rg) {
            u32x2 w0, w1; w0.x = cvt_pk_bf16(o0[4 * rg] * inv, o0[4 * rg + 1] * inv); w0.y = cvt_pk_bf16(o0[4 * rg + 2] * inv, o0[4 * rg + 3] * inv);
            w1.x = cvt_pk_bf16(o1[4 * rg] * inv, o1[4 * rg + 1] * inv); w1.y = cvt_pk_bf16(o1[4 * rg + 2] * inv, o1[4 * rg + 3] * inv);
            *(u32x2*)(op + 8 * rg) = w0; *(u32x2*)(op + 32 + 8 * rg) = w1; }
    }
}


__device__ __forceinline__ void p0_moe_weights(CParams& p, LAS unsigned char* lds, const int wave_s) {
    unsigned char* ws = p.ws;
    const int tidx = opaque_tid(wave_s), lane = tidx & 63, wave = tidx >> 6;
    LAS float* scr = (LAS float*)(lds + wave * 16384);
    const int gw = blockIdx.x * (NT / 64) + wave, NGW = gridDim.x * (NT / 64);
    bf16_t* wt_gu = (bf16_t*)(ws + WS_WT_GU); bf16_t* wt_d = (bf16_t*)(ws + WS_WT_D);
    constexpr int I_GU = (D / 64) * (1024 / 32), I_D = (DFF / 64) * (D / 32);
    for (int it = gw; it < NE * (I_GU + I_D); it += NGW) {
        const int e = it / (I_GU + I_D); int r = it % (I_GU + I_D);
        if (r < I_GU) { const int kb = r >> 5, nb = r & 31, np = 32 * nb, pn = np >> 8, bj = (np >> 7) & 1, o = np & 127;
            const float* W = (bj ? p.w_up : p.w_gate) + (size_t)e * D * DFF;
            p0_transpose_item(W, DFF, 128 * pn + o, 64 * kb, p.g_ffn, wt_gu + (size_t)e * 1024 * D, D, np, scr, lane); }
        else { r -= I_GU; const int kb = r >> 5, nb = r & 31;
            p0_transpose_item(p.w_down + (size_t)e * DFF * D, D, 32 * nb, 64 * kb, nullptr, wt_d + (size_t)e * D * DFF, DFF, 32 * nb, scr, lane); }
    }
}

constexpr int RT_WAVE = (64 * 36 + 32 * 32 + 32 * 4) * 4;
__device__ __forceinline__ void route_phase_fast(CParams& p, const float* X, const bf16_t* delta, bf16_t* hb, int* toke, int* tokr, int* ltok, float* lrs, float* lw, unsigned* gcount,
                                                 LAS unsigned char* lds, const int wave_s) {
    const int tid = opaque_tid(wave_s), lane = tid & 63, kq = wave_s & 3, tg = wave_s >> 2, r32 = lane & 31, hi = lane >> 5;
    LAS float* tile = (LAS float*)(lds + wave_s * RT_WAVE); LAS float* Wl = tile + 64 * 36; LAS float* Wgl = Wl + 32 * 32;
    LAS unsigned* hist = (LAS unsigned*)(lds + 8 * RT_WAVE);
    for (int task = blockIdx.x; task < T / 128; task += gridDim.x) {
        const int tok0 = task * 128 + tg * 64;
        if (tid < 32) hist[tid] = 0u;
        f32x16 acc0 = {0.f, 0.f, 0.f, 0.f, 0.f, 0.f, 0.f, 0.f, 0.f, 0.f, 0.f, 0.f, 0.f, 0.f, 0.f, 0.f}, acc1 = acc0;
        f32x4 ag = {0.f, 0.f, 0.f, 0.f}; float ss = 0.f;
        f32x4 hr[8], wr[4], wgr = {0.f, 0.f, 0.f, 0.f}; u32x2 dr[8]; float gk[4], ggr = 0.f;
        const int rsub = lane >> 3, c4 = (lane & 7) * 4; const int hoff = (rsub * D + c4) * 4;
        const __amdgpu_buffer_rsrc_t rx = __builtin_amdgcn_make_buffer_rsrc((void*)X, 0, T * D * 4, 0x00020000), rd = __builtin_amdgcn_make_buffer_rsrc((void*)delta, 0, T * D * 2, 0x00020000),
            rwe = __builtin_amdgcn_make_buffer_rsrc((void*)p.w_expert, 0, D * NE * 4, 0x00020000), rwg = __builtin_amdgcn_make_buffer_rsrc((void*)p.w_group, 0, D * NG * 4, 0x00020000),
            rg = __builtin_amdgcn_make_buffer_rsrc((void*)p.g_ffn, 0, D * 4, 0x00020000), rhb = __builtin_amdgcn_make_buffer_rsrc((void*)hb, 0, T * D * 2, 0x00020000);
#define RT_LOAD(ch) do { const int k0_ = kq * 256 + (ch) * 32; const int sx_ = (tok0 * D + k0_) * 4; \
            _Pragma("unroll") for (int i = 0; i < 8; ++i) { hr[i] = __builtin_bit_cast(f32x4, __builtin_amdgcn_raw_buffer_load_b128(rx, hoff, sx_ + i * 8 * D * 4, 0)); \
                                                            dr[i] = __builtin_amdgcn_raw_buffer_load_b64(rd, hoff >> 1, (sx_ >> 1) + i * 8 * D * 2, 0); } \
            _Pragma("unroll") for (int i = 0; i < 4; ++i) { wr[i] = __builtin_bit_cast(f32x4, __builtin_amdgcn_raw_buffer_load_b128(rwe, lane * 16, k0_ * NE * 4 + i * 1024, 0)); \
                                                            gk[i] = __builtin_bit_cast(float, __builtin_amdgcn_raw_buffer_load_b32(rg, rsub * 4, (k0_ + i * 8) * 4, 0)); } \
            if (lane < 32) { wgr = __builtin_bit_cast(f32x4, __builtin_amdgcn_raw_buffer_load_b128(rwg, lane * 16, k0_ * NG * 4, 0)); ggr = __builtin_bit_cast(float, __builtin_amdgcn_raw_buffer_load_b32(rg, lane * 4, k0_ * 4, 0)); } } while (0)
        RT_LOAD(0);
#pragma unroll 1
        for (int ch = 0; ch < 8; ++ch) {
            const int k0 = kq * 256 + ch * 32;
#pragma unroll
            for (int i = 0; i < 8; ++i) { const int row = 8 * i + rsub; hr[i] += (f32x4){bf_lo(dr[i].x), bf_hi(dr[i].x), bf_lo(dr[i].y), bf_hi(dr[i].y)};
                u32x2 w; w.x = cvt_pk_bf16(hr[i][0], hr[i][1]); w.y = cvt_pk_bf16(hr[i][2], hr[i][3]);
                __builtin_amdgcn_raw_buffer_store_b64(w, rhb, hoff >> 1, (tok0 * D + k0) * 2 + i * 8 * D * 2, 0); *(LAS f32x4*)(tile + row * 36 + c4) = hr[i]; }
#pragma unroll
            for (int i = 0; i < 4; ++i) *(LAS f32x4*)(Wl + (i * 64 + lane) * 4) = wr[i] * gk[i];
            if (lane < 32) *(LAS f32x4*)(Wgl + lane * 4) = wgr * ggr;
            if (ch + 1 < 8) RT_LOAD(ch + 1);
            float bv[16];
#pragma unroll
            for (int s2 = 0; s2 < 16; ++s2) bv[s2] = Wl[(16 * hi + s2) * 32 + r32];
#pragma unroll
            for (int tt = 0; tt < 2; ++tt) {
                f32x4 a4[4];
#pragma unroll
                for (int q = 0; q < 4; ++q) a4[q] = *(const LAS f32x4*)(tile + (32 * tt + r32) * 36 + 16 * hi + 4 * q);
#pragma unroll
                for (int s2 = 0; s2 < 16; ++s2) { if (tt == 0) acc0 = __builtin_amdgcn_mfma_f32_32x32x2f32(a4[s2 >> 2][s2 & 3], bv[s2], acc0, 0, 0, 0);
                                                  else acc1 = __builtin_amdgcn_mfma_f32_32x32x2f32(a4[s2 >> 2][s2 & 3], bv[s2], acc1, 0, 0, 0); }
            }
#pragma unroll
            for (int k4 = 0; k4 < 8; ++k4) { const f32x4 hv = *(const LAS f32x4*)(tile + lane * 36 + 4 * k4);
#pragma unroll
                for (int q = 0; q < 4; ++q) { const f32x4 wg = *(const LAS f32x4*)(Wgl + (4 * k4 + q) * 4); ag += wg * hv[q]; ss = fmaf(hv[q], hv[q], ss); } }
        }
#undef RT_LOAD
#pragma unroll
        for (int r = 0; r < 16; ++r) { const int cr = (r & 3) + 8 * (r >> 2) + 4 * hi; tile[cr * 37 + 4 + r32] = acc0[r]; tile[(32 + cr) * 37 + 4 + r32] = acc1[r]; }
        tile[lane * 37 + 0] = ag[0]; tile[lane * 37 + 1] = ag[1]; tile[lane * 37 + 2] = ag[2]; tile[lane * 37 + 3] = ag[3]; tile[lane * 37 + 36] = ss;
        __syncthreads();
        int ea = 0, eb = 0; unsigned ra = 0u, rb = 0u; float w1 = 0.f, w2 = 0.f, rstd = 0.f;
        if (kq == 0) {
            float lg[NG + NE]; float s2 = 0.f;
#pragma unroll
            for (int e = 0; e < NG + NE; ++e) lg[e] = 0.f;
#pragma unroll
            for (int q = 0; q < 4; ++q) { const LAS float* pt = (const LAS float*)(lds + (tg * 4 + q) * RT_WAVE) + lane * 37;
#pragma unroll
                for (int e = 0; e < NG + NE; ++e) lg[e] += pt[e];
                s2 += pt[36]; }
            rstd = rsqrtf(s2 * (1.f / D) + EPS);
            float gl[NG]; float gmax = -INFINITY; int gsel = 0;
#pragma unroll
            for (int g = 0; g < NG; ++g) { gl[g] = lg[g] * rstd + p.b_group[g]; if (gl[g] > gmax) { gmax = gl[g]; gsel = g; } }
            float gden = 0.f;
#pragma unroll
            for (int g = 0; g < NG; ++g) gden += __expf(gl[g] - gmax);
            const float pg = 1.f / gden;
            float v1 = -INFINITY, v2 = -INFINITY; int i1 = 0, i2 = 0;
#pragma unroll
            for (int g = 0; g < NG; ++g) if (g == gsel) {
#pragma unroll
                for (int j = 0; j < EPG; ++j) { const float val = lg[4 + g * EPG + j] * rstd + p.b_expert[g * EPG + j];
                    if (val > v1) { v2 = v1; i2 = i1; v1 = val; i1 = j; } else if (val > v2) { v2 = val; i2 = j; } }
            }
            const float e2 = __expf(v2 - v1); w1 = pg / (1.f + e2); w2 = pg * e2 / (1.f + e2);
            ea = gsel * EPG + i1; eb = gsel * EPG + i2;
            ra = __hip_atomic_fetch_add(hist + ea, 1u, __ATOMIC_RELAXED, __HIP_MEMORY_SCOPE_WORKGROUP);
            rb = __hip_atomic_fetch_add(hist + eb, 1u, __ATOMIC_RELAXED, __HIP_MEMORY_SCOPE_WORKGROUP);
        }
        __syncthreads();
        { const int t2 = opaque_i(tid); if (t2 < 32) hist[32 + t2] = __hip_atomic_fetch_add(gcount + t2, hist[t2], __ATOMIC_RELAXED, __HIP_MEMORY_SCOPE_AGENT); }
        __syncthreads();
        if (kq == 0) {
            const int tok = tok0 + lane; const unsigned pa = hist[32 + ea] + ra, pb = hist[32 + eb] + rb;
            ltok[(size_t)ea * CAP + pa] = tok; lrs[(size_t)ea * CAP + pa] = rstd; lw[(size_t)ea * CAP + pa] = w1;
            ltok[(size_t)eb * CAP + pb] = tok; lrs[(size_t)eb * CAP + pb] = rstd; lw[(size_t)eb * CAP + pb] = w2;
            toke[2 * tok] = ea; toke[2 * tok + 1] = eb; tokr[2 * tok] = (int)pa; tokr[2 * tok + 1] = (int)pb;
        }
        __syncthreads();
    }
}

__device__ __forceinline__ void moe_build_map(const unsigned* gcount, LAS unsigned char* lds, int tid) {
    LAS int* nbp = (LAS int*)(lds + MOE_NBP_OFF); LAS int* cnt = (LAS int*)(lds + MOE_CNT_OFF);
    __syncthreads();
    if (tid < 64) {
        const int c = tid < NE ? (int)__hip_atomic_load(gcount + (tid & 31), __ATOMIC_RELAXED, __HIP_MEMORY_SCOPE_AGENT) : 0;
        int x = (c + 255) >> 8;
#pragma unroll
        for (int o = 1; o < 32; o <<= 1) { const int t = __shfl_up(x, o); if ((tid & 63) >= o) x += t; }
        if (tid < NE) { cnt[tid] = c; nbp[tid + 1] = x; }
        if (tid == 0) nbp[0] = 0;
    }
    __syncthreads();
}
__device__ __forceinline__ void moe_unit_of(int i, int G, int c, int& blk, int& pn) {
    if ((G & 31) == 0) { const int w = c >> 3; blk = i * (G >> 2) + (c & 7) * (G >> 5) + (w >> 2); pn = w & 3; }
    else { const int L = i * G + c; blk = L >> 2; pn = L & 3; }
}
__device__ __forceinline__ void moe_build_units(const int* ltok, LAS unsigned char* lds, int G, int c, int tid, bool gather) {
    const LAS int* nbp = (const LAS int*)(lds + MOE_NBP_OFF); const LAS int* cnt = (const LAS int*)(lds + MOE_CNT_OFF);
    LAS int* ut = (LAS int*)(lds + MOE_UT_OFF); LAS unsigned* tbl = (LAS unsigned*)(lds + MOE_TBL_OFF);
    const int nunits = nbp[NE] * 4;
    for (int i = 0; i < MOE_MAXU; ++i) {
        int blk, pnn; moe_unit_of(i, G, c, blk, pnn); if (blk * 4 >= nunits) continue;
        int e = 0;
        for (int j = 1; j < NE; ++j) if (blk >= nbp[j]) e = j;
        const int rb = blk - nbp[e];
        if (tid == 0) { ut[4 * i] = e; ut[4 * i + 1] = blk; ut[4 * i + 2] = pnn; ut[4 * i + 3] = rb * 256; }
        if (gather && tid < 256) { const int rank = rb * 256 + tid; tbl[i * 256 + tid] = rank < cnt[e] ? (unsigned)ltok[(size_t)e * CAP + rank] * (unsigned)(D * 2) : 0u; }
    }
    __syncthreads();
}
namespace pg8 {
struct MoeSched {
    const LAS int* ut; const LAS unsigned* tbl; const LAS int* nbp; const char* A; const char* Bt; int G, c, K; bool gather;
    __device__ __forceinline__ bool next(int i, Unit& u) const {
        const int nunits = __builtin_amdgcn_readfirstlane(nbp[NE]) * 4;
        if (i >= MOE_MAXU) return false;
        { int blk_, pn_; moe_unit_of(i, G, c, blk_, pn_); if (blk_ * 4 >= nunits) return false; }
        const int e = __builtin_amdgcn_readfirstlane(ut[4 * i]), blk = __builtin_amdgcn_readfirstlane(ut[4 * i + 1]), pn = __builtin_amdgcn_readfirstlane(ut[4 * i + 2]), r0 = __builtin_amdgcn_readfirstlane(ut[4 * i + 3]);
        u.pm = blk; u.pn = pn; u.aux = e; u.rank0 = r0;
        u.a = gather ? A : A + (size_t)blk * 256 * K * 2;
        u.b = Bt + ((size_t)e * 1024 + (size_t)pn * 256) * K * 2;
        return true;
    }
    __device__ __forceinline__ void a_voff(const Unit&, int ui, int tid, int K_, unsigned (&v)[2][2]) const {
#pragma unroll
        for (int i = 0; i < 2; ++i) { int R, C; stage_rc(tid * 16 + i * 8192, R, C);
            if (gather) { v[0][i] = tbl[ui * 256 + R] + (unsigned)C * 2u; v[1][i] = tbl[ui * 256 + HALF + R] + (unsigned)C * 2u; }
            else { v[0][i] = (unsigned)(R * K_ + C) * 2u; v[1][i] = (unsigned)((HALF + R) * K_ + C) * 2u; } }
    }
    __device__ __forceinline__ void a_ready(const Unit&) const {}
    __device__ __forceinline__ void done(const Unit&) const {}
};
struct EpiSwiglu {
    static constexpr bool PERM = true, AFTER_DRAIN = false; static constexpr int MIDK = 0;
    const float* lrs; const LAS int* cnt; bf16_t* hmid;
    __device__ __forceinline__ void operator()(const f32x4 (&acc)[2][2][4][2], const Unit& u, int wr, int wc, int fr, int fq) const {
        const int e = u.aux, n = __builtin_amdgcn_readfirstlane(cnt[e]); const int coff = wc * 32 + 8 * fq;
#pragma unroll
        for (int ai = 0; ai < 2; ++ai)
#pragma unroll
            for (int m = 0; m < 4; ++m) {
                const int ri = ai * HALF + wr * 64 + m * 16 + fr, rank = u.rank0 + ri; const float s = rank < n ? lrs[(size_t)e * CAP + rank] : 0.f;
                const f32x4 a0 = acc[ai][0][m][0] * s, a1 = acc[ai][0][m][1] * s, b0 = acc[ai][1][m][0] * s, b1 = acc[ai][1][m][1] * s;
                *(u32x4*)(hmid + (size_t)(u.pm * 256 + ri) * DFF + 128 * u.pn + coff) = pack8(a0 * sig4(a0) * b0, a1 * sig4(a1) * b1);
            }
    }
};
struct EpiDown {
    static constexpr bool PERM = true, AFTER_DRAIN = false; static constexpr int MIDK = 0;
    const float* lw; const LAS int* cnt; bf16_t* y;
    __device__ __forceinline__ void operator()(const f32x4 (&acc)[2][2][4][2], const Unit& u, int wr, int wc, int fr, int fq) const {
        const int e = u.aux, n = __builtin_amdgcn_readfirstlane(cnt[e]); const int col0 = u.pn * BM + wc * 32 + 8 * fq;
#pragma unroll
        for (int ai = 0; ai < 2; ++ai)
#pragma unroll
            for (int m = 0; m < 4; ++m) {
                const int ri = ai * HALF + wr * 64 + m * 16 + fr, rank = u.rank0 + ri; const float s = rank < n ? lw[(size_t)e * CAP + rank] : 0.f;
                bf16_t* yp = y + (size_t)(u.pm * 256 + ri) * D + col0;
                *(u32x4*)yp = pack8(acc[ai][0][m][0] * s, acc[ai][0][m][1] * s); *(u32x4*)(yp + HALF) = pack8(acc[ai][1][m][0] * s, acc[ai][1][m][1] * s);
            }
    }
};
}

__device__ __forceinline__ void final_phase(CParams& p, const bf16_t* hb, const bf16_t* y, const int* toke, const int* tokr, float* outp, LAS unsigned char* lds, const int wave_s) {
    const int tidx = opaque_tid(wave_s), lane = tidx & 63, gw = blockIdx.x * (NT / 64) + (tidx >> 6), NGW = gridDim.x * (NT / 64);
    const LAS int* nbp = (const LAS int*)(lds + MOE_NBP_OFF);
    for (int m = gw; m < T; m += NGW) {
        const int ea = toke[2 * m], eb = toke[2 * m + 1];
        const size_t sa = (size_t)nbp[ea] * 256 + tokr[2 * m], sb = (size_t)nbp[eb] * 256 + tokr[2 * m + 1];
        const u32x2* xr = (const u32x2*)(hb + (size_t)m * D) + lane; const u32x2* ya = (const u32x2*)(y + sa * D) + lane; const u32x2* yb = (const u32x2*)(y + sb * D) + lane;
        f32x4 v[4]; float s = 0.f;
#pragma unroll
        for (int j = 0; j < 4; ++j) { const u32x2 h2 = xr[64 * j], a = ya[64 * j], b = yb[64 * j];
            v[j] = (f32x4){bf_lo(h2.x), bf_hi(h2.x), bf_lo(h2.y), bf_hi(h2.y)} + (f32x4){bf_lo(a.x), bf_hi(a.x), bf_lo(a.y), bf_hi(a.y)} + (f32x4){bf_lo(b.x), bf_hi(b.x), bf_lo(b.y), bf_hi(b.y)};
            s += (v[j][0] * v[j][0] + v[j][1] * v[j][1]) + (v[j][2] * v[j][2] + v[j][3] * v[j][3]); }
        const float rstd = rsqrtf(wave_sum(s) * (1.f / D) + EPS);
        f32x4* o = (f32x4*)(outp + (size_t)m * D) + lane;
#pragma unroll
        for (int j = 0; j < 4; ++j) o[64 * j] = v[j] * rstd * ((const f32x4*)p.g_final)[lane + 64 * j];
    }
}


__global__ void __launch_bounds__(NT, 2) k_all(Params p_arg) {
    CParams* pp_ = (CParams*)__builtin_amdgcn_kernarg_segment_ptr(); asm volatile("" : "+s"(pp_)); CParams& p = *pp_;
    extern __shared__ __attribute__((aligned(16))) unsigned char lds_raw[];
    LAS unsigned char* lds = (LAS unsigned char*)lds_raw;
    volatile LAS unsigned* MISC = (volatile LAS unsigned*)(lds + MISC_OFF);
    const int wave_s = __builtin_amdgcn_readfirstlane((int)threadIdx.x >> 6);
    if (threadIdx.x < 32) MISC[threadIdx.x] = 0u;
    __syncthreads();
    unsigned char* ws = p.ws;
    unsigned* ctl = (unsigned*)(ws + WS_CTL);
    XcdBarrier bar = xcd_barrier_post(ctl + CW_BAR, MISC, wave_s == 0);
    const int G = gridDim.x;

    bf16_t* wt_in = (bf16_t*)(ws + WS_WT_IN); bf16_t* wt_mix = (bf16_t*)(ws + WS_WT_MIX); bf16_t* wt_out = (bf16_t*)(ws + WS_WT_OUT);
    bf16_t* xb = (bf16_t*)(ws + WS_XB); bf16_t* merged = (bf16_t*)(ws + WS_MERGED); float* rstd1 = (float*)(ws + WS_RSTD1);
    bf16_t* vglu = (bf16_t*)(ws + WS_VGLU); bf16_t* qb = (bf16_t*)(ws + WS_QB); bf16_t* kvb = (bf16_t*)(ws + WS_KVB);
    bf16_t* sgc = (bf16_t*)(ws + WS_SGC); bf16_t* sga = (bf16_t*)(ws + WS_SGA); bf16_t* mix = (bf16_t*)(ws + WS_MIX); bf16_t* cact = mix; bf16_t* att = mix + CC;
    bf16_t* delta = (bf16_t*)(ws + WS_DELTA);

#ifndef ENABLE
#define ENABLE 0xff
#endif
#ifndef REPEAT
#define REPEAT 0
#endif
#define BARX() do { xcd_barrier(bar); if ((REPEAT >> 15) & 1) xcd_barrier(bar); } while (0)
#define REP(k) _Pragma("unroll") for (int rep_ = 0; rep_ < 1 + ((REPEAT >> (k)) & 1); ++rep_)
    asm volatile("; PHASE_MARK 0");
    REP(0) if (ENABLE & 1) { p0_prologue(p, lds, wave_s); p0_moe_weights(p, lds, wave_s); }
    BARX();
    asm volatile("; PHASE_MARK 1");
    REP(1) if (ENABLE & 2) { pg8::DenseSched S; S.init(xb, wt_in, T, INC, D, G, (int)blockIdx.x);
      pg8::EpiProj E{rstd1, vglu, qb, kvb, sgc, sga, 0.125f * LOG2E};
      pg8::gemm_phase<pg8::EpiProj, pg8::DenseSched, true, true>(lds, D, S, E, wave_s); }
    BARX();
    asm volatile("; PHASE_MARK 2");
    REP(2) if (ENABLE & 4) conv_phase(p, vglu, cact, lds, wave_s);
    asm volatile("; PHASE_MARK 3");
    REP(3) if (ENABLE & 8) attn_phase(p, qb, kvb, att, lds, wave_s);
    BARX();
    asm volatile("; PHASE_MARK 4");
    REP(4) if (ENABLE & 16) { pg8::DenseSched S; S.init(mix, wt_mix, T, D, D, G, (int)blockIdx.x);
      pg8::EpiMerge E{sgc, sga, merged};
      pg8::gemm_phase<pg8::EpiMerge, pg8::DenseSched, true, true>(lds, D, S, E, wave_s); }
    BARX();
    asm volatile("; PHASE_MARK 6");
    REP(5) if (ENABLE & 32) { pg8::DenseSched S; S.init(merged, wt_out, T, D, D, G, (int)blockIdx.x);
      pg8::EpiDelta E{delta};
      pg8::gemm_phase<pg8::EpiDelta, pg8::DenseSched, true, true>(lds, D, S, E, wave_s); }
    BARX();
    bf16_t* hb = (bf16_t*)(ws + WS_HB); bf16_t* hmid = (bf16_t*)(ws + WS_HMID); bf16_t* y = (bf16_t*)(ws + WS_Y);
    int* toke = (int*)(ws + WS_TOKE); int* tokr = (int*)(ws + WS_TOKR); int* ltok = (int*)(ws + WS_LTOK); float* lrs = (float*)(ws + WS_LRS); float* lw = (float*)(ws + WS_LW);
    unsigned* gcount = ctl + CW_CNT;
    asm volatile("; PHASE_MARK 7");
    if ((REPEAT >> 7) & 1) { unsigned char* sc = ws + WS_VGLU + 64 * MiB;
        route_phase_fast(p, p.x, delta, hb, (int*)(sc), (int*)(sc + 1 * MiB), (int*)(sc + 2 * MiB), (float*)(sc + 6 * MiB), (float*)(sc + 10 * MiB), gcount + 64, lds, wave_s); }
    route_phase_fast(p, p.x, delta, hb, toke, tokr, ltok, lrs, lw, gcount, lds, wave_s);
    BARX();
    asm volatile("; PHASE_MARK 8");
    REP(8) { const int tid = opaque_tid(wave_s);
      moe_build_map(gcount, lds, tid); moe_build_units(ltok, lds, G, (int)blockIdx.x, tid, true);
      pg8::MoeSched S{(const LAS int*)(lds + MOE_UT_OFF), (const LAS unsigned*)(lds + MOE_TBL_OFF), (const LAS int*)(lds + MOE_NBP_OFF), (const char*)hb, (const char*)(ws + WS_WT_GU), G, (int)blockIdx.x, D, true};
      pg8::EpiSwiglu E{lrs, (const LAS int*)(lds + MOE_CNT_OFF), hmid};
      pg8::gemm_phase<pg8::EpiSwiglu, pg8::MoeSched, true, true>(lds, D, S, E, wave_s); }
    BARX();
    asm volatile("; PHASE_MARK 9");
    REP(9) { const int tid = opaque_tid(wave_s);
      moe_build_map(gcount, lds, tid); moe_build_units(ltok, lds, G, (int)blockIdx.x, tid, false);
      pg8::MoeSched S{(const LAS int*)(lds + MOE_UT_OFF), (const LAS unsigned*)(lds + MOE_TBL_OFF), (const LAS int*)(lds + MOE_NBP_OFF), (const char*)hmid, (const char*)(ws + WS_WT_D), G, (int)blockIdx.x, DFF, false};
      pg8::EpiDown E{lw, (const LAS int*)(lds + MOE_CNT_OFF), y};
      pg8::gemm_phase<pg8::EpiDown, pg8::MoeSched, true, true>(lds, DFF, S, E, wave_s); }
    BARX();
    asm volatile("; PHASE_MARK 10");
    { const int tid = opaque_tid(wave_s); moe_build_map(gcount, lds, tid); }
    if ((REPEAT >> 10) & 1) final_phase(p, hb, y, toke, tokr, p.out, lds, wave_s);
    final_phase(p, hb, y, toke, tokr, p.out, lds, wave_s);
}

extern "C" void kernel_launch(void* const* d_in, const int* in_sizes, int n_in, void* d_out, int out_size, void* d_ws, size_t ws_size, hipStream_t stream) {
    static int grid = 0;
    if (grid == 0) {
        if (n_in != 20 || in_sizes[0] != T * D || out_size != T * D || ws_size < WS_END) {
            fprintf(stderr, "kernel_launch: unexpected shapes (n_in %d, in0 %d, out %d, ws %zu); nothing launched\n", n_in, n_in > 0 ? in_sizes[0] : -1, out_size, ws_size); grid = -1; return; }
        int dev = 0, cus = 0, per_cu = 0;
        if (hipGetDevice(&dev) != hipSuccess || hipDeviceGetAttribute(&cus, hipDeviceAttributeMultiprocessorCount, dev) != hipSuccess) { grid = -1; return; }
        if (hipFuncSetAttribute((const void*)k_all, hipFuncAttributeMaxDynamicSharedMemorySize, LDS_BYTES) != hipSuccess) { fprintf(stderr, "kernel_launch: hipFuncSetAttribute failed\n"); grid = -1; return; }
        if (hipOccupancyMaxActiveBlocksPerMultiprocessor(&per_cu, (const void*)k_all, NT, LDS_BYTES) != hipSuccess || per_cu < 1)
            fprintf(stderr, "kernel_launch: note: occupancy query reports %d workgroups per CU\n", per_cu);
        (void)hipGetLastError();
        grid = cus;
    }
    if (grid < 0) return;
    if (hipMemsetAsync((char*)d_ws + WS_CTL, 0, CTL_BYTES, stream) != hipSuccess) return;
    Params p{};
    const float** pp = (const float**)&p;
    for (int i = 0; i < 20; ++i) pp[i] = (const float*)d_in[i];
    p.out = (float*)d_out; p.ws = (unsigned char*)d_ws;
    hipLaunchKernelGGL(k_all, dim3(grid), dim3(NT), LDS_BYTES, stream, p);
}
```

```cpp
#include <hip/hip_runtime.h>
#include <cstdio>
#include <cstdint>

constexpr int T = 32768, D = 1024, SEQ = 4096;
constexpr int CC = 512, CW = 31, NH = 8, HD = 64, QD = 512, KVD = 128, INC = 3840;
constexpr int NE = 32, NG = 4, EPG = 8, DFF = 512;
constexpr float EPS = 1e-6f;
constexpr int NT = 512;
constexpr float LOG2E = 1.4426950408889634f;

#define GAS __attribute__((address_space(1)))
#define LAS __attribute__((address_space(3)))
typedef unsigned short bf16_t;
typedef short bf16x8 __attribute__((ext_vector_type(8)));
typedef float f32x4 __attribute__((ext_vector_type(4)));
typedef float f32x16 __attribute__((ext_vector_type(16)));
typedef unsigned u32x4 __attribute__((ext_vector_type(4)));
typedef unsigned u32x2 __attribute__((ext_vector_type(2)));

__device__ __forceinline__ int lane_id_v() { int l; asm volatile("v_mbcnt_lo_u32_b32 %0, -1, 0\n\tv_mbcnt_hi_u32_b32 %0, -1, %0" : "=v"(l)); return l; }
__device__ __forceinline__ int opaque_tid(int wave_s) { return wave_s * 64 + lane_id_v(); }
__device__ __forceinline__ int opaque_i(int v) { asm volatile("" : "+v"(v)); return v; }
__device__ __forceinline__ float wave_sum(float v) {
#pragma unroll
    for (int o = 1; o < 64; o <<= 1) v += __shfl_xor(v, o);
    return v;
}
__device__ __forceinline__ float sigmoidf_(float v) { return 1.f / (1.f + __expf(-v)); }
__device__ __forceinline__ float fsig(float v) { return __builtin_amdgcn_rcpf(1.f + __builtin_amdgcn_exp2f(-LOG2E * v)); }
__device__ __forceinline__ unsigned cvt_pk_bf16(float lo, float hi) { unsigned r; asm volatile("v_cvt_pk_bf16_f32 %0, %1, %2" : "=v"(r) : "v"(lo), "v"(hi)); return r; }
__device__ __forceinline__ float bf_lo(unsigned w) { return __uint_as_float(w << 16); }
__device__ __forceinline__ float bf_hi(unsigned w) { return __uint_as_float(w & 0xffff0000u); }

namespace pg8 {
#define PG8_LAS __attribute__((address_space(3)))
constexpr int BM = 256, BK = 64, HALF = 128, HTB = HALF * BK * 2  , STAGE_BYTES = 8 * HTB, NXCD = 8, WGM = 8;

__host__ __device__ __forceinline__ int lds_byte(int r, int c) { const int st = (r >> 4) * 2 + (c >> 5), rr = r & 15, cc = c & 31, ob = rr * 64 + cc * 2; return st * 1024 + (ob ^ (((ob >> 9) & 1) << 5)); }
__host__ __device__ __forceinline__ void stage_rc(int b, int& R, int& C) { const int st = b / 1024, sb = b % 1024, swz = sb ^ (((sb >> 9) & 1) << 5); R = (st >> 1) * 16 + swz / 64; C = (st & 1) * 32 + (swz % 64) / 2; }
__host__ __device__ __forceinline__ int perm32(int rho) { const int n = rho >> 4, i = rho & 15; return 8 * (i >> 2) + 4 * n + (i & 3); }

struct Unit { int pm, pn; const char* a; const char* b; int aux, rank0; };

struct StaticOrder {
    int nM, nN, nwg, G, c;
    __host__ __device__ void init(int M, int N, int G_, int c_) { nM = M / BM; nN = N / BM; nwg = nM * nN; G = G_; c = c_; }
    __host__ __device__ bool next_mn(int i, int& pm, int& pn) const {
        const long L = (long)i * G + c; if (L >= nwg) return false;
        int wgid = (int)L; { const int q = nwg / NXCD, r = nwg % NXCD, xcd = wgid % NXCD, off = wgid / NXCD; wgid = (xcd < r ? xcd * (q + 1) : r * (q + 1) + (xcd - r) * q) + off; }
        const int nig = WGM * nN, gid = wgid / nig, fm = gid * WGM, gsz = (nM - fm) < WGM ? (nM - fm) : WGM;
        pm = fm + ((wgid % nig) % gsz); pn = (wgid % nig) / gsz; return true;
    }
};
struct DenseSched {
    StaticOrder so; const char* A; const char* Bt; size_t tstep;
    __device__ __forceinline__ void init(const bf16_t* A_, const bf16_t* Bt_, int M, int N, int K, int G, int c) { so.init(M, N, G, c); A = (const char*)A_; Bt = (const char*)Bt_; tstep = (size_t)BM * K * 2; }
    __device__ __forceinline__ bool next(int i, Unit& u) const { if (!so.next_mn(i, u.pm, u.pn)) return false; u.a = A + (size_t)u.pm * tstep; u.b = Bt + (size_t)u.pn * tstep; u.aux = 0; u.rank0 = 0; return true; }
    __device__ __forceinline__ void a_voff(const Unit&, int, int tid, int K, unsigned (&v)[2][2]) const {
#pragma unroll
        for (int i = 0; i < 2; ++i) { int R, C; stage_rc(tid * 16 + i * 8192, R, C); v[0][i] = (unsigned)(R * K + C) * 2u; v[1][i] = (unsigned)((HALF + R) * K + C) * 2u; } }
    __device__ __forceinline__ void a_ready(const Unit&) const {}
    __device__ __forceinline__ void done(const Unit&) const {}
};

template <class Epi, class Sched, bool ALIGN_EPI = false, bool SP2 = false>
__device__ __forceinline__ void gemm_phase(PG8_LAS unsigned char* lds, const int K_, const Sched& S, const Epi& E, const int wave_s) {
    const int tid_ = opaque_tid(wave_s); const int tid = tid_, wid = __builtin_amdgcn_readfirstlane(tid >> 6), lane = tid & 63, wr = wid >> 2, wc = wid & 3, fr = lane & 15, fq = lane >> 4;
    const int K = K_, nt = K / BK;
    unsigned voffB[2]; unsigned vC[2][2], vN[2][2];
#pragma unroll
    for (int i = 0; i < 2; ++i) { int R, C; stage_rc(tid * 16 + i * 8192, R, C); const int Rb = Epi::PERM ? ((R & ~31) + perm32(R & 31)) : R;
        voffB[i] = (unsigned)(Rb * K + C) * 2u; }
    const size_t kstep = (size_t)(BK * 2);
    const size_t hstep = (size_t)HALF * K * 2;
    const unsigned ldsw = (unsigned)wid * 1024u;
    const int aoff = lds_byte(wr * 64 + fr, fq * 8), boff = lds_byte(wc * 32 + fr, fq * 8);
#define PG8_SA(b, h) (((b) * 2 + (h)) * HTB)
#define PG8_SB(b, h) ((4 + (b) * 2 + (h)) * HTB)
#define PG8_STAGE(bufoff, gbase, voff) do { _Pragma("unroll") for (int _i = 0; _i < 2; ++_i) \
        __builtin_amdgcn_global_load_lds((const unsigned*)((const char*)(gbase) + (voff)[_i]), (PG8_LAS unsigned*)(lds + (bufoff) + ldsw + _i * 8192), 16, 0, 0); } while (0)
#define PG8_LDA(dst, b, h) do { _Pragma("unroll") for (int m = 0; m < 4; ++m) _Pragma("unroll") for (int k = 0; k < 2; ++k) dst[m][k] = *(const PG8_LAS bf16x8*)(lds + PG8_SA(b, h) + aoff + m * 2048 + k * 1024); } while (0)
#define PG8_LDB(dst, b, h) do { _Pragma("unroll") for (int n = 0; n < 2; ++n) _Pragma("unroll") for (int k = 0; k < 2; ++k) dst[n][k] = *(const PG8_LAS bf16x8*)(lds + PG8_SB(b, h) + boff + n * 2048 + k * 1024); } while (0)
#define PG8_MMA(ai, bj, At, Bt) do { __builtin_amdgcn_s_setprio(1); _Pragma("unroll") for (int m = 0; m < 4; ++m) _Pragma("unroll") for (int n = 0; n < 2; ++n) _Pragma("unroll") for (int k = 0; k < 2; ++k) \
        acc[ai][bj][m][n] = __builtin_amdgcn_mfma_f32_16x16x32_bf16(Bt[n][k], At[m][k], acc[ai][bj][m][n], 0, 0, 0); __builtin_amdgcn_s_setprio(0); } while (0)
#define PG8_WAIT_V(n) asm volatile("s_waitcnt vmcnt(" #n ")" ::: "memory")
#define PG8_WAIT_L(n) asm volatile("s_waitcnt lgkmcnt(" #n ")" ::: "memory")
#define PG8_BAR __builtin_amdgcn_s_barrier()
#define PG8_SCHED __builtin_amdgcn_sched_barrier(0)
    Unit cur, nxt; int ui = 0;
    if (!S.next(0, cur)) return;
    S.a_voff(cur, 0, tid, K, vC);
    f32x4 acc[2][2][4][2];
#pragma unroll
    for (int a = 0; a < 2; ++a)
#pragma unroll
        for (int b = 0; b < 2; ++b)
#pragma unroll
            for (int m = 0; m < 4; ++m)
#pragma unroll
                for (int n = 0; n < 2; ++n) acc[a][b][m][n] = (f32x4){0.f, 0.f, 0.f, 0.f};
    bf16x8 At[4][2], B0[2][2], B1[2][2];
    const char* cA = cur.a; const char* cB = cur.b;
    S.a_ready(cur);
    if constexpr (SP2) {
        PG8_STAGE(PG8_SB(0, 0), cB, voffB); PG8_STAGE(PG8_SB(0, 1), cB + hstep, voffB); PG8_STAGE(PG8_SA(0, 0), cA, vC[0]); PG8_STAGE(PG8_SA(0, 1), cA, vC[1]);
        if (wr == 1) PG8_BAR;
        PG8_WAIT_V(2); PG8_BAR;
        PG8_STAGE(PG8_SB(1, 0), cB + kstep, voffB); PG8_STAGE(PG8_SA(1, 0), cA + kstep, vC[0]); PG8_STAGE(PG8_SB(1, 1), cB + hstep + kstep, voffB);
        PG8_WAIT_V(6); PG8_BAR;
    } else {
        PG8_STAGE(PG8_SB(0, 0), cB, voffB); PG8_STAGE(PG8_SA(0, 0), cA, vC[0]); PG8_STAGE(PG8_SB(0, 1), cB + hstep, voffB); PG8_STAGE(PG8_SA(0, 1), cA, vC[1]);
        if (wr == 1) PG8_BAR;
        PG8_WAIT_V(4); PG8_BAR;
        PG8_STAGE(PG8_SB(1, 0), cB + kstep, voffB); PG8_STAGE(PG8_SA(1, 0), cA + kstep, vC[0]); PG8_STAGE(PG8_SB(1, 1), cB + hstep + kstep, voffB);
        PG8_WAIT_V(6); PG8_BAR;
    }
    for (;;) {
        const bool has_next = S.next(ui + 1, nxt);
        if (has_next) S.a_voff(nxt, ui + 1, tid, K, vN); else { vN[0][0] = vC[0][0]; vN[0][1] = vC[0][1]; vN[1][0] = vC[1][0]; vN[1][1] = vC[1][1]; }
        const char* nA = has_next ? nxt.a : cA; const char* nB = has_next ? nxt.b : cB;
        for (int t = 0; t < nt; t += 2) {
            const bool last = (t == nt - 2);
            unsigned v2[2][2]; v2[0][0] = last ? vN[0][0] : vC[0][0]; v2[0][1] = last ? vN[0][1] : vC[0][1]; v2[1][0] = last ? vN[1][0] : vC[1][0]; v2[1][1] = last ? vN[1][1] : vC[1][1];
            const char* a1 = cA + (size_t)(t + 1) * kstep;
            const char* a2 = last ? nA : cA + (size_t)(t + 2) * kstep; const char* b2 = last ? nB : cB + (size_t)(t + 2) * kstep;
            const char* a3 = a2 + kstep; const char* b3 = b2 + kstep;
            if (last && has_next) S.a_ready(nxt);
            if constexpr (Epi::MIDK > 0) { if (t == Epi::MIDK) E.mid(acc, cur, wr, wc, fr, fq); }
            if constexpr (SP2) {
            PG8_LDB(B0, 0, 0); PG8_LDB(B1, 0, 1); PG8_SCHED; PG8_LDA(At, 0, 0); PG8_STAGE(PG8_SA(1, 1), a1, vC[1]);
            PG8_WAIT_V(8); PG8_WAIT_L(0); PG8_BAR; PG8_MMA(0, 0, At, B0); PG8_MMA(0, 1, At, B1); PG8_BAR; PG8_SCHED;
            PG8_LDA(At, 0, 1); PG8_STAGE(PG8_SB(0, 0), b2, voffB); PG8_STAGE(PG8_SB(0, 1), b2 + hstep, voffB); PG8_STAGE(PG8_SA(0, 0), a2, v2[0]);
            PG8_WAIT_V(8); PG8_WAIT_L(0); PG8_BAR; PG8_MMA(1, 0, At, B0); PG8_MMA(1, 1, At, B1); PG8_BAR; PG8_SCHED;
            PG8_LDB(B0, 1, 0); PG8_LDB(B1, 1, 1); PG8_SCHED; PG8_LDA(At, 1, 0); PG8_STAGE(PG8_SA(0, 1), a2, v2[1]);
            PG8_WAIT_V(8); PG8_WAIT_L(0); PG8_BAR; PG8_MMA(0, 0, At, B0); PG8_MMA(0, 1, At, B1); PG8_BAR; PG8_SCHED;
            PG8_LDA(At, 1, 1); PG8_STAGE(PG8_SB(1, 0), b3, voffB); PG8_STAGE(PG8_SB(1, 1), b3 + hstep, voffB); PG8_STAGE(PG8_SA(1, 0), a3, v2[0]);
            PG8_WAIT_V(8); PG8_WAIT_L(0); PG8_BAR; PG8_MMA(1, 0, At, B0); PG8_MMA(1, 1, At, B1); PG8_BAR; PG8_SCHED;
            } else {
            PG8_LDB(B0, 0, 0); PG8_SCHED; PG8_LDA(At, 0, 0); PG8_STAGE(PG8_SA(1, 1), a1, vC[1]);
            PG8_WAIT_L(8); PG8_BAR; PG8_WAIT_L(0); PG8_MMA(0, 0, At, B0); PG8_BAR; PG8_SCHED;
            PG8_LDB(B1, 0, 1); PG8_STAGE(PG8_SB(0, 0), b2, voffB);
            PG8_BAR; PG8_WAIT_L(0); PG8_MMA(0, 1, At, B1); PG8_BAR;
            PG8_LDA(At, 0, 1); PG8_STAGE(PG8_SA(0, 0), a2, v2[0]);
            PG8_BAR; PG8_WAIT_L(0); PG8_MMA(1, 0, At, B0); PG8_BAR; PG8_SCHED;
            PG8_STAGE(PG8_SB(0, 1), b2 + hstep, voffB);
            PG8_WAIT_V(6); PG8_BAR; PG8_MMA(1, 1, At, B1); PG8_BAR;
            PG8_LDB(B0, 1, 0); PG8_SCHED; PG8_LDA(At, 1, 0); PG8_STAGE(PG8_SA(0, 1), a2, v2[1]);
            PG8_WAIT_L(8); PG8_BAR; PG8_WAIT_L(0); PG8_MMA(0, 0, At, B0); PG8_BAR; PG8_SCHED;
            PG8_LDB(B1, 1, 1); PG8_STAGE(PG8_SB(1, 0), b3, voffB);
            PG8_BAR; PG8_WAIT_L(0); PG8_MMA(0, 1, At, B1); PG8_BAR;
            PG8_LDA(At, 1, 1); PG8_STAGE(PG8_SA(1, 0), a3, v2[0]);
            PG8_BAR; PG8_WAIT_L(0); PG8_MMA(1, 0, At, B0); PG8_BAR; PG8_SCHED;
            PG8_STAGE(PG8_SB(1, 1), b3 + hstep, voffB);
            PG8_WAIT_V(6); PG8_BAR; PG8_MMA(1, 1, At, B1); PG8_BAR;
            }
        }
        if constexpr (ALIGN_EPI) { if (wr == 0) PG8_BAR; }
        if constexpr (!Epi::AFTER_DRAIN) { E(acc, cur, wr, wc, fr, fq); S.done(cur); }
        if (!has_next) break;
#pragma unroll
        for (int a = 0; a < 2; ++a)
#pragma unroll
            for (int b = 0; b < 2; ++b)
#pragma unroll
                for (int m = 0; m < 4; ++m)
#pragma unroll
                    for (int n = 0; n < 2; ++n) acc[a][b][m][n] = (f32x4){0.f, 0.f, 0.f, 0.f};
        cur = nxt; cA = nA; cB = nB; ++ui; vC[0][0] = vN[0][0]; vC[0][1] = vN[0][1]; vC[1][0] = vN[1][0]; vC[1][1] = vN[1][1];
        if constexpr (ALIGN_EPI) { if (wr == 1) PG8_BAR; }
    }
    PG8_WAIT_V(0);
    if constexpr (!ALIGN_EPI) { if (wr == 0) PG8_BAR; }
    PG8_BAR;
    if constexpr (Epi::AFTER_DRAIN) { E.fused(acc, cur, wr, wc, fr, fq, lds, wid, lane); S.done(cur); }
#undef PG8_SA
#undef PG8_SB
#undef PG8_STAGE
#undef PG8_LDA
#undef PG8_LDB
#undef PG8_MMA
#undef PG8_WAIT_V
#undef PG8_WAIT_L
#undef PG8_BAR
#undef PG8_SCHED
}

__device__ __forceinline__ u32x4 pack8(const f32x4 v0, const f32x4 v1) { u32x4 w; w.x = cvt_pk_bf16(v0[0], v0[1]); w.y = cvt_pk_bf16(v0[2], v0[3]); w.z = cvt_pk_bf16(v1[0], v1[1]); w.w = cvt_pk_bf16(v1[2], v1[3]); return w; }
__device__ __forceinline__ f32x4 sig4(const f32x4 v) { return (f32x4){fsig(v[0]), fsig(v[1]), fsig(v[2]), fsig(v[3])}; }

struct EpiProj {
    static constexpr bool PERM = true, AFTER_DRAIN = false; static constexpr int MIDK = 0;
    const float* rstd; bf16_t *vglu, *qb, *kvb, *sgc, *sga; float qscale;
    __device__ __forceinline__ void operator()(const f32x4 (&acc)[2][2][4][2], const Unit& u, int wr, int wc, int fr, int fq) const {
        const int pn = __builtin_amdgcn_readfirstlane(u.pn); const int coff = wc * 32 + 8 * fq; const int row0 = u.pm * BM + wr * 64 + fr;
#pragma unroll
        for (int ai = 0; ai < 2; ++ai)
#pragma unroll
            for (int m = 0; m < 4; ++m) {
                const int r = row0 + ai * HALF + m * 16; const float s = rstd[r];
                const f32x4 a0 = acc[ai][0][m][0] * s, a1 = acc[ai][0][m][1] * s, b0 = acc[ai][1][m][0] * s, b1 = acc[ai][1][m][1] * s;
                if (pn < 4) {
                    *(u32x4*)(vglu + (size_t)r * CC + 128 * pn + coff) = pack8(a0 * sig4(b0), a1 * sig4(b1));
                } else if (pn < 6) {
                    bf16_t* qp = qb + (size_t)r * QD + 256 * (pn - 4) + coff;
                    *(u32x4*)qp = pack8(a0 * qscale, a1 * qscale); *(u32x4*)(qp + HALF) = pack8(b0 * qscale, b1 * qscale);
                } else if (pn == 6) {
                    bf16_t* kp = kvb + (size_t)r * 256 + coff;
                    *(u32x4*)kp = pack8(a0, a1); *(u32x4*)(kp + HALF) = pack8(b0, b1);
                } else {
                    const size_t o = (size_t)r * D + 128 * (pn - 7) + coff;
                    const f32x4 s0 = sig4(b0), s1 = sig4(b1);
                    *(u32x4*)(sgc + o) = pack8(sig4(a0) / s0, sig4(a1) / s1); *(u32x4*)(sga + o) = pack8(s0, s1);
                }
            }
    }
};
struct EpiMerge {
    static constexpr bool PERM = true, AFTER_DRAIN = false; static constexpr int MIDK = 8;
    const bf16_t* R; const bf16_t* G; bf16_t* O;
    __device__ __forceinline__ void mid(f32x4 (&acc)[2][2][4][2], const Unit& u, int wr, int wc, int fr, int fq) const {
        const char* Rb = (const char*)R + (size_t)u.pm * BM * D * 2;
        const unsigned ob = (unsigned)((wr * 64 + opaque_i(fr)) * D + u.pn * BM + wc * 32 + 8 * fq) * 2u;
#pragma unroll
        for (int ai = 0; ai < 2; ++ai)
#pragma unroll
            for (int m = 0; m < 4; ++m) {
#pragma unroll
                for (int bj = 0; bj < 2; ++bj) { const u32x4 g = *(const u32x4*)(Rb + (ob + (unsigned)(((ai * HALF + m * 16) * D + bj * HALF) * 2)));
                    acc[ai][bj][m][0] *= (f32x4){bf_lo(g.x), bf_hi(g.x), bf_lo(g.y), bf_hi(g.y)}; acc[ai][bj][m][1] *= (f32x4){bf_lo(g.z), bf_hi(g.z), bf_lo(g.w), bf_hi(g.w)}; }
                if (m == 3) asm volatile("" ::: "memory");
            }
    }
    __device__ __forceinline__ void operator()(const f32x4 (&acc)[2][2][4][2], const Unit& u, int wr, int wc, int fr, int fq) const {
        const int row0 = u.pm * BM + wr * 64 + opaque_i(fr), col0 = u.pn * BM + wc * 32 + 8 * fq;
#pragma unroll
        for (int ai = 0; ai < 2; ++ai)
#pragma unroll
            for (int m = 0; m < 4; ++m) {
                const size_t o = (size_t)(row0 + ai * HALF + m * 16) * D + col0;
#pragma unroll
                for (int bj = 0; bj < 2; ++bj) { const u32x4 g = *(const u32x4*)(G + o + bj * HALF);
                    *(u32x4*)(O + o + bj * HALF) = pack8(acc[ai][bj][m][0] * (f32x4){bf_lo(g.x), bf_hi(g.x), bf_lo(g.y), bf_hi(g.y)}, acc[ai][bj][m][1] * (f32x4){bf_lo(g.z), bf_hi(g.z), bf_lo(g.w), bf_hi(g.w)}); }
                if (m & 1) asm volatile("" ::: "memory");
            }
    }
};
struct EpiDelta {
    static constexpr bool PERM = true, AFTER_DRAIN = false; static constexpr int MIDK = 0;
    bf16_t* O;
    __device__ __forceinline__ void operator()(const f32x4 (&acc)[2][2][4][2], const Unit& u, int wr, int wc, int fr, int fq) const {
        const int row0 = u.pm * BM + wr * 64 + fr, col0 = u.pn * BM + wc * 32 + 8 * fq;
#pragma unroll
        for (int ai = 0; ai < 2; ++ai)
#pragma unroll
            for (int m = 0; m < 4; ++m) {
                bf16_t* op = O + (size_t)(row0 + ai * HALF + m * 16) * D + col0;
                *(u32x4*)op = pack8(acc[ai][0][m][0], acc[ai][0][m][1]); *(u32x4*)(op + HALF) = pack8(acc[ai][1][m][0], acc[ai][1][m][1]);
            }
    }
};
}


constexpr size_t MiB = 1u << 20;
constexpr size_t WS_CTL = 0, CTL_BYTES = 1 * MiB;
constexpr size_t WS_WT_IN = 2 * MiB;
constexpr size_t WS_WT_MIX = 10 * MiB;
constexpr size_t WS_WT_OUT = 12 * MiB;
constexpr size_t WS_WT_GU = 16 * MiB;
constexpr size_t WS_WT_D = 80 * MiB;
constexpr size_t WS_RSTD1 = 112 * MiB;
constexpr size_t WS_TOKE = 113 * MiB;
constexpr size_t WS_TOKR = 113 * MiB + 512 * 1024;
constexpr size_t WS_LTOK = 114 * MiB, WS_LRS = 118 * MiB, WS_LW = 122 * MiB;
constexpr size_t WS_XB = 128 * MiB;
constexpr size_t WS_MERGED = WS_XB;
constexpr size_t WS_VGLU = 192 * MiB;
constexpr size_t WS_QB = 224 * MiB;
constexpr size_t WS_DELTA = 192 * MiB;
constexpr size_t WS_HB = 128 * MiB;
constexpr size_t WS_KVB = 256 * MiB;
constexpr size_t WS_SGC = 272 * MiB, WS_SGA = 336 * MiB;
constexpr size_t WS_Y = 256 * MiB;
constexpr size_t WS_MIX = 400 * MiB;
constexpr size_t WS_HMID = 400 * MiB;
constexpr size_t WS_END = 472 * MiB;
constexpr int CAP = 32768;
constexpr int NSLOT = 2 * T + NE * 256;
static_assert(WS_Y + (size_t)NSLOT * D * 2 <= WS_MIX && WS_HMID + (size_t)NSLOT * DFF * 2 <= WS_END, "d_ws map");
constexpr int CW_BAR = 4096, CW_CNT = 16384;
constexpr int RING_BYTES = 131072, LDS_BYTES = 147456, MISC_OFF = LDS_BYTES - 128;
constexpr int MOE_TBL_OFF = RING_BYTES, MOE_MAXU = 8;
constexpr int MOE_UT_OFF = MOE_TBL_OFF + MOE_MAXU * 1024, MOE_NBP_OFF = MOE_UT_OFF + MOE_MAXU * 16, MOE_CNT_OFF = MOE_NBP_OFF + 160;
static_assert(MOE_CNT_OFF + 128 <= MISC_OFF, "LDS map");

#define XB_TMO      128
#define XB_XCNT(j)  (256  + 64 * (j))
#define XB_XSUB(j)  (1280 + 64 * (j))
#define XB_XGEN(j)  (2304 + 64 * (j))
#define XB_TOP      3328
#define XB_TOPGEN   3392
#define XCD_BAR_WORDS 3456
#define XB_SPIN_CAP (1u << 18)

__device__ __forceinline__ unsigned xb_ld(unsigned* p)              { return __hip_atomic_load(p, __ATOMIC_RELAXED, __HIP_MEMORY_SCOPE_AGENT); }
__device__ __forceinline__ unsigned xb_add(unsigned* p, unsigned v) { return __hip_atomic_fetch_add(p, v, __ATOMIC_RELAXED, __HIP_MEMORY_SCOPE_AGENT); }
__device__ __forceinline__ unsigned xb_xcc_id() { return (unsigned)__builtin_amdgcn_s_getreg((3 << 11) | 20) & 0xFu; }
#define XB_SPIN(cond, bar) do { unsigned _sp = 0; while (cond) { __builtin_amdgcn_s_sleep(1); \
    if ((++_sp & 255u) == 0u) { if (xb_ld(&(bar)[XB_TMO])) break; if (_sp > XB_SPIN_CAP) { atomicAdd(&(bar)[XB_TMO], 1u); break; } } } } while (0)

struct XcdBarrier { unsigned* bar; unsigned x; volatile LAS unsigned* st; bool leader; };

__device__ __forceinline__ XcdBarrier xcd_barrier_post(unsigned* bar, volatile LAS unsigned* st, bool wave0) {
    XcdBarrier b; b.bar = bar; b.x = xb_xcc_id(); b.st = st; b.leader = wave0;
    if (wave0 && lane_id_v() == 0) (void)xb_add(&bar[XB_XCNT(b.x)], 1u);
    return b;
}
__device__ __forceinline__ void xcd_barrier_complete(unsigned* bar, unsigned x, unsigned& nloc, unsigned& nx) {
    const unsigned G = gridDim.x * gridDim.y * gridDim.z;
    unsigned sum, cnt, mine, sp = 0u;
    for (;;) {
        sum = 0u; cnt = 0u; mine = 0u;
#pragma unroll
        for (unsigned j = 0; j < 16; ++j) { const unsigned c = xb_ld(&bar[XB_XCNT(j)]); sum += c; cnt += (c > 0u) ? 1u : 0u; mine = (j == x) ? c : mine; }
        if (sum == G) break;
        __builtin_amdgcn_s_sleep(1);
        if ((++sp & 255u) == 0u) { if (xb_ld(&bar[XB_TMO])) break; if (sp > XB_SPIN_CAP) { atomicAdd(&bar[XB_TMO], 1u); break; } }
    }
    nloc = mine > 0u ? mine : 1u; nx = cnt > 0u ? cnt : 1u;
}
__device__ __forceinline__ void xcd_barrier(const XcdBarrier& b) {
    asm volatile("s_waitcnt vmcnt(0)" ::: "memory");
    __syncthreads();
    if (b.leader && lane_id_v() == 0) {
        unsigned* bar = b.bar;
        __builtin_amdgcn_s_waitcnt(0);
        unsigned nloc = b.st[0], nx = b.st[1];
        if (nloc == 0u) { xcd_barrier_complete(bar, b.x, nloc, nx); b.st[0] = nloc; b.st[1] = nx; }
        const unsigned old = xb_add(&bar[XB_XSUB(b.x)], 1u);
        const unsigned gen = old / nloc;
        if (old + 1u == (gen + 1u) * nloc) {
            __builtin_amdgcn_fence(__ATOMIC_RELEASE, "agent");
            asm volatile("s_waitcnt vmcnt(0)" ::: "memory");
            const unsigned og = xb_add(&bar[XB_TOP], 1u);
            const unsigned tg = og / nx;
            if (og + 1u == (tg + 1u) * nx) xb_add(&bar[XB_TOPGEN], 1u);
            else XB_SPIN(xb_ld(&bar[XB_TOPGEN]) == tg, bar);
            __builtin_amdgcn_fence(__ATOMIC_ACQUIRE, "agent");
            xb_add(&bar[XB_XGEN(b.x)], 1u);
            asm volatile("s_waitcnt vmcnt(0)" ::: "memory");
        } else {
            XB_SPIN(xb_ld(&bar[XB_XGEN(b.x)]) == gen, bar);
            __builtin_amdgcn_fence(__ATOMIC_ACQUIRE, "agent");
            asm volatile("s_waitcnt vmcnt(0)" ::: "memory");
        }
    }
    __syncthreads();
}

struct Params {
    const float *x, *g_mix, *w_in, *w_dw, *b_dw, *ln_g, *ln_b, *sinks, *w_conv_out, *w_attn_out, *w_out, *g_ffn,
                *w_group, *b_group, *w_expert, *b_expert, *w_gate, *w_up, *w_down, *g_final;
    float* out; unsigned char* ws;
};
typedef const __attribute__((address_space(4))) Params CParams;

__device__ __forceinline__ void p0_transpose_item(const float* W, int ld, int srccol, int k0, const float* gain, bf16_t* WT, int K, int dstrow, LAS float* scr, int lane) {
    const int ksub = lane >> 3, n4 = (lane & 7) * 4;
    f32x4 v[8];
#pragma unroll
    for (int i = 0; i < 8; ++i) v[i] = *(const f32x4*)(W + (size_t)(k0 + 8 * i + ksub) * ld + srccol + n4);
    if (gain) {
#pragma unroll
        for (int i = 0; i < 8; ++i) v[i] *= gain[k0 + 8 * i + ksub]; }
#pragma unroll
    for (int i = 0; i < 8; ++i) { LAS float* d = scr + (8 * i + ksub) * 33 + n4; d[0] = v[i][0]; d[1] = v[i][1]; d[2] = v[i][2]; d[3] = v[i][3]; }
    asm volatile("s_waitcnt lgkmcnt(0)" ::: "memory");
    const int c = lane & 7;
#pragma unroll
    for (int j = 0; j < 4; ++j) { const int n = (lane >> 3) + 8 * j; const LAS float* s = scr + (8 * c) * 33 + n;
        u32x4 o; o.x = cvt_pk_bf16(s[0 * 33], s[1 * 33]); o.y = cvt_pk_bf16(s[2 * 33], s[3 * 33]); o.z = cvt_pk_bf16(s[4 * 33], s[5 * 33]); o.w = cvt_pk_bf16(s[6 * 33], s[7 * 33]);
        *(u32x4*)(WT + (size_t)(dstrow + n) * K + k0 + 8 * c) = o; }
    asm volatile("s_waitcnt lgkmcnt(0)" ::: "memory");
}
__device__ __forceinline__ int win_srccol(int np) {
    const int pn = np >> 8, bj = (np >> 7) & 1, o = np & 127;
    if (pn < 4) return (bj ? 512 : 0) + 128 * pn + o;
    if (pn < 6) return 1024 + 256 * (pn - 4) + 128 * bj + o;
    if (pn == 6) return (bj ? 1664 : 1536) + o;
    return (bj ? 2816 : 1792) + 128 * (pn - 7) + o;
}
__device__ __forceinline__ void p0_prologue(CParams& p, LAS unsigned char* lds, const int wave_s) {
    unsigned char* ws = p.ws;
    const int tidx = opaque_tid(wave_s), lane = tidx & 63, wave = tidx >> 6;
    LAS float* scr = (LAS float*)(lds + wave * 16384);
    const int gw = blockIdx.x * (NT / 64) + wave, NGW = gridDim.x * (NT / 64);
    bf16_t* wt_in = (bf16_t*)(ws + WS_WT_IN); bf16_t* wt_mix = (bf16_t*)(ws + WS_WT_MIX); bf16_t* wt_out = (bf16_t*)(ws + WS_WT_OUT);
    constexpr int I_IN = (D / 64) * (INC / 32), I_CO = (CC / 64) * (D / 32), I_AO = (QD / 64) * (D / 32), I_OUT = (D / 64) * (D / 32);
    constexpr int NITEMS = I_IN + I_CO + I_AO + I_OUT;
    for (int it = gw; it < NITEMS; it += NGW) {
        int r = it;
        if (r < I_IN) { const int nblk = INC / 32, kb = r / nblk, nb = r % nblk; p0_transpose_item(p.w_in, INC, win_srccol(32 * nb), 64 * kb, p.g_mix, wt_in, D, 32 * nb, scr, lane); continue; } r -= I_IN;
        if (r < I_CO) { const int nblk = D / 32, kb = r / nblk, nb = r % nblk; p0_transpose_item(p.w_conv_out, D, 32 * nb, 64 * kb, nullptr, wt_mix, D, 32 * nb, scr, lane); continue; } r -= I_CO;
        if (r < I_AO) { const int nblk = D / 32, kb = r / nblk, nb = r % nblk; p0_transpose_item(p.w_attn_out, D, 32 * nb, 64 * kb, nullptr, wt_mix + CC, D, 32 * nb, scr, lane); continue; } r -= I_AO;
        { const int nblk = D / 32, kb = r / nblk, nb = r % nblk; p0_transpose_item(p.w_out, D, 32 * nb, 64 * kb, nullptr, wt_out, D, 32 * nb, scr, lane); }
    }
    bf16_t* xb = (bf16_t*)(ws + WS_XB); float* rstd1 = (float*)(ws + WS_RSTD1);
    for (int m = gw; m < T; m += NGW) {
        const f32x4* xr = (const f32x4*)(p.x + (size_t)m * D) + lane;
        f32x4 v[4]; float s = 0.f;
#pragma unroll
        for (int j = 0; j < 4; ++j) { v[j] = xr[64 * j]; s += (v[j][0] * v[j][0] + v[j][1] * v[j][1]) + (v[j][2] * v[j][2] + v[j][3] * v[j][3]); }
        s = wave_sum(s);
        if (lane == 0) rstd1[m] = rsqrtf(s * (1.f / D) + EPS);
        u32x2* o = (u32x2*)(xb + (size_t)m * D) + lane;
#pragma unroll
        for (int j = 0; j < 4; ++j) { u32x2 w; w.x = cvt_pk_bf16(v[j][0], v[j][1]); w.y = cvt_pk_bf16(v[j][2], v[j][3]); o[64 * j] = w; }
    }
}

template <int N> __device__ __forceinline__ void red_step(float (&v)[16], int lane, int k) {
#pragma unroll
    for (int a = 0; a < N / 2; ++a) { const bool up = (lane & k) != 0; const float send = up ? v[a] : v[a + N / 2], keep = up ? v[a + N / 2] : v[a]; v[a] = keep + __shfl_xor(send, k); }
}
constexpr int CONV_ROWS = 64 + CW - 1;
__device__ __forceinline__ void conv_phase(CParams& p, const bf16_t* vglu, bf16_t* cact, LAS unsigned char* lds, const int wave_s) {
    const int tid = opaque_tid(wave_s), lane = tid & 63, wid = tid >> 6, cp = tid & 255, th = tid >> 8, wq = wid & 3;
    float w0[CW], w1[CW];
#pragma unroll
    for (int j = 0; j < CW; ++j) { w0[j] = p.w_dw[j * CC + 2 * cp]; w1[j] = p.w_dw[j * CC + 2 * cp + 1]; }
    const float bi0 = p.b_dw[2 * cp], bi1 = p.b_dw[2 * cp + 1], lg0 = p.ln_g[2 * cp], lg1 = p.ln_g[2 * cp + 1], lb0 = p.ln_b[2 * cp], lb1 = p.ln_b[2 * cp + 1];
    LAS unsigned char* Vs = lds;
    LAS float* red = (LAS float*)(lds + CONV_ROWS * 1024);
    u32x4 creg[12];
#define CONV_PREFETCH(cbb) do { const int t0_ = (cbb) * 64, seq0_ = (t0_ / SEQ) * SEQ; \
        _Pragma("unroll") for (int j = 0; j < 12; ++j) { const int c = tid + j * NT, row = c >> 6, ch = c & 63, pos = t0_ - (CW - 1) + row; creg[j] = (u32x4){0u, 0u, 0u, 0u}; \
            if (c < CONV_ROWS * 64 && pos >= seq0_) creg[j] = *(const u32x4*)(vglu + (size_t)pos * CC + ch * 8); } } while (0)
    if ((int)blockIdx.x < T / 64) CONV_PREFETCH((int)blockIdx.x);
    for (int cb = blockIdx.x; cb < T / 64; cb += gridDim.x) {
        const int t0 = cb * 64;
        __syncthreads();
#pragma unroll
        for (int j = 0; j < 12; ++j) { const int c = tid + j * NT, row = c >> 6, ch = c & 63; if (c < CONV_ROWS * 64) *(LAS u32x4*)(Vs + row * 1024 + ch * 16) = creg[j]; }
        if (cb + (int)gridDim.x < T / 64) CONV_PREFETCH(cb + (int)gridDim.x);
        __syncthreads();
#pragma unroll 1
        for (int grp = 0; grp < 4; ++grp) {
            float y[8][2]; const int tok0 = 32 * th + 8 * grp;
#pragma unroll
            for (int i = 0; i < 8; ++i) { y[i][0] = bi0; y[i][1] = bi1; }
            { const LAS unsigned char* base = Vs + tok0 * 1024 + cp * 4;
#pragma unroll
                for (int r = 0; r < 8 + CW - 1; ++r) { const unsigned pr = *(const LAS unsigned*)(base + r * 1024); const float lo = bf_lo(pr), hi2 = bf_hi(pr);
#pragma unroll
                    for (int i = 0; i < 8; ++i) { const int j = r - i; if (j >= 0 && j < CW) { y[i][0] = fmaf(w0[j], lo, y[i][0]); y[i][1] = fmaf(w1[j], hi2, y[i][1]); } } } }
            float v[16];
#pragma unroll
            for (int i = 0; i < 8; ++i) { v[i] = y[i][0] + y[i][1]; v[8 + i] = y[i][0] * y[i][0] + y[i][1] * y[i][1]; }
            red_step<16>(v, lane, 32); red_step<8>(v, lane, 16); red_step<4>(v, lane, 8); red_step<2>(v, lane, 4);
            float tot = v[0]; tot += __shfl_xor(tot, 2); tot += __shfl_xor(tot, 1);
            const int idx = ((lane >> 5) & 1) * 8 + ((lane >> 4) & 1) * 4 + ((lane >> 3) & 1) * 2 + ((lane >> 2) & 1);
            LAS float* rb = red + (grp & 1) * 128;
            if ((lane & 3) == 0) rb[(th * 4 + wq) * 16 + idx] = tot;
            __syncthreads();
#pragma unroll
            for (int i = 0; i < 8; ++i) {
                float S = 0.f, Q = 0.f;
#pragma unroll
                for (int q = 0; q < 4; ++q) { S += rb[(th * 4 + q) * 16 + i]; Q += rb[(th * 4 + q) * 16 + 8 + i]; }
                const float mean = S * (1.f / CC), var = Q * (1.f / CC) - mean * mean, rstd = rsqrtf(fmaxf(var, 0.f) + EPS);
                float z0 = (y[i][0] - mean) * rstd * lg0 + lb0, z1 = (y[i][1] - mean) * rstd * lg1 + lb1;
                z0 *= fsig(z0); z1 *= fsig(z1);
                *(unsigned*)(cact + (size_t)(t0 + tok0 + i) * D + 2 * cp) = cvt_pk_bf16(z0, z1);
            }
        }
    }
}

__device__ __forceinline__ int crow(int r, int hi) { return (r & 3) + 8 * (r >> 2) + 4 * hi; }
constexpr int ATT_KS = 144, ATT_VT = 400, ATT_VT_OFF = 192 * ATT_KS;
__device__ __forceinline__ void attn_phase(CParams& p, const bf16_t* qb, const bf16_t* kvb, bf16_t* att, LAS unsigned char* lds, const int wave_s) {
    const int tid = opaque_tid(wave_s), lane = tid & 63, wid = __builtin_amdgcn_readfirstlane(tid >> 6), r32 = lane & 31, hi = lane >> 5, g = wid & 3, w2 = wid >> 2;
    LAS unsigned char* Ks = lds; LAS unsigned char* Vt = lds + ATT_VT_OFF;
    u32x4 kreg[3], vreg[3];
#define ATT_PREFETCH(uu) do { const int qb_ = (uu) >> 1, kvh_ = (uu) & 1, t0_ = qb_ * 64, seq0_ = (t0_ / SEQ) * SEQ; \
        _Pragma("unroll") for (int j = 0; j < 3; ++j) { const int c = tid + j * NT, row = c >> 3, ch = c & 7, pos = t0_ - 128 + row; kreg[j] = (u32x4){0u, 0u, 0u, 0u}; vreg[j] = kreg[j]; \
            if (pos >= seq0_) { const bf16_t* src = kvb + (size_t)pos * 256 + kvh_ * HD + ch * 8; kreg[j] = *(const u32x4*)src; vreg[j] = *(const u32x4*)(src + 128); } } } while (0)
    if ((int)blockIdx.x < (T / 64) * 2) ATT_PREFETCH((int)blockIdx.x);
    for (int u = blockIdx.x; u < (T / 64) * 2; u += gridDim.x) {
        const int qblk = u >> 1, kvh = u & 1, t0 = qblk * 64, seq0 = (t0 / SEQ) * SEQ, h = kvh * 4 + g;
        const int tw = t0 + 32 * w2;
        bf16x8 qf[4]; { const bf16_t* qp = qb + (size_t)(tw + r32) * QD + h * HD + hi * 8;
#pragma unroll
            for (int ks = 0; ks < 4; ++ks) qf[ks] = *(const bf16x8*)(qp + ks * 16); }
        __syncthreads();
#pragma unroll
        for (int j = 0; j < 3; ++j) {
            const int c = tid + j * NT, row = c >> 3, ch = c & 7; const u32x4 vv = vreg[j];
            *(LAS u32x4*)(Ks + row * ATT_KS + ch * 16) = kreg[j];
            LAS bf16_t* vt = (LAS bf16_t*)(Vt + (ch * 8) * ATT_VT) + row;
            vt[0 * (ATT_VT / 2)] = (bf16_t)(vv.x & 0xffffu); vt[1 * (ATT_VT / 2)] = (bf16_t)(vv.x >> 16); vt[2 * (ATT_VT / 2)] = (bf16_t)(vv.y & 0xffffu); vt[3 * (ATT_VT / 2)] = (bf16_t)(vv.y >> 16);
            vt[4 * (ATT_VT / 2)] = (bf16_t)(vv.z & 0xffffu); vt[5 * (ATT_VT / 2)] = (bf16_t)(vv.z >> 16); vt[6 * (ATT_VT / 2)] = (bf16_t)(vv.w & 0xffffu); vt[7 * (ATT_VT / 2)] = (bf16_t)(vv.w >> 16);
        }
        if (u + (int)gridDim.x < (T / 64) * 2) ATT_PREFETCH(u + (int)gridDim.x);
        __syncthreads();
        f32x16 pt[5];
#pragma unroll
        for (int jj = 0; jj < 5; ++jj) { f32x16 a = {0.f, 0.f, 0.f, 0.f, 0.f, 0.f, 0.f, 0.f, 0.f, 0.f, 0.f, 0.f, 0.f, 0.f, 0.f, 0.f};
            const LAS unsigned char* kp = Ks + (32 * (w2 + jj) + r32) * ATT_KS + hi * 16;
#pragma unroll
            for (int ks = 0; ks < 4; ++ks) { const bf16x8 kf = *(const LAS bf16x8*)(kp + ks * 32); a = __builtin_amdgcn_mfma_f32_32x32x16_bf16(kf, qf[ks], a, 0, 0, 0); }
            pt[jj] = a; __builtin_amdgcn_sched_barrier(0); }
        const float slope2 = exp2f(-(float)(h + 1)) * LOG2E, sink2 = p.sinks[h] * LOG2E;
        const int kmin = seq0 - (tw - 128); const int r32o = opaque_i(r32), hio = opaque_i(hi);
        float m = sink2;
#pragma unroll
        for (int jj = 0; jj < 5; ++jj)
#pragma unroll
            for (int r = 0; r < 16; ++r) { const int kw = 32 * jj + crow(r, hio), rel = 128 + r32o - kw; const bool valid = (kw > r32o) && (kw <= r32o + 128) && (kw >= kmin);
                const float s = valid ? pt[jj][r] - slope2 * (float)rel : -INFINITY; pt[jj][r] = s; m = fmaxf(m, s); }
        m = fmaxf(m, __shfl_xor(m, 32));
        float l = 0.f;
#pragma unroll
        for (int jj = 0; jj < 5; ++jj)
#pragma unroll
            for (int r = 0; r < 16; ++r) { const float e = __builtin_amdgcn_exp2f(pt[jj][r] - m); pt[jj][r] = e; l += e; }
        l += __shfl_xor(l, 32); l += __builtin_amdgcn_exp2f(sink2 - m);
        f32x16 o0 = {0.f, 0.f, 0.f, 0.f, 0.f, 0.f, 0.f, 0.f, 0.f, 0.f, 0.f, 0.f, 0.f, 0.f, 0.f, 0.f}, o1 = o0;
#pragma unroll
        for (int jj = 0; jj < 5; ++jj)
#pragma unroll
            for (int s2 = 0; s2 < 2; ++s2) {
                u32x4 pw; pw.x = cvt_pk_bf16(pt[jj][8 * s2 + 0], pt[jj][8 * s2 + 1]); pw.y = cvt_pk_bf16(pt[jj][8 * s2 + 2], pt[jj][8 * s2 + 3]);
                pw.z = cvt_pk_bf16(pt[jj][8 * s2 + 4], pt[jj][8 * s2 + 5]); pw.w = cvt_pk_bf16(pt[jj][8 * s2 + 6], pt[jj][8 * s2 + 7]);
                const bf16x8 pf = __builtin_bit_cast(bf16x8, pw);
                const LAS unsigned char* vp = Vt + r32 * ATT_VT + (32 * (w2 + jj) + 16 * s2 + 4 * hi) * 2;
                const u32x2 a0 = *(const LAS u32x2*)vp, a1 = *(const LAS u32x2*)(vp + 16), b0 = *(const LAS u32x2*)(vp + 32 * ATT_VT), b1 = *(const LAS u32x2*)(vp + 32 * ATT_VT + 16);
                const bf16x8 vf0 = __builtin_bit_cast(bf16x8, (u32x4){a0.x, a0.y, a1.x, a1.y}), vf1 = __builtin_bit_cast(bf16x8, (u32x4){b0.x, b0.y, b1.x, b1.y});
                o0 = __builtin_amdgcn_mfma_f32_32x32x16_bf16(vf0, pf, o0, 0, 0, 0); o1 = __builtin_amdgcn_mfma_f32_32x32x16_bf16(vf1, pf, o1, 0, 0, 0);
                __builtin_amdgcn_sched_barrier(0);
            }
        const float inv = 1.f / l;
        bf16_t* op = att + (size_t)(tw + r32) * D + h * HD + 4 * hi;
#pragma unroll
        for (int rg = 0; rg < 4; ++rg) {
            u32x2 w0, w1; w0.x = cvt_pk_bf16(o0[4 * rg] * inv, o0[4 * rg + 1] * inv); w0.y = cvt_pk_bf16(o0[4 * rg + 2] * inv, o0[4 * rg + 3] * inv);
            w1.x = cvt_pk_bf16(o1[4 * rg] * inv, o1[4 * rg + 1] * inv); w1.y = cvt_pk_bf16(o1[4 * rg + 2] * inv, o1[4 * rg + 3] * inv);
            *(u32x2*)(op + 8 * rg) = w0; *(u32x2*)(op + 32 + 8 * rg) = w1; }
    }
#undef ATT_PREFETCH
}


__device__ __forceinline__ void p0_moe_weights(CParams& p, LAS unsigned char* lds, const int wave_s, int it0, int it1, int wk, int nwk) {
    unsigned char* ws = p.ws;
    const int tidx = opaque_tid(wave_s), lane = tidx & 63, wave = tidx >> 6;
    LAS float* scr = (LAS float*)(lds + wave * 16384);
    bf16_t* wt_gu = (bf16_t*)(ws + WS_WT_GU); bf16_t* wt_d = (bf16_t*)(ws + WS_WT_D);
    constexpr int I_GU = (D / 64) * (1024 / 32), I_D = (DFF / 64) * (D / 32);
    for (int it = it0 + wk; it < it1; it += nwk) {
        const int e = it / (I_GU + I_D); int r = it % (I_GU + I_D);
        if (r < I_GU) { const int kb = r >> 5, nb = r & 31, np = 32 * nb, pn = np >> 8, bj = (np >> 7) & 1, o = np & 127;
            const float* W = (bj ? p.w_up : p.w_gate) + (size_t)e * D * DFF;
            p0_transpose_item(W, DFF, 128 * pn + o, 64 * kb, p.g_ffn, wt_gu + (size_t)e * 1024 * D, D, np, scr, lane); }
        else { r -= I_GU; const int kb = r >> 5, nb = r & 31;
            p0_transpose_item(p.w_down + (size_t)e * DFF * D, D, 32 * nb, 64 * kb, nullptr, wt_d + (size_t)e * D * DFF, DFF, 32 * nb, scr, lane); }
    }
}
constexpr int MOE_ITEMS = NE * 768;
constexpr int MOE_ITEMS_P0 = 12288;

constexpr int RT_WAVE = (64 * 36 + 32 * 32 + 32 * 4) * 4;
__device__ __forceinline__ void route_phase_fast(CParams& p, const float* X, const bf16_t* delta, bf16_t* hb, int* toke, int* tokr, int* ltok, float* lrs, float* lw, unsigned* gcount,
                                                 LAS unsigned char* lds, const int wave_s) {
    const int tid = opaque_tid(wave_s), lane = tid & 63, kq = wave_s & 3, tg = wave_s >> 2, r32 = lane & 31, hi = lane >> 5;
    LAS float* tile = (LAS float*)(lds + wave_s * RT_WAVE); LAS float* Wl = tile + 64 * 36; LAS float* Wgl = Wl + 32 * 32;
    LAS unsigned* hist = (LAS unsigned*)(lds + 8 * RT_WAVE);
    for (int task = blockIdx.x; task < T / 128; task += gridDim.x) {
        const int tok0 = task * 128 + tg * 64;
        if (tid < 32) hist[tid] = 0u;
        f32x16 acc0 = {0.f, 0.f, 0.f, 0.f, 0.f, 0.f, 0.f, 0.f, 0.f, 0.f, 0.f, 0.f, 0.f, 0.f, 0.f, 0.f}, acc1 = acc0;
        f32x4 ag = {0.f, 0.f, 0.f, 0.f}; float ss = 0.f;
        f32x4 hr[8], wr[4], wgr = {0.f, 0.f, 0.f, 0.f}; u32x2 dr[8]; float gk[4], ggr = 0.f;
        const int rsub = lane >> 3, c4 = (lane & 7) * 4; const int hoff = (rsub * D + c4) * 4;
        const __amdgpu_buffer_rsrc_t rx = __builtin_amdgcn_make_buffer_rsrc((void*)X, 0, T * D * 4, 0x00020000), rd = __builtin_amdgcn_make_buffer_rsrc((void*)delta, 0, T * D * 2, 0x00020000),
            rwe = __builtin_amdgcn_make_buffer_rsrc((void*)p.w_expert, 0, D * NE * 4, 0x00020000), rwg = __builtin_amdgcn_make_buffer_rsrc((void*)p.w_group, 0, D * NG * 4, 0x00020000),
            rg = __builtin_amdgcn_make_buffer_rsrc((void*)p.g_ffn, 0, D * 4, 0x00020000), rhb = __builtin_amdgcn_make_buffer_rsrc((void*)hb, 0, T * D * 2, 0x00020000);
#define RT_LOAD(ch) do { const int k0_ = kq * 256 + (ch) * 32; const int sx_ = (tok0 * D + k0_) * 4; \
            _Pragma("unroll") for (int i = 0; i < 8; ++i) { hr[i] = __builtin_bit_cast(f32x4, __builtin_amdgcn_raw_buffer_load_b128(rx, hoff, sx_ + i * 8 * D * 4, 0)); \
                                                            dr[i] = __builtin_amdgcn_raw_buffer_load_b64(rd, hoff >> 1, (sx_ >> 1) + i * 8 * D * 2, 0); } \
            _Pragma("unroll") for (int i = 0; i < 4; ++i) { wr[i] = __builtin_bit_cast(f32x4, __builtin_amdgcn_raw_buffer_load_b128(rwe, lane * 16, k0_ * NE * 4 + i * 1024, 0)); \
                                                            gk[i] = __builtin_bit_cast(float, __builtin_amdgcn_raw_buffer_load_b32(rg, rsub * 4, (k0_ + i * 8) * 4, 0)); } \
            if (lane < 32) { wgr = __builtin_bit_cast(f32x4, __builtin_amdgcn_raw_buffer_load_b128(rwg, lane * 16, k0_ * NG * 4, 0)); ggr = __builtin_bit_cast(float, __builtin_amdgcn_raw_buffer_load_b32(rg, lane * 4, k0_ * 4, 0)); } } while (0)
        RT_LOAD(0);
#pragma unroll 1
        for (int ch = 0; ch < 8; ++ch) {
            const int k0 = kq * 256 + ch * 32;
#pragma unroll
            for (int i = 0; i < 8; ++i) { const int row = 8 * i + rsub; hr[i] += (f32x4){bf_lo(dr[i].x), bf_hi(dr[i].x), bf_lo(dr[i].y), bf_hi(dr[i].y)};
                u32x2 w; w.x = cvt_pk_bf16(hr[i][0], hr[i][1]); w.y = cvt_pk_bf16(hr[i][2], hr[i][3]);
                __builtin_amdgcn_raw_buffer_store_b64(w, rhb, hoff >> 1, (tok0 * D + k0) * 2 + i * 8 * D * 2, 0); *(LAS f32x4*)(tile + row * 36 + c4) = hr[i]; }
#pragma unroll
            for (int i = 0; i < 4; ++i) *(LAS f32x4*)(Wl + (i * 64 + lane) * 4) = wr[i] * gk[i];
            if (lane < 32) *(LAS f32x4*)(Wgl + lane * 4) = wgr * ggr;
            if (ch + 1 < 8) RT_LOAD(ch + 1);
            float bv[16];
#pragma unroll
            for (int s2 = 0; s2 < 16; ++s2) bv[s2] = Wl[(16 * hi + s2) * 32 + r32];
#pragma unroll
            for (int tt = 0; tt < 2; ++tt) {
                f32x4 a4[4];
#pragma unroll
                for (int q = 0; q < 4; ++q) a4[q] = *(const LAS f32x4*)(tile + (32 * tt + r32) * 36 + 16 * hi + 4 * q);
#pragma unroll
                for (int s2 = 0; s2 < 16; ++s2) { if (tt == 0) acc0 = __builtin_amdgcn_mfma_f32_32x32x2f32(a4[s2 >> 2][s2 & 3], bv[s2], acc0, 0, 0, 0);
                                                  else acc1 = __builtin_amdgcn_mfma_f32_32x32x2f32(a4[s2 >> 2][s2 & 3], bv[s2], acc1, 0, 0, 0); }
            }
#pragma unroll
            for (int k4 = 0; k4 < 8; ++k4) { const f32x4 hv = *(const LAS f32x4*)(tile + lane * 36 + 4 * k4);
#pragma unroll
                for (int q = 0; q < 4; ++q) { const f32x4 wg = *(const LAS f32x4*)(Wgl + (4 * k4 + q) * 4); ag += wg * hv[q]; ss = fmaf(hv[q], hv[q], ss); } }
        }
#undef RT_LOAD
#pragma unroll
        for (int r = 0; r < 16; ++r) { const int cr = (r & 3) + 8 * (r >> 2) + 4 * hi; tile[cr * 37 + 4 + r32] = acc0[r]; tile[(32 + cr) * 37 + 4 + r32] = acc1[r]; }
        tile[lane * 37 + 0] = ag[0]; tile[lane * 37 + 1] = ag[1]; tile[lane * 37 + 2] = ag[2]; tile[lane * 37 + 3] = ag[3]; tile[lane * 37 + 36] = ss;
        __syncthreads();
        int ea = 0, eb = 0; unsigned ra = 0u, rb = 0u; float w1 = 0.f, w2 = 0.f, rstd = 0.f;
        if (kq == 0) {
            float lg[NG + NE]; float s2 = 0.f;
#pragma unroll
            for (int e = 0; e < NG + NE; ++e) lg[e] = 0.f;
#pragma unroll
            for (int q = 0; q < 4; ++q) { const LAS float* pt = (const LAS float*)(lds + (tg * 4 + q) * RT_WAVE) + lane * 37;
#pragma unroll
                for (int e = 0; e < NG + NE; ++e) lg[e] += pt[e];
                s2 += pt[36]; }
            rstd = rsqrtf(s2 * (1.f / D) + EPS);
            float gl[NG]; float gmax = -INFINITY; int gsel = 0;
#pragma unroll
            for (int g = 0; g < NG; ++g) { gl[g] = lg[g] * rstd + p.b_group[g]; if (gl[g] > gmax) { gmax = gl[g]; gsel = g; } }
            float gden = 0.f;
#pragma unroll
            for (int g = 0; g < NG; ++g) gden += __expf(gl[g] - gmax);
            const float pg = 1.f / gden;
            float v1 = -INFINITY, v2 = -INFINITY; int i1 = 0, i2 = 0;
#pragma unroll
            for (int g = 0; g < NG; ++g) if (g == gsel) {
#pragma unroll
                for (int j = 0; j < EPG; ++j) { const float val = lg[4 + g * EPG + j] * rstd + p.b_expert[g * EPG + j];
                    if (val > v1) { v2 = v1; i2 = i1; v1 = val; i1 = j; } else if (val > v2) { v2 = val; i2 = j; } }
            }
            const float e2 = __expf(v2 - v1); w1 = pg / (1.f + e2); w2 = pg * e2 / (1.f + e2);
            ea = gsel * EPG + i1; eb = gsel * EPG + i2;
            ra = __hip_atomic_fetch_add(hist + ea, 1u, __ATOMIC_RELAXED, __HIP_MEMORY_SCOPE_WORKGROUP);
            rb = __hip_atomic_fetch_add(hist + eb, 1u, __ATOMIC_RELAXED, __HIP_MEMORY_SCOPE_WORKGROUP);
        }
        __syncthreads();
        { const int t2 = opaque_i(tid); if (t2 < 32) hist[32 + t2] = __hip_atomic_fetch_add(gcount + t2, hist[t2], __ATOMIC_RELAXED, __HIP_MEMORY_SCOPE_AGENT); }
        __syncthreads();
        if (kq == 0) {
            const int tok = tok0 + lane; const unsigned pa = hist[32 + ea] + ra, pb = hist[32 + eb] + rb;
            ltok[(size_t)ea * CAP + pa] = tok; lrs[(size_t)ea * CAP + pa] = rstd; lw[(size_t)ea * CAP + pa] = w1;
            ltok[(size_t)eb * CAP + pb] = tok; lrs[(size_t)eb * CAP + pb] = rstd; lw[(size_t)eb * CAP + pb] = w2;
            toke[2 * tok] = ea; toke[2 * tok + 1] = eb; tokr[2 * tok] = (int)pa; tokr[2 * tok + 1] = (int)pb;
        }
        __syncthreads();
    }
}

__device__ __forceinline__ void moe_build_map(const unsigned* gcount, LAS unsigned char* lds, int tid) {
    LAS int* nbp = (LAS int*)(lds + MOE_NBP_OFF); LAS int* cnt = (LAS int*)(lds + MOE_CNT_OFF);
    __syncthreads();
    if (tid < 64) {
        const int c = tid < NE ? (int)__hip_atomic_load(gcount + (tid & 31), __ATOMIC_RELAXED, __HIP_MEMORY_SCOPE_AGENT) : 0;
        int x = (c + 255) >> 8;
#pragma unroll
        for (int o = 1; o < 32; o <<= 1) { const int t = __shfl_up(x, o); if ((tid & 63) >= o) x += t; }
        if (tid < NE) { cnt[tid] = c; nbp[tid + 1] = x; }
        if (tid == 0) nbp[0] = 0;
    }
    __syncthreads();
}
__device__ __forceinline__ void moe_unit_of(int i, int G, int c, int& blk, int& pn) {
    if ((G & 31) == 0) { const int w = c >> 3; blk = i * (G >> 2) + (c & 7) * (G >> 5) + (w >> 2); pn = w & 3; }
    else { const int L = i * G + c; blk = L >> 2; pn = L & 3; }
}
__device__ __forceinline__ void moe_build_units(const int* ltok, LAS unsigned char* lds, int G, int c, int tid, bool gather) {
    const LAS int* nbp = (const LAS int*)(lds + MOE_NBP_OFF); const LAS int* cnt = (const LAS int*)(lds + MOE_CNT_OFF);
    LAS int* ut = (LAS int*)(lds + MOE_UT_OFF); LAS unsigned* tbl = (LAS unsigned*)(lds + MOE_TBL_OFF);
    const int nunits = nbp[NE] * 4;
    for (int i = 0; i < MOE_MAXU; ++i) {
        int blk, pnn; moe_unit_of(i, G, c, blk, pnn); if (blk * 4 >= nunits) continue;
        int e = 0;
        for (int j = 1; j < NE; ++j) if (blk >= nbp[j]) e = j;
        const int rb = blk - nbp[e];
        if (tid == 0) { ut[4 * i] = e; ut[4 * i + 1] = blk; ut[4 * i + 2] = pnn; ut[4 * i + 3] = rb * 256; }
        if (gather && tid < 256) { const int rank = rb * 256 + tid; tbl[i * 256 + tid] = rank < cnt[e] ? (unsigned)ltok[(size_t)e * CAP + rank] * (unsigned)(D * 2) : 0u; }
    }
    __syncthreads();
}
namespace pg8 {
struct MoeSched {
    const LAS int* ut; const LAS unsigned* tbl; const LAS int* nbp; const char* A; const char* Bt; int G, c, K; bool gather;
    __device__ __forceinline__ bool next(int i, Unit& u) const {
        const int nunits = __builtin_amdgcn_readfirstlane(nbp[NE]) * 4;
        if (i >= MOE_MAXU) return false;
        { int blk_, pn_; moe_unit_of(i, G, c, blk_, pn_); if (blk_ * 4 >= nunits) return false; }
        const int e = __builtin_amdgcn_readfirstlane(ut[4 * i]), blk = __builtin_amdgcn_readfirstlane(ut[4 * i + 1]), pn = __builtin_amdgcn_readfirstlane(ut[4 * i + 2]), r0 = __builtin_amdgcn_readfirstlane(ut[4 * i + 3]);
        u.pm = blk; u.pn = pn; u.aux = e; u.rank0 = r0;
        u.a = gather ? A : A + (size_t)blk * 256 * K * 2;
        u.b = Bt + ((size_t)e * 1024 + (size_t)pn * 256) * K * 2;
        return true;
    }
    __device__ __forceinline__ void a_voff(const Unit&, int ui, int tid, int K_, unsigned (&v)[2][2]) const {
#pragma unroll
        for (int i = 0; i < 2; ++i) { int R, C; stage_rc(tid * 16 + i * 8192, R, C);
            if (gather) { v[0][i] = tbl[ui * 256 + R] + (unsigned)C * 2u; v[1][i] = tbl[ui * 256 + HALF + R] + (unsigned)C * 2u; }
            else { v[0][i] = (unsigned)(R * K_ + C) * 2u; v[1][i] = (unsigned)((HALF + R) * K_ + C) * 2u; } }
    }
    __device__ __forceinline__ void a_ready(const Unit&) const {}
    __device__ __forceinline__ void done(const Unit&) const {}
};
struct EpiSwiglu {
    static constexpr bool PERM = true, AFTER_DRAIN = false; static constexpr int MIDK = 0;
    const float* lrs; const LAS int* cnt; bf16_t* hmid;
    __device__ __forceinline__ void operator()(const f32x4 (&acc)[2][2][4][2], const Unit& u, int wr, int wc, int fr, int fq) const {
        const int e = u.aux, n = __builtin_amdgcn_readfirstlane(cnt[e]); const int coff = wc * 32 + 8 * fq;
#pragma unroll
        for (int ai = 0; ai < 2; ++ai)
#pragma unroll
            for (int m = 0; m < 4; ++m) {
                const int ri = ai * HALF + wr * 64 + m * 16 + fr, rank = u.rank0 + ri; const float s = rank < n ? lrs[(size_t)e * CAP + rank] : 0.f;
                const f32x4 a0 = acc[ai][0][m][0] * s, a1 = acc[ai][0][m][1] * s, b0 = acc[ai][1][m][0] * s, b1 = acc[ai][1][m][1] * s;
                *(u32x4*)(hmid + (size_t)(u.pm * 256 + ri) * DFF + 128 * u.pn + coff) = pack8(a0 * sig4(a0) * b0, a1 * sig4(a1) * b1);
            }
    }
};
struct EpiDown {
    static constexpr bool PERM = true, AFTER_DRAIN = false; static constexpr int MIDK = 0;
    const float* lw; const LAS int* cnt; bf16_t* y;
    __device__ __forceinline__ void operator()(const f32x4 (&acc)[2][2][4][2], const Unit& u, int wr, int wc, int fr, int fq) const {
        const int e = u.aux, n = __builtin_amdgcn_readfirstlane(cnt[e]); const int col0 = u.pn * BM + wc * 32 + 8 * fq;
#pragma unroll
        for (int ai = 0; ai < 2; ++ai)
#pragma unroll
            for (int m = 0; m < 4; ++m) {
                const int ri = ai * HALF + wr * 64 + m * 16 + fr, rank = u.rank0 + ri; const float s = rank < n ? lw[(size_t)e * CAP + rank] : 0.f;
                bf16_t* yp = y + (size_t)(u.pm * 256 + ri) * D + col0;
                *(u32x4*)yp = pack8(acc[ai][0][m][0] * s, acc[ai][0][m][1] * s); *(u32x4*)(yp + HALF) = pack8(acc[ai][1][m][0] * s, acc[ai][1][m][1] * s);
            }
    }
};
}

__device__ __forceinline__ void final_phase(CParams& p, const bf16_t* hb, const bf16_t* y, const int* toke, const int* tokr, float* outp, LAS unsigned char* lds, const int wave_s) {
    const int tidx = opaque_tid(wave_s), lane = tidx & 63, gw = blockIdx.x * (NT / 64) + (tidx >> 6), NGW = gridDim.x * (NT / 64);
    const LAS int* nbp = (const LAS int*)(lds + MOE_NBP_OFF);
    for (int m = gw; m < T; m += NGW) {
        const int ea = toke[2 * m], eb = toke[2 * m + 1];
        const size_t sa = (size_t)nbp[ea] * 256 + tokr[2 * m], sb = (size_t)nbp[eb] * 256 + tokr[2 * m + 1];
        const u32x2* xr = (const u32x2*)(hb + (size_t)m * D) + lane; const u32x2* ya = (const u32x2*)(y + sa * D) + lane; const u32x2* yb = (const u32x2*)(y + sb * D) + lane;
        f32x4 v[4]; float s = 0.f;
#pragma unroll
        for (int j = 0; j < 4; ++j) { const u32x2 h2 = xr[64 * j], a = ya[64 * j], b = yb[64 * j];
            v[j] = (f32x4){bf_lo(h2.x), bf_hi(h2.x), bf_lo(h2.y), bf_hi(h2.y)} + (f32x4){bf_lo(a.x), bf_hi(a.x), bf_lo(a.y), bf_hi(a.y)} + (f32x4){bf_lo(b.x), bf_hi(b.x), bf_lo(b.y), bf_hi(b.y)};
            s += (v[j][0] * v[j][0] + v[j][1] * v[j][1]) + (v[j][2] * v[j][2] + v[j][3] * v[j][3]); }
        const float rstd = rsqrtf(wave_sum(s) * (1.f / D) + EPS);
        f32x4* o = (f32x4*)(outp + (size_t)m * D) + lane;
#pragma unroll
        for (int j = 0; j < 4; ++j) o[64 * j] = v[j] * rstd * ((const f32x4*)p.g_final)[lane + 64 * j];
    }
}


__global__ void __launch_bounds__(NT, 2) k_all(Params p_arg) {
    CParams* pp_ = (CParams*)__builtin_amdgcn_kernarg_segment_ptr(); asm volatile("" : "+s"(pp_)); CParams& p = *pp_;
    extern __shared__ __attribute__((aligned(16))) unsigned char lds_raw[];
    LAS unsigned char* lds = (LAS unsigned char*)lds_raw;
    volatile LAS unsigned* MISC = (volatile LAS unsigned*)(lds + MISC_OFF);
    const int wave_s = __builtin_amdgcn_readfirstlane((int)threadIdx.x >> 6);
    if (threadIdx.x < 32) MISC[threadIdx.x] = 0u;
    __syncthreads();
    unsigned char* ws = p.ws;
    unsigned* ctl = (unsigned*)(ws + WS_CTL);
    XcdBarrier bar = xcd_barrier_post(ctl + CW_BAR, MISC, wave_s == 0);
    const int G = gridDim.x;

    bf16_t* wt_in = (bf16_t*)(ws + WS_WT_IN); bf16_t* wt_mix = (bf16_t*)(ws + WS_WT_MIX); bf16_t* wt_out = (bf16_t*)(ws + WS_WT_OUT);
    bf16_t* xb = (bf16_t*)(ws + WS_XB); bf16_t* merged = (bf16_t*)(ws + WS_MERGED); float* rstd1 = (float*)(ws + WS_RSTD1);
    bf16_t* vglu = (bf16_t*)(ws + WS_VGLU); bf16_t* qb = (bf16_t*)(ws + WS_QB); bf16_t* kvb = (bf16_t*)(ws + WS_KVB);
    bf16_t* sgc = (bf16_t*)(ws + WS_SGC); bf16_t* sga = (bf16_t*)(ws + WS_SGA); bf16_t* mix = (bf16_t*)(ws + WS_MIX); bf16_t* cact = mix; bf16_t* att = mix + CC;
    bf16_t* delta = (bf16_t*)(ws + WS_DELTA);

#ifndef ENABLE
#define ENABLE 0xff
#endif
#ifndef REPEAT
#define REPEAT 0
#endif
#define BARX() do { xcd_barrier(bar); if ((REPEAT >> 15) & 1) xcd_barrier(bar); } while (0)
#define REP(k) _Pragma("unroll") for (int rep_ = 0; rep_ < 1 + ((REPEAT >> (k)) & 1); ++rep_)
    asm volatile("; PHASE_MARK 0");
    REP(0) if (ENABLE & 1) { p0_prologue(p, lds, wave_s); p0_moe_weights(p, lds, wave_s, 0, MOE_ITEMS_P0, (int)blockIdx.x * (NT / 64) + wave_s, G * (NT / 64)); }
    BARX();
    asm volatile("; PHASE_MARK 1");
    REP(1) if (ENABLE & 2) {
      const int nfull = (T / 256) * (INC / 256) - 7 * G;
      const bool split = nfull > 0 && nfull < G; const int MID = (MOE_ITEMS_P0 + MOE_ITEMS) / 2;
      if (rep_ == 0 && split && (int)blockIdx.x >= nfull) p0_moe_weights(p, lds, wave_s, MOE_ITEMS_P0, MID, ((int)blockIdx.x - nfull) * (NT / 64) + wave_s, (G - nfull) * (NT / 64));
      __syncthreads();
      pg8::DenseSched S; S.init(xb, wt_in, T, INC, D, G, (int)blockIdx.x);
      pg8::EpiProj E{rstd1, vglu, qb, kvb, sgc, sga, 0.125f * LOG2E};
      pg8::gemm_phase<pg8::EpiProj, pg8::DenseSched, true, true>(lds, D, S, E, wave_s);
      if (rep_ == 0) { if (split) { if ((int)blockIdx.x >= nfull) p0_moe_weights(p, lds, wave_s, MID, MOE_ITEMS, ((int)blockIdx.x - nfull) * (NT / 64) + wave_s, (G - nfull) * (NT / 64)); }
                       else p0_moe_weights(p, lds, wave_s, MOE_ITEMS_P0, MOE_ITEMS, (int)blockIdx.x * (NT / 64) + wave_s, G * (NT / 64)); } }
    BARX();
    asm volatile("; PHASE_MARK 2");
    REP(2) if (ENABLE & 4) conv_phase(p, vglu, cact, lds, wave_s);
    asm volatile("; PHASE_MARK 3");
    REP(3) if (ENABLE & 8) attn_phase(p, qb, kvb, att, lds, wave_s);
    BARX();
    asm volatile("; PHASE_MARK 4");
    REP(4) if (ENABLE & 16) { pg8::DenseSched S; S.init(mix, wt_mix, T, D, D, G, (int)blockIdx.x);
      pg8::EpiMerge E{sgc, sga, merged};
      pg8::gemm_phase<pg8::EpiMerge, pg8::DenseSched, true, true>(lds, D, S, E, wave_s); }
    BARX();
    asm volatile("; PHASE_MARK 6");
    REP(5) if (ENABLE & 32) { pg8::DenseSched S; S.init(merged, wt_out, T, D, D, G, (int)blockIdx.x);
      pg8::EpiDelta E{delta};
      pg8::gemm_phase<pg8::EpiDelta, pg8::DenseSched, true, true>(lds, D, S, E, wave_s); }
    BARX();
    bf16_t* hb = (bf16_t*)(ws + WS_HB); bf16_t* hmid = (bf16_t*)(ws + WS_HMID); bf16_t* y = (bf16_t*)(ws + WS_Y);
    int* toke = (int*)(ws + WS_TOKE); int* tokr = (int*)(ws + WS_TOKR); int* ltok = (int*)(ws + WS_LTOK); float* lrs = (float*)(ws + WS_LRS); float* lw = (float*)(ws + WS_LW);
    unsigned* gcount = ctl + CW_CNT;
    asm volatile("; PHASE_MARK 7");
    if ((REPEAT >> 7) & 1) { unsigned char* sc = ws + WS_VGLU + 64 * MiB;
        route_phase_fast(p, p.x, delta, hb, (int*)(sc), (int*)(sc + 1 * MiB), (int*)(sc + 2 * MiB), (float*)(sc + 6 * MiB), (float*)(sc + 10 * MiB), gcount + 64, lds, wave_s); }
    route_phase_fast(p, p.x, delta, hb, toke, tokr, ltok, lrs, lw, gcount, lds, wave_s);
    BARX();
    asm volatile("; PHASE_MARK 8");
    REP(8) { const int tid = opaque_tid(wave_s);
      moe_build_map(gcount, lds, tid); moe_build_units(ltok, lds, G, (int)blockIdx.x, tid, true);
      pg8::MoeSched S{(const LAS int*)(lds + MOE_UT_OFF), (const LAS unsigned*)(lds + MOE_TBL_OFF), (const LAS int*)(lds + MOE_NBP_OFF), (const char*)hb, (const char*)(ws + WS_WT_GU), G, (int)blockIdx.x, D, true};
      pg8::EpiSwiglu E{lrs, (const LAS int*)(lds + MOE_CNT_OFF), hmid};
      pg8::gemm_phase<pg8::EpiSwiglu, pg8::MoeSched, true, true>(lds, D, S, E, wave_s); }
    BARX();
    asm volatile("; PHASE_MARK 9");
    REP(9) { const int tid = opaque_tid(wave_s);
      moe_build_map(gcount, lds, tid); moe_build_units(ltok, lds, G, (int)blockIdx.x, tid, false);
      pg8::MoeSched S{(const LAS int*)(lds + MOE_UT_OFF), (const LAS unsigned*)(lds + MOE_TBL_OFF), (const LAS int*)(lds + MOE_NBP_OFF), (const char*)hmid, (const char*)(ws + WS_WT_D), G, (int)blockIdx.x, DFF, false};
      pg8::EpiDown E{lw, (const LAS int*)(lds + MOE_CNT_OFF), y};
      pg8::gemm_phase<pg8::EpiDown, pg8::MoeSched, true, true>(lds, DFF, S, E, wave_s); }
    BARX();
    asm volatile("; PHASE_MARK 10");
    { const int tid = opaque_tid(wave_s); moe_build_map(gcount, lds, tid); }
    if ((REPEAT >> 10) & 1) final_phase(p, hb, y, toke, tokr, p.out, lds, wave_s);
    final_phase(p, hb, y, toke, tokr, p.out, lds, wave_s);
}

extern "C" void kernel_launch(void* const* d_in, const int* in_sizes, int n_in, void* d_out, int out_size, void* d_ws, size_t ws_size, hipStream_t stream) {
    static int grid = 0;
    if (grid == 0) {
        if (n_in != 20 || in_sizes[0] != T * D || out_size != T * D || ws_size < WS_END) {
            fprintf(stderr, "kernel_launch: unexpected shapes (n_in %d, in0 %d, out %d, ws %zu); nothing launched\n", n_in, n_in > 0 ? in_sizes[0] : -1, out_size, ws_size); grid = -1; return; }
        int dev = 0, cus = 0, per_cu = 0;
        if (hipGetDevice(&dev) != hipSuccess || hipDeviceGetAttribute(&cus, hipDeviceAttributeMultiprocessorCount, dev) != hipSuccess) { grid = -1; return; }
        if (hipFuncSetAttribute((const void*)k_all, hipFuncAttributeMaxDynamicSharedMemorySize, LDS_BYTES) != hipSuccess) { fprintf(stderr, "kernel_launch: hipFuncSetAttribute failed\n"); grid = -1; return; }
        if (hipOccupancyMaxActiveBlocksPerMultiprocessor(&per_cu, (const void*)k_all, NT, LDS_BYTES) != hipSuccess || per_cu < 1)
            fprintf(stderr, "kernel_launch: note: occupancy query reports %d workgroups per CU\n", per_cu);
        (void)hipGetLastError();
        grid = cus;
    }
    if (grid < 0) return;
    if (hipMemsetAsync((char*)d_ws + WS_CTL, 0, CTL_BYTES, stream) != hipSuccess) return;
    Params p{};
    const float** pp = (const float**)&p;
    for (int i = 0; i < 20; ++i) pp[i] = (const float*)d_in[i];
    p.out = (float*)d_out; p.ws = (unsigned char*)d_ws;
    hipLaunchKernelGGL(k_all, dim3(grid), dim3(NT), LDS_BYTES, stream, p);
}
```

```cpp
#include <hip/hip_runtime.h>
#include <cstdio>
#include <cstdint>

constexpr int T = 32768, D = 1024, SEQ = 4096;
constexpr int CC = 512, CW = 31, NH = 8, HD = 64, QD = 512, KVD = 128, INC = 3840;
constexpr int NE = 32, NG = 4, EPG = 8, DFF = 512;
constexpr float EPS = 1e-6f;
constexpr int NT = 512;
constexpr float LOG2E = 1.4426950408889634f;

#define GAS __attribute__((address_space(1)))
#define LAS __attribute__((address_space(3)))
typedef unsigned short bf16_t;
typedef short bf16x8 __attribute__((ext_vector_type(8)));
typedef float f32x4 __attribute__((ext_vector_type(4)));
typedef float f32x16 __attribute__((ext_vector_type(16)));
typedef unsigned u32x4 __attribute__((ext_vector_type(4)));
typedef unsigned u32x2 __attribute__((ext_vector_type(2)));

__device__ __forceinline__ int lane_id_v() { int l; asm volatile("v_mbcnt_lo_u32_b32 %0, -1, 0\n\tv_mbcnt_hi_u32_b32 %0, -1, %0" : "=v"(l)); return l; }
__device__ __forceinline__ int opaque_tid(int wave_s) { return wave_s * 64 + lane_id_v(); }
__device__ __forceinline__ int opaque_i(int v) { asm volatile("" : "+v"(v)); return v; }
__device__ __forceinline__ float wave_sum(float v) {
#pragma unroll
    for (int o = 1; o < 64; o <<= 1) v += __shfl_xor(v, o);
    return v;
}
__device__ __forceinline__ float sigmoidf_(float v) { return 1.f / (1.f + __expf(-v)); }
__device__ __forceinline__ float fsig(float v) { return __builtin_amdgcn_rcpf(1.f + __builtin_amdgcn_exp2f(-LOG2E * v)); }
__device__ __forceinline__ unsigned cvt_pk_bf16(float lo, float hi) { unsigned r; asm volatile("v_cvt_pk_bf16_f32 %0, %1, %2" : "=v"(r) : "v"(lo), "v"(hi)); return r; }
__device__ __forceinline__ float bf_lo(unsigned w) { return __uint_as_float(w << 16); }
__device__ __forceinline__ float bf_hi(unsigned w) { return __uint_as_float(w & 0xffff0000u); }

__device__ __forceinline__ void st16_wt(const __amdgpu_buffer_rsrc_t& r, unsigned byteoff, u32x4 v) { __builtin_amdgcn_raw_buffer_store_b128(v, r, (int)byteoff, 0, 16); }

namespace pg8 {
#define PG8_LAS __attribute__((address_space(3)))
constexpr int BM = 256, BK = 64, HALF = 128, HTB = HALF * BK * 2  , STAGE_BYTES = 8 * HTB, NXCD = 8, WGM = 8;

__host__ __device__ __forceinline__ int lds_byte(int r, int c) { const int st = (r >> 4) * 2 + (c >> 5), rr = r & 15, cc = c & 31, ob = rr * 64 + cc * 2; return st * 1024 + (ob ^ (((ob >> 9) & 1) << 5)); }
__host__ __device__ __forceinline__ void stage_rc(int b, int& R, int& C) { const int st = b / 1024, sb = b % 1024, swz = sb ^ (((sb >> 9) & 1) << 5); R = (st >> 1) * 16 + swz / 64; C = (st & 1) * 32 + (swz % 64) / 2; }
__host__ __device__ __forceinline__ int perm32(int rho) { const int n = rho >> 4, i = rho & 15; return 8 * (i >> 2) + 4 * n + (i & 3); }

struct Unit { int pm, pn; const char* a; const char* b; int aux, rank0; };

struct StaticOrder {
    int nM, nN, nwg, G, c;
    __host__ __device__ void init(int M, int N, int G_, int c_) { nM = M / BM; nN = N / BM; nwg = nM * nN; G = G_; c = c_; }
    __host__ __device__ bool next_mn(int i, int& pm, int& pn) const {
        const long L = (long)i * G + c; if (L >= nwg) return false;
        int wgid = (int)L; { const int q = nwg / NXCD, r = nwg % NXCD, xcd = wgid % NXCD, off = wgid / NXCD; wgid = (xcd < r ? xcd * (q + 1) : r * (q + 1) + (xcd - r) * q) + off; }
        const int nig = WGM * nN, gid = wgid / nig, fm = gid * WGM, gsz = (nM - fm) < WGM ? (nM - fm) : WGM;
        pm = fm + ((wgid % nig) % gsz); pn = (wgid % nig) / gsz; return true;
    }
};
struct DenseSched {
    StaticOrder so; const char* A; const char* Bt; size_t tstep;
    __device__ __forceinline__ void init(const bf16_t* A_, const bf16_t* Bt_, int M, int N, int K, int G, int c) { so.init(M, N, G, c); A = (const char*)A_; Bt = (const char*)Bt_; tstep = (size_t)BM * K * 2; }
    __device__ __forceinline__ bool next(int i, Unit& u) const { if (!so.next_mn(i, u.pm, u.pn)) return false; u.a = A + (size_t)u.pm * tstep; u.b = Bt + (size_t)u.pn * tstep; u.aux = 0; u.rank0 = 0; return true; }
    __device__ __forceinline__ void a_voff(const Unit&, int, int tid, int K, unsigned (&v)[2][2]) const {
#pragma unroll
        for (int i = 0; i < 2; ++i) { int R, C; stage_rc(tid * 16 + i * 8192, R, C); v[0][i] = (unsigned)(R * K + C) * 2u; v[1][i] = (unsigned)((HALF + R) * K + C) * 2u; } }
    __device__ __forceinline__ void a_ready(const Unit&) const {}
    __device__ __forceinline__ void done(const Unit&) const {}
};

template <class Epi, class Sched, bool ALIGN_EPI = false, bool SP2 = false>
__device__ __forceinline__ void gemm_phase(PG8_LAS unsigned char* lds, const int K_, const Sched& S, const Epi& E, const int wave_s) {
    const int tid_ = opaque_tid(wave_s); const int tid = tid_, wid = __builtin_amdgcn_readfirstlane(tid >> 6), lane = tid & 63, wr = wid >> 2, wc = wid & 3, fr = lane & 15, fq = lane >> 4;
    const int K = K_, nt = K / BK;
    unsigned voffB[2]; unsigned vC[2][2], vN[2][2];
#pragma unroll
    for (int i = 0; i < 2; ++i) { int R, C; stage_rc(tid * 16 + i * 8192, R, C); const int Rb = Epi::PERM ? ((R & ~31) + perm32(R & 31)) : R;
        voffB[i] = (unsigned)(Rb * K + C) * 2u; }
    const size_t kstep = (size_t)(BK * 2);
    const size_t hstep = (size_t)HALF * K * 2;
    const unsigned ldsw = (unsigned)wid * 1024u;
    const int aoff = lds_byte(wr * 64 + fr, fq * 8), boff = lds_byte(wc * 32 + fr, fq * 8);
#define PG8_SA(b, h) (((b) * 2 + (h)) * HTB)
#define PG8_SB(b, h) ((4 + (b) * 2 + (h)) * HTB)
#define PG8_STAGE(bufoff, gbase, voff) do { _Pragma("unroll") for (int _i = 0; _i < 2; ++_i) \
        __builtin_amdgcn_global_load_lds((const unsigned*)((const char*)(gbase) + (voff)[_i]), (PG8_LAS unsigned*)(lds + (bufoff) + ldsw + _i * 8192), 16, 0, 0); } while (0)
#define PG8_LDA(dst, b, h) do { _Pragma("unroll") for (int m = 0; m < 4; ++m) _Pragma("unroll") for (int k = 0; k < 2; ++k) dst[m][k] = *(const PG8_LAS bf16x8*)(lds + PG8_SA(b, h) + aoff + m * 2048 + k * 1024); } while (0)
#define PG8_LDB(dst, b, h) do { _Pragma("unroll") for (int n = 0; n < 2; ++n) _Pragma("unroll") for (int k = 0; k < 2; ++k) dst[n][k] = *(const PG8_LAS bf16x8*)(lds + PG8_SB(b, h) + boff + n * 2048 + k * 1024); } while (0)
#define PG8_MMA(ai, bj, At, Bt) do { __builtin_amdgcn_s_setprio(1); _Pragma("unroll") for (int m = 0; m < 4; ++m) _Pragma("unroll") for (int n = 0; n < 2; ++n) _Pragma("unroll") for (int k = 0; k < 2; ++k) \
        acc[ai][bj][m][n] = __builtin_amdgcn_mfma_f32_16x16x32_bf16(Bt[n][k], At[m][k], acc[ai][bj][m][n], 0, 0, 0); __builtin_amdgcn_s_setprio(0); } while (0)
#define PG8_WAIT_V(n) asm volatile("s_waitcnt vmcnt(" #n ")" ::: "memory")
#define PG8_WAIT_L(n) asm volatile("s_waitcnt lgkmcnt(" #n ")" ::: "memory")
#define PG8_BAR __builtin_amdgcn_s_barrier()
#define PG8_SCHED __builtin_amdgcn_sched_barrier(0)
    Unit cur, nxt; int ui = 0;
    if (!S.next(0, cur)) return;
    S.a_voff(cur, 0, tid, K, vC);
    f32x4 acc[2][2][4][2];
#pragma unroll
    for (int a = 0; a < 2; ++a)
#pragma unroll
        for (int b = 0; b < 2; ++b)
#pragma unroll
            for (int m = 0; m < 4; ++m)
#pragma unroll
                for (int n = 0; n < 2; ++n) acc[a][b][m][n] = (f32x4){0.f, 0.f, 0.f, 0.f};
    bf16x8 At[4][2], B0[2][2], B1[2][2];
    const char* cA = cur.a; const char* cB = cur.b;
    S.a_ready(cur);
    if constexpr (SP2) {
        PG8_STAGE(PG8_SB(0, 0), cB, voffB); PG8_STAGE(PG8_SB(0, 1), cB + hstep, voffB); PG8_STAGE(PG8_SA(0, 0), cA, vC[0]); PG8_STAGE(PG8_SA(0, 1), cA, vC[1]);
        if (wr == 1) PG8_BAR;
        PG8_WAIT_V(2); PG8_BAR;
        PG8_STAGE(PG8_SB(1, 0), cB + kstep, voffB); PG8_STAGE(PG8_SA(1, 0), cA + kstep, vC[0]); PG8_STAGE(PG8_SB(1, 1), cB + hstep + kstep, voffB);
        PG8_WAIT_V(6); PG8_BAR;
    } else {
        PG8_STAGE(PG8_SB(0, 0), cB, voffB); PG8_STAGE(PG8_SA(0, 0), cA, vC[0]); PG8_STAGE(PG8_SB(0, 1), cB + hstep, voffB); PG8_STAGE(PG8_SA(0, 1), cA, vC[1]);
        if (wr == 1) PG8_BAR;
        PG8_WAIT_V(4); PG8_BAR;
        PG8_STAGE(PG8_SB(1, 0), cB + kstep, voffB); PG8_STAGE(PG8_SA(1, 0), cA + kstep, vC[0]); PG8_STAGE(PG8_SB(1, 1), cB + hstep + kstep, voffB);
        PG8_WAIT_V(6); PG8_BAR;
    }
    for (;;) {
        const bool has_next = S.next(ui + 1, nxt);
        if (has_next) S.a_voff(nxt, ui + 1, tid, K, vN); else { vN[0][0] = vC[0][0]; vN[0][1] = vC[0][1]; vN[1][0] = vC[1][0]; vN[1][1] = vC[1][1]; }
        const char* nA = has_next ? nxt.a : cA; const char* nB = has_next ? nxt.b : cB;
        for (int t = 0; t < nt; t += 2) {
            const bool last = (t == nt - 2);
            unsigned v2[2][2]; v2[0][0] = last ? vN[0][0] : vC[0][0]; v2[0][1] = last ? vN[0][1] : vC[0][1]; v2[1][0] = last ? vN[1][0] : vC[1][0]; v2[1][1] = last ? vN[1][1] : vC[1][1];
            const char* a1 = cA + (size_t)(t + 1) * kstep;
            const char* a2 = last ? nA : cA + (size_t)(t + 2) * kstep; const char* b2 = last ? nB : cB + (size_t)(t + 2) * kstep;
            const char* a3 = a2 + kstep; const char* b3 = b2 + kstep;
            if (last && has_next) S.a_ready(nxt);
            if constexpr (Epi::MIDK > 0) { if (t == Epi::MIDK) E.mid(acc, cur, wr, wc, fr, fq); }
            if constexpr (SP2) {
            PG8_LDB(B0, 0, 0); PG8_LDB(B1, 0, 1); PG8_SCHED; PG8_LDA(At, 0, 0); PG8_STAGE(PG8_SA(1, 1), a1, vC[1]);
            PG8_WAIT_V(8); PG8_WAIT_L(0); PG8_BAR; PG8_MMA(0, 0, At, B0); PG8_MMA(0, 1, At, B1); PG8_BAR; PG8_SCHED;
            PG8_LDA(At, 0, 1); PG8_STAGE(PG8_SB(0, 0), b2, voffB); PG8_STAGE(PG8_SB(0, 1), b2 + hstep, voffB); PG8_STAGE(PG8_SA(0, 0), a2, v2[0]);
            PG8_WAIT_V(8); PG8_WAIT_L(0); PG8_BAR; PG8_MMA(1, 0, At, B0); PG8_MMA(1, 1, At, B1); PG8_BAR; PG8_SCHED;
            PG8_LDB(B0, 1, 0); PG8_LDB(B1, 1, 1); PG8_SCHED; PG8_LDA(At, 1, 0); PG8_STAGE(PG8_SA(0, 1), a2, v2[1]);
            PG8_WAIT_V(8); PG8_WAIT_L(0); PG8_BAR; PG8_MMA(0, 0, At, B0); PG8_MMA(0, 1, At, B1); PG8_BAR; PG8_SCHED;
            PG8_LDA(At, 1, 1); PG8_STAGE(PG8_SB(1, 0), b3, voffB); PG8_STAGE(PG8_SB(1, 1), b3 + hstep, voffB); PG8_STAGE(PG8_SA(1, 0), a3, v2[0]);
            PG8_WAIT_V(8); PG8_WAIT_L(0); PG8_BAR; PG8_MMA(1, 0, At, B0); PG8_MMA(1, 1, At, B1); PG8_BAR; PG8_SCHED;
            } else {
            PG8_LDB(B0, 0, 0); PG8_SCHED; PG8_LDA(At, 0, 0); PG8_STAGE(PG8_SA(1, 1), a1, vC[1]);
            PG8_WAIT_L(8); PG8_BAR; PG8_WAIT_L(0); PG8_MMA(0, 0, At, B0); PG8_BAR; PG8_SCHED;
            PG8_LDB(B1, 0, 1); PG8_STAGE(PG8_SB(0, 0), b2, voffB);
            PG8_BAR; PG8_WAIT_L(0); PG8_MMA(0, 1, At, B1); PG8_BAR;
            PG8_LDA(At, 0, 1); PG8_STAGE(PG8_SA(0, 0), a2, v2[0]);
            PG8_BAR; PG8_WAIT_L(0); PG8_MMA(1, 0, At, B0); PG8_BAR; PG8_SCHED;
            PG8_STAGE(PG8_SB(0, 1), b2 + hstep, voffB);
            PG8_WAIT_V(6); PG8_BAR; PG8_MMA(1, 1, At, B1); PG8_BAR;
            PG8_LDB(B0, 1, 0); PG8_SCHED; PG8_LDA(At, 1, 0); PG8_STAGE(PG8_SA(0, 1), a2, v2[1]);
            PG8_WAIT_L(8); PG8_BAR; PG8_WAIT_L(0); PG8_MMA(0, 0, At, B0); PG8_BAR; PG8_SCHED;
            PG8_LDB(B1, 1, 1); PG8_STAGE(PG8_SB(1, 0), b3, voffB);
            PG8_BAR; PG8_WAIT_L(0); PG8_MMA(0, 1, At, B1); PG8_BAR;
            PG8_LDA(At, 1, 1); PG8_STAGE(PG8_SA(1, 0), a3, v2[0]);
            PG8_BAR; PG8_WAIT_L(0); PG8_MMA(1, 0, At, B0); PG8_BAR; PG8_SCHED;
            PG8_STAGE(PG8_SB(1, 1), b3 + hstep, voffB);
            PG8_WAIT_V(6); PG8_BAR; PG8_MMA(1, 1, At, B1); PG8_BAR;
            }
        }
        if constexpr (ALIGN_EPI) { if (wr == 0) PG8_BAR; }
        if constexpr (!Epi::AFTER_DRAIN) { E(acc, cur, wr, wc, fr, fq); S.done(cur); }
        if (!has_next) break;
#pragma unroll
        for (int a = 0; a < 2; ++a)
#pragma unroll
            for (int b = 0; b < 2; ++b)
#pragma unroll
                for (int m = 0; m < 4; ++m)
#pragma unroll
                    for (int n = 0; n < 2; ++n) acc[a][b][m][n] = (f32x4){0.f, 0.f, 0.f, 0.f};
        cur = nxt; cA = nA; cB = nB; ++ui; vC[0][0] = vN[0][0]; vC[0][1] = vN[0][1]; vC[1][0] = vN[1][0]; vC[1][1] = vN[1][1];
        if constexpr (ALIGN_EPI) { if (wr == 1) PG8_BAR; }
    }
    PG8_WAIT_V(0);
    if constexpr (!ALIGN_EPI) { if (wr == 0) PG8_BAR; }
    PG8_BAR;
    if constexpr (Epi::AFTER_DRAIN) { E.fused(acc, cur, wr, wc, fr, fq, lds, wid, lane); S.done(cur); }
#undef PG8_SA
#undef PG8_SB
#undef PG8_STAGE
#undef PG8_LDA
#undef PG8_LDB
#undef PG8_MMA
#undef PG8_WAIT_V
#undef PG8_WAIT_L
#undef PG8_BAR
#undef PG8_SCHED
}

__device__ __forceinline__ u32x4 pack8(const f32x4 v0, const f32x4 v1) { u32x4 w; w.x = cvt_pk_bf16(v0[0], v0[1]); w.y = cvt_pk_bf16(v0[2], v0[3]); w.z = cvt_pk_bf16(v1[0], v1[1]); w.w = cvt_pk_bf16(v1[2], v1[3]); return w; }
__device__ __forceinline__ f32x4 sig4(const f32x4 v) { return (f32x4){fsig(v[0]), fsig(v[1]), fsig(v[2]), fsig(v[3])}; }

struct EpiProj {
    static constexpr bool PERM = true, AFTER_DRAIN = false; static constexpr int MIDK = 0;
    const float* rstd; bf16_t *vglu, *qb, *kvb, *sgc, *sga; float qscale;
    __device__ __forceinline__ void operator()(const f32x4 (&acc)[2][2][4][2], const Unit& u, int wr, int wc, int fr, int fq) const {
        const int pn = __builtin_amdgcn_readfirstlane(u.pn); const int coff = wc * 32 + 8 * fq; const int row0 = u.pm * BM + wr * 64 + fr;
#pragma unroll
        for (int ai = 0; ai < 2; ++ai)
#pragma unroll
            for (int m = 0; m < 4; ++m) {
                const int r = row0 + ai * HALF + m * 16; const float s = rstd[r];
                const f32x4 a0 = acc[ai][0][m][0] * s, a1 = acc[ai][0][m][1] * s, b0 = acc[ai][1][m][0] * s, b1 = acc[ai][1][m][1] * s;
                if (pn < 4) {
                    *(u32x4*)(vglu + (size_t)r * CC + 128 * pn + coff) = pack8(a0 * sig4(b0), a1 * sig4(b1));
                } else if (pn < 6) {
                    bf16_t* qp = qb + (size_t)r * QD + 256 * (pn - 4) + coff;
                    *(u32x4*)qp = pack8(a0 * qscale, a1 * qscale); *(u32x4*)(qp + HALF) = pack8(b0 * qscale, b1 * qscale);
                } else if (pn == 6) {
                    bf16_t* kp = kvb + (size_t)r * 256 + coff;
                    *(u32x4*)kp = pack8(a0, a1); *(u32x4*)(kp + HALF) = pack8(b0, b1);
                } else {
                    const size_t o = (size_t)r * D + 128 * (pn - 7) + coff;
                    f32x4 r0, r1, s0, s1;
#pragma unroll
                    for (int q = 0; q < 4; ++q) { const float ea0 = 1.f + __builtin_amdgcn_exp2f(-LOG2E * b0[q]), ec0 = 1.f + __builtin_amdgcn_exp2f(-LOG2E * a0[q]), ea1 = 1.f + __builtin_amdgcn_exp2f(-LOG2E * b1[q]), ec1 = 1.f + __builtin_amdgcn_exp2f(-LOG2E * a1[q]);
                        s0[q] = __builtin_amdgcn_rcpf(ea0); r0[q] = ea0 * __builtin_amdgcn_rcpf(ec0); s1[q] = __builtin_amdgcn_rcpf(ea1); r1[q] = ea1 * __builtin_amdgcn_rcpf(ec1); }
                    *(u32x4*)(sgc + o) = pack8(r0, r1); *(u32x4*)(sga + o) = pack8(s0, s1);
                }
            }
    }
};
struct EpiMerge {
    static constexpr bool PERM = true, AFTER_DRAIN = false; static constexpr int MIDK = 8;
    const bf16_t* R; const bf16_t* G; bf16_t* O;
    __device__ __forceinline__ void mid(f32x4 (&acc)[2][2][4][2], const Unit& u, int wr, int wc, int fr, int fq) const {
        const char* Rb = (const char*)R + (size_t)u.pm * BM * D * 2;
        const unsigned ob = (unsigned)((wr * 64 + opaque_i(fr)) * D + u.pn * BM + wc * 32 + 8 * fq) * 2u;
#pragma unroll
        for (int ai = 0; ai < 2; ++ai)
#pragma unroll
            for (int m = 0; m < 4; ++m) {
#pragma unroll
                for (int bj = 0; bj < 2; ++bj) { const u32x4 g = *(const u32x4*)(Rb + (ob + (unsigned)(((ai * HALF + m * 16) * D + bj * HALF) * 2)));
                    acc[ai][bj][m][0] *= (f32x4){bf_lo(g.x), bf_hi(g.x), bf_lo(g.y), bf_hi(g.y)}; acc[ai][bj][m][1] *= (f32x4){bf_lo(g.z), bf_hi(g.z), bf_lo(g.w), bf_hi(g.w)}; }
                if (m == 3) asm volatile("" ::: "memory");
            }
    }
    __device__ __forceinline__ void operator()(const f32x4 (&acc)[2][2][4][2], const Unit& u, int wr, int wc, int fr, int fq) const {
        const int row0 = u.pm * BM + wr * 64 + opaque_i(fr), col0 = u.pn * BM + wc * 32 + 8 * fq;
#pragma unroll
        for (int ai = 0; ai < 2; ++ai)
#pragma unroll
            for (int m = 0; m < 4; ++m) {
                const size_t o = (size_t)(row0 + ai * HALF + m * 16) * D + col0;
#pragma unroll
                for (int bj = 0; bj < 2; ++bj) { const u32x4 g = *(const u32x4*)(G + o + bj * HALF);
                    *(u32x4*)(O + o + bj * HALF) = pack8(acc[ai][bj][m][0] * (f32x4){bf_lo(g.x), bf_hi(g.x), bf_lo(g.y), bf_hi(g.y)}, acc[ai][bj][m][1] * (f32x4){bf_lo(g.z), bf_hi(g.z), bf_lo(g.w), bf_hi(g.w)}); }
                if (m & 1) asm volatile("" ::: "memory");
            }
    }
};
struct EpiDelta {
    static constexpr bool PERM = true, AFTER_DRAIN = false; static constexpr int MIDK = 0;
    bf16_t* O;
    __device__ __forceinline__ void operator()(const f32x4 (&acc)[2][2][4][2], const Unit& u, int wr, int wc, int fr, int fq) const {
        const int row0 = u.pm * BM + wr * 64 + fr, col0 = u.pn * BM + wc * 32 + 8 * fq;
#pragma unroll
        for (int ai = 0; ai < 2; ++ai)
#pragma unroll
            for (int m = 0; m < 4; ++m) {
                bf16_t* op = O + (size_t)(row0 + ai * HALF + m * 16) * D + col0;
                *(u32x4*)op = pack8(acc[ai][0][m][0], acc[ai][0][m][1]); *(u32x4*)(op + HALF) = pack8(acc[ai][1][m][0], acc[ai][1][m][1]);
            }
    }
};
}


constexpr size_t MiB = 1u << 20;
constexpr size_t WS_CTL = 0, CTL_BYTES = 1 * MiB;
constexpr size_t WS_WT_IN = 2 * MiB;
constexpr size_t WS_WT_MIX = 10 * MiB;
constexpr size_t WS_WT_OUT = 12 * MiB;
constexpr size_t WS_WT_GU = 16 * MiB;
constexpr size_t WS_WT_D = 80 * MiB;
constexpr size_t WS_RSTD1 = 112 * MiB;
constexpr size_t WS_TOKE = 113 * MiB;
constexpr size_t WS_TOKR = 113 * MiB + 512 * 1024;
constexpr size_t WS_LTOK = 114 * MiB, WS_LRS = 118 * MiB, WS_LW = 122 * MiB;
constexpr size_t WS_XB = 128 * MiB;
constexpr size_t WS_MERGED = WS_XB;
constexpr size_t WS_VGLU = 192 * MiB;
constexpr size_t WS_QB = 224 * MiB;
constexpr size_t WS_DELTA = 192 * MiB;
constexpr size_t WS_HB = 128 * MiB;
constexpr size_t WS_KVB = 256 * MiB;
constexpr size_t WS_SGC = 272 * MiB, WS_SGA = 336 * MiB;
constexpr size_t WS_Y = 256 * MiB;
constexpr size_t WS_MIX = 400 * MiB;
constexpr size_t WS_HMID = 400 * MiB;
constexpr size_t WS_END = 472 * MiB;
constexpr int CAP = 32768;
constexpr int NSLOT = 2 * T + NE * 256;
static_assert(WS_Y + (size_t)NSLOT * D * 2 <= WS_MIX && WS_HMID + (size_t)NSLOT * DFF * 2 <= WS_END, "d_ws map");
constexpr int CW_BAR = 4096, CW_CNT = 16384;
constexpr int RING_BYTES = 131072, LDS_BYTES = 147456, MISC_OFF = LDS_BYTES - 128;
constexpr int MOE_TBL_OFF = RING_BYTES, MOE_MAXU = 8;
constexpr int MOE_UT_OFF = MOE_TBL_OFF + MOE_MAXU * 1024, MOE_NBP_OFF = MOE_UT_OFF + MOE_MAXU * 16, MOE_CNT_OFF = MOE_NBP_OFF + 160;
static_assert(MOE_CNT_OFF + 128 <= MISC_OFF, "LDS map");

#define XB_TMO      128
#define XB_XCNT(j)  (256  + 64 * (j))
#define XB_XSUB(j)  (1280 + 64 * (j))
#define XB_XGEN(j)  (2304 + 64 * (j))
#define XB_TOP      3328
#define XB_TOPGEN   3392
#define XCD_BAR_WORDS 3456
#define XB_SPIN_CAP (1u << 18)

__device__ __forceinline__ unsigned xb_ld(unsigned* p)              { return __hip_atomic_load(p, __ATOMIC_RELAXED, __HIP_MEMORY_SCOPE_AGENT); }
__device__ __forceinline__ unsigned xb_add(unsigned* p, unsigned v) { return __hip_atomic_fetch_add(p, v, __ATOMIC_RELAXED, __HIP_MEMORY_SCOPE_AGENT); }
__device__ __forceinline__ unsigned xb_xcc_id() { return (unsigned)__builtin_amdgcn_s_getreg((3 << 11) | 20) & 0xFu; }
#define XB_SPIN(cond, bar) do { unsigned _sp = 0; while (cond) { __builtin_amdgcn_s_sleep(1); \
    if ((++_sp & 255u) == 0u) { if (xb_ld(&(bar)[XB_TMO])) break; if (_sp > XB_SPIN_CAP) { atomicAdd(&(bar)[XB_TMO], 1u); break; } } } } while (0)

struct XcdBarrier { unsigned* bar; unsigned x; volatile LAS unsigned* st; bool leader; };

__device__ __forceinline__ XcdBarrier xcd_barrier_post(unsigned* bar, volatile LAS unsigned* st, bool wave0) {
    XcdBarrier b; b.bar = bar; b.x = xb_xcc_id(); b.st = st; b.leader = wave0;
    if (wave0 && lane_id_v() == 0) (void)xb_add(&bar[XB_XCNT(b.x)], 1u);
    return b;
}
__device__ __forceinline__ void xcd_barrier_complete(unsigned* bar, unsigned x, unsigned& nloc, unsigned& nx) {
    const unsigned G = gridDim.x * gridDim.y * gridDim.z;
    unsigned sum, cnt, mine, sp = 0u;
    for (;;) {
        sum = 0u; cnt = 0u; mine = 0u;
#pragma unroll
        for (unsigned j = 0; j < 16; ++j) { const unsigned c = xb_ld(&bar[XB_XCNT(j)]); sum += c; cnt += (c > 0u) ? 1u : 0u; mine = (j == x) ? c : mine; }
        if (sum == G) break;
        __builtin_amdgcn_s_sleep(1);
        if ((++sp & 255u) == 0u) { if (xb_ld(&bar[XB_TMO])) break; if (sp > XB_SPIN_CAP) { atomicAdd(&bar[XB_TMO], 1u); break; } }
    }
    nloc = mine > 0u ? mine : 1u; nx = cnt > 0u ? cnt : 1u;
}
__device__ __forceinline__ void xcd_barrier(const XcdBarrier& b) {
    asm volatile("s_waitcnt vmcnt(0)" ::: "memory");
    __syncthreads();
    if (b.leader && lane_id_v() == 0) {
        unsigned* bar = b.bar;
        __builtin_amdgcn_s_waitcnt(0);
        unsigned nloc = b.st[0], nx = b.st[1];
        if (nloc == 0u) { xcd_barrier_complete(bar, b.x, nloc, nx); b.st[0] = nloc; b.st[1] = nx; }
        const unsigned old = xb_add(&bar[XB_XSUB(b.x)], 1u);
        const unsigned gen = old / nloc;
        if (old + 1u == (gen + 1u) * nloc) {
            __builtin_amdgcn_fence(__ATOMIC_RELEASE, "agent");
            asm volatile("s_waitcnt vmcnt(0)" ::: "memory");
            const unsigned og = xb_add(&bar[XB_TOP], 1u);
            const unsigned tg = og / nx;
            if (og + 1u == (tg + 1u) * nx) xb_add(&bar[XB_TOPGEN], 1u);
            else XB_SPIN(xb_ld(&bar[XB_TOPGEN]) == tg, bar);
            __builtin_amdgcn_fence(__ATOMIC_ACQUIRE, "agent");
            xb_add(&bar[XB_XGEN(b.x)], 1u);
            asm volatile("s_waitcnt vmcnt(0)" ::: "memory");
        } else {
            XB_SPIN(xb_ld(&bar[XB_XGEN(b.x)]) == gen, bar);
            __builtin_amdgcn_fence(__ATOMIC_ACQUIRE, "agent");
            asm volatile("s_waitcnt vmcnt(0)" ::: "memory");
        }
    }
    __syncthreads();
}

struct Params {
    const float *x, *g_mix, *w_in, *w_dw, *b_dw, *ln_g, *ln_b, *sinks, *w_conv_out, *w_attn_out, *w_out, *g_ffn,
                *w_group, *b_group, *w_expert, *b_expert, *w_gate, *w_up, *w_down, *g_final;
    float* out; unsigned char* ws;
};
typedef const __attribute__((address_space(4))) Params CParams;

__device__ __forceinline__ void p0_transpose_item(const float* W, int ld, int srccol, int k0, const float* gain, bf16_t* WT, int K, int dstrow, LAS float* scr, int lane) {
    const int ksub = lane >> 3, n4 = (lane & 7) * 4;
    f32x4 v[8];
#pragma unroll
    for (int i = 0; i < 8; ++i) v[i] = *(const f32x4*)(W + (size_t)(k0 + 8 * i + ksub) * ld + srccol + n4);
    if (gain) {
#pragma unroll
        for (int i = 0; i < 8; ++i) v[i] *= gain[k0 + 8 * i + ksub]; }
#pragma unroll
    for (int i = 0; i < 8; ++i) { LAS float* d = scr + (8 * i + ksub) * 33 + n4; d[0] = v[i][0]; d[1] = v[i][1]; d[2] = v[i][2]; d[3] = v[i][3]; }
    asm volatile("s_waitcnt lgkmcnt(0)" ::: "memory");
    const int c = lane & 7;
#pragma unroll
    for (int j = 0; j < 4; ++j) { const int n = (lane >> 3) + 8 * j; const LAS float* s = scr + (8 * c) * 33 + n;
        u32x4 o; o.x = cvt_pk_bf16(s[0 * 33], s[1 * 33]); o.y = cvt_pk_bf16(s[2 * 33], s[3 * 33]); o.z = cvt_pk_bf16(s[4 * 33], s[5 * 33]); o.w = cvt_pk_bf16(s[6 * 33], s[7 * 33]);
        *(u32x4*)(WT + (size_t)(dstrow + n) * K + k0 + 8 * c) = o; }
    asm volatile("s_waitcnt lgkmcnt(0)" ::: "memory");
}
__device__ __forceinline__ int win_srccol(int np) {
    const int pn = np >> 8, bj = (np >> 7) & 1, o = np & 127;
    if (pn < 4) return (bj ? 512 : 0) + 128 * pn + o;
    if (pn < 6) return 1024 + 256 * (pn - 4) + 128 * bj + o;
    if (pn == 6) return (bj ? 1664 : 1536) + o;
    return (bj ? 2816 : 1792) + 128 * (pn - 7) + o;
}
__device__ __forceinline__ void p0_prologue(CParams& p, LAS unsigned char* lds, const int wave_s) {
    unsigned char* ws = p.ws;
    const int tidx = opaque_tid(wave_s), lane = tidx & 63, wave = tidx >> 6;
    LAS float* scr = (LAS float*)(lds + wave * 16384);
    const int gw = blockIdx.x * (NT / 64) + wave, NGW = gridDim.x * (NT / 64);
    bf16_t* wt_in = (bf16_t*)(ws + WS_WT_IN); bf16_t* wt_mix = (bf16_t*)(ws + WS_WT_MIX); bf16_t* wt_out = (bf16_t*)(ws + WS_WT_OUT);
    constexpr int I_IN = (D / 64) * (INC / 32), I_CO = (CC / 64) * (D / 32), I_AO = (QD / 64) * (D / 32), I_OUT = (D / 64) * (D / 32);
    constexpr int NITEMS = I_IN + I_CO + I_AO + I_OUT;
    for (int it = gw; it < NITEMS; it += NGW) {
        int r = it;
        if (r < I_IN) { const int nblk = INC / 32, kb = r / nblk, nb = r % nblk; p0_transpose_item(p.w_in, INC, win_srccol(32 * nb), 64 * kb, p.g_mix, wt_in, D, 32 * nb, scr, lane); continue; } r -= I_IN;
        if (r < I_CO) { const int nblk = D / 32, kb = r / nblk, nb = r % nblk; p0_transpose_item(p.w_conv_out, D, 32 * nb, 64 * kb, nullptr, wt_mix, D, 32 * nb, scr, lane); continue; } r -= I_CO;
        if (r < I_AO) { const int nblk = D / 32, kb = r / nblk, nb = r % nblk; p0_transpose_item(p.w_attn_out, D, 32 * nb, 64 * kb, nullptr, wt_mix + CC, D, 32 * nb, scr, lane); continue; } r -= I_AO;
        { const int nblk = D / 32, kb = r / nblk, nb = r % nblk; p0_transpose_item(p.w_out, D, 32 * nb, 64 * kb, nullptr, wt_out, D, 32 * nb, scr, lane); }
    }
    bf16_t* xb = (bf16_t*)(ws + WS_XB); float* rstd1 = (float*)(ws + WS_RSTD1);
    for (int m = gw; m < T; m += NGW) {
        const f32x4* xr = (const f32x4*)(p.x + (size_t)m * D) + lane;
        f32x4 v[4]; float s = 0.f;
#pragma unroll
        for (int j = 0; j < 4; ++j) { v[j] = xr[64 * j]; s += (v[j][0] * v[j][0] + v[j][1] * v[j][1]) + (v[j][2] * v[j][2] + v[j][3] * v[j][3]); }
        s = wave_sum(s);
        if (lane == 0) rstd1[m] = rsqrtf(s * (1.f / D) + EPS);
        u32x2* o = (u32x2*)(xb + (size_t)m * D) + lane;
#pragma unroll
        for (int j = 0; j < 4; ++j) { u32x2 w; w.x = cvt_pk_bf16(v[j][0], v[j][1]); w.y = cvt_pk_bf16(v[j][2], v[j][3]); o[64 * j] = w; }
    }
}

template <int N> __device__ __forceinline__ void red_step(float (&v)[16], int lane, int k) {
#pragma unroll
    for (int a = 0; a < N / 2; ++a) { const bool up = (lane & k) != 0; const float send = up ? v[a] : v[a + N / 2], keep = up ? v[a + N / 2] : v[a]; v[a] = keep + __shfl_xor(send, k); }
}
constexpr int CONV_ROWS = 64 + CW - 1;
__device__ __forceinline__ void conv_phase(CParams& p, const bf16_t* vglu, bf16_t* cact, LAS unsigned char* lds, const int wave_s) {
    const int tid = opaque_tid(wave_s), lane = tid & 63, wid = tid >> 6, cp = tid & 255, th = tid >> 8, wq = wid & 3;
    float w0[CW], w1[CW];
#pragma unroll
    for (int j = 0; j < CW; ++j) { w0[j] = p.w_dw[j * CC + 2 * cp]; w1[j] = p.w_dw[j * CC + 2 * cp + 1]; }
    const float bi0 = p.b_dw[2 * cp], bi1 = p.b_dw[2 * cp + 1], lg0 = p.ln_g[2 * cp], lg1 = p.ln_g[2 * cp + 1], lb0 = p.ln_b[2 * cp], lb1 = p.ln_b[2 * cp + 1];
    LAS unsigned char* Vs = lds;
    LAS float* red = (LAS float*)(lds + CONV_ROWS * 1024);
    u32x4 creg[12];
#define CONV_PREFETCH(cbb) do { const int t0_ = (cbb) * 64, seq0_ = (t0_ / SEQ) * SEQ; \
        _Pragma("unroll") for (int j = 0; j < 12; ++j) { const int c = tid + j * NT, row = c >> 6, ch = c & 63, pos = t0_ - (CW - 1) + row; creg[j] = (u32x4){0u, 0u, 0u, 0u}; \
            if (c < CONV_ROWS * 64 && pos >= seq0_) creg[j] = *(const u32x4*)(vglu + (size_t)pos * CC + ch * 8); } } while (0)
    if ((int)blockIdx.x < T / 64) CONV_PREFETCH((int)blockIdx.x);
    for (int cb = blockIdx.x; cb < T / 64; cb += gridDim.x) {
        const int t0 = cb * 64;
        __syncthreads();
#pragma unroll
        for (int j = 0; j < 12; ++j) { const int c = tid + j * NT, row = c >> 6, ch = c & 63; if (c < CONV_ROWS * 64) *(LAS u32x4*)(Vs + row * 1024 + ch * 16) = creg[j]; }
        if (cb + (int)gridDim.x < T / 64) CONV_PREFETCH(cb + (int)gridDim.x);
        __syncthreads();
#pragma unroll 1
        for (int grp = 0; grp < 4; ++grp) {
            float y[8][2]; const int tok0 = 32 * th + 8 * grp;
#pragma unroll
            for (int i = 0; i < 8; ++i) { y[i][0] = bi0; y[i][1] = bi1; }
            { const LAS unsigned char* base = Vs + tok0 * 1024 + cp * 4;
#pragma unroll
                for (int r = 0; r < 8 + CW - 1; ++r) { const unsigned pr = *(const LAS unsigned*)(base + r * 1024); const float lo = bf_lo(pr), hi2 = bf_hi(pr);
#pragma unroll
                    for (int i = 0; i < 8; ++i) { const int j = r - i; if (j >= 0 && j < CW) { y[i][0] = fmaf(w0[j], lo, y[i][0]); y[i][1] = fmaf(w1[j], hi2, y[i][1]); } } } }
            float v[16];
#pragma unroll
            for (int i = 0; i < 8; ++i) { v[i] = y[i][0] + y[i][1]; v[8 + i] = y[i][0] * y[i][0] + y[i][1] * y[i][1]; }
            red_step<16>(v, lane, 32); red_step<8>(v, lane, 16); red_step<4>(v, lane, 8); red_step<2>(v, lane, 4);
            float tot = v[0]; tot += __shfl_xor(tot, 2); tot += __shfl_xor(tot, 1);
            const int idx = ((lane >> 5) & 1) * 8 + ((lane >> 4) & 1) * 4 + ((lane >> 3) & 1) * 2 + ((lane >> 2) & 1);
            LAS float* rb = red + (grp & 1) * 128;
            if ((lane & 3) == 0) rb[(th * 4 + wq) * 16 + idx] = tot;
            __syncthreads();
#pragma unroll
            for (int i = 0; i < 8; ++i) {
                float S = 0.f, Q = 0.f;
#pragma unroll
                for (int q = 0; q < 4; ++q) { S += rb[(th * 4 + q) * 16 + i]; Q += rb[(th * 4 + q) * 16 + 8 + i]; }
                const float mean = S * (1.f / CC), var = Q * (1.f / CC) - mean * mean, rstd = rsqrtf(fmaxf(var, 0.f) + EPS);
                float z0 = (y[i][0] - mean) * rstd * lg0 + lb0, z1 = (y[i][1] - mean) * rstd * lg1 + lb1;
                z0 *= fsig(z0); z1 *= fsig(z1);
                *(unsigned*)(cact + (size_t)(t0 + tok0 + i) * D + 2 * cp) = cvt_pk_bf16(z0, z1);
            }
        }
    }
}

__device__ __forceinline__ int crow(int r, int hi) { return (r & 3) + 8 * (r >> 2) + 4 * hi; }
constexpr int ATT_KS = 144, ATT_VT = 400, ATT_VT_OFF = 192 * ATT_KS;
__device__ __forceinline__ void attn_phase(CParams& p, const bf16_t* qb, const bf16_t* kvb, bf16_t* att, LAS unsigned char* lds, const int wave_s) {
    const int tid = opaque_tid(wave_s), lane = tid & 63, wid = __builtin_amdgcn_readfirstlane(tid >> 6), r32 = lane & 31, hi = lane >> 5, g = wid & 3, w2 = wid >> 2;
    LAS unsigned char* Ks = lds; LAS unsigned char* Vt = lds + ATT_VT_OFF;
    u32x4 kreg[3], vreg[3];
#define ATT_PREFETCH(uu) do { const int qb_ = (uu) >> 1, kvh_ = (uu) & 1, t0_ = qb_ * 64, seq0_ = (t0_ / SEQ) * SEQ; \
        _Pragma("unroll") for (int j = 0; j < 3; ++j) { const int c = tid + j * NT, row = c >> 3, ch = c & 7, pos = t0_ - 128 + row; kreg[j] = (u32x4){0u, 0u, 0u, 0u}; vreg[j] = kreg[j]; \
            if (pos >= seq0_) { const bf16_t* src = kvb + (size_t)pos * 256 + kvh_ * HD + ch * 8; kreg[j] = *(const u32x4*)src; vreg[j] = *(const u32x4*)(src + 128); } } } while (0)
    if ((int)blockIdx.x < (T / 64) * 2) ATT_PREFETCH((int)blockIdx.x);
    for (int u = blockIdx.x; u < (T / 64) * 2; u += gridDim.x) {
        const int qblk = u >> 1, kvh = u & 1, t0 = qblk * 64, seq0 = (t0 / SEQ) * SEQ, h = kvh * 4 + g;
        const int tw = t0 + 32 * w2;
        bf16x8 qf[4]; { const bf16_t* qp = qb + (size_t)(tw + r32) * QD + h * HD + hi * 8;
#pragma unroll
            for (int ks = 0; ks < 4; ++ks) qf[ks] = *(const bf16x8*)(qp + ks * 16); }
        __syncthreads();
#pragma unroll
        for (int j = 0; j < 3; ++j) {
            const int c = tid + j * NT, row = c >> 3, ch = c & 7; const u32x4 vv = vreg[j];
            *(LAS u32x4*)(Ks + row * ATT_KS + ch * 16) = kreg[j];
            LAS bf16_t* vt = (LAS bf16_t*)(Vt + (ch * 8) * ATT_VT) + row;
            vt[0 * (ATT_VT / 2)] = (bf16_t)(vv.x & 0xffffu); vt[1 * (ATT_VT / 2)] = (bf16_t)(vv.x >> 16); vt[2 * (ATT_VT / 2)] = (bf16_t)(vv.y & 0xffffu); vt[3 * (ATT_VT / 2)] = (bf16_t)(vv.y >> 16);
            vt[4 * (ATT_VT / 2)] = (bf16_t)(vv.z & 0xffffu); vt[5 * (ATT_VT / 2)] = (bf16_t)(vv.z >> 16); vt[6 * (ATT_VT / 2)] = (bf16_t)(vv.w & 0xffffu); vt[7 * (ATT_VT / 2)] = (bf16_t)(vv.w >> 16);
        }
        if (u + (int)gridDim.x < (T / 64) * 2) ATT_PREFETCH(u + (int)gridDim.x);
        __syncthreads();
        f32x16 pt[5];
#pragma unroll
        for (int jj = 0; jj < 5; ++jj) { f32x16 a = {0.f, 0.f, 0.f, 0.f, 0.f, 0.f, 0.f, 0.f, 0.f, 0.f, 0.f, 0.f, 0.f, 0.f, 0.f, 0.f};
            const LAS unsigned char* kp = Ks + (32 * (w2 + jj) + r32) * ATT_KS + hi * 16;
#pragma unroll
            for (int ks = 0; ks < 4; ++ks) { const bf16x8 kf = *(const LAS bf16x8*)(kp + ks * 32); a = __builtin_amdgcn_mfma_f32_32x32x16_bf16(kf, qf[ks], a, 0, 0, 0); }
            pt[jj] = a; __builtin_amdgcn_sched_barrier(0); }
        const float slope2 = exp2f(-(float)(h + 1)) * LOG2E, sink2 = p.sinks[h] * LOG2E;
        const int kmin = seq0 - (tw - 128); const int r32o = opaque_i(r32), hio = opaque_i(hi);
        float m = sink2;
#pragma unroll
        for (int jj = 0; jj < 5; ++jj)
#pragma unroll
            for (int r = 0; r < 16; ++r) { const int kw = 32 * jj + crow(r, hio), rel = 128 + r32o - kw; const bool valid = (kw > r32o) && (kw <= r32o + 128) && (kw >= kmin);
                const float s = valid ? pt[jj][r] - slope2 * (float)rel : -INFINITY; pt[jj][r] = s; m = fmaxf(m, s); }
        m = fmaxf(m, __shfl_xor(m, 32));
        float l = 0.f;
#pragma unroll
        for (int jj = 0; jj < 5; ++jj)
#pragma unroll
            for (int r = 0; r < 16; ++r) { const float e = __builtin_amdgcn_exp2f(pt[jj][r] - m); pt[jj][r] = e; l += e; }
        l += __shfl_xor(l, 32); l += __builtin_amdgcn_exp2f(sink2 - m);
        f32x16 o0 = {0.f, 0.f, 0.f, 0.f, 0.f, 0.f, 0.f, 0.f, 0.f, 0.f, 0.f, 0.f, 0.f, 0.f, 0.f, 0.f}, o1 = o0;
#pragma unroll
        for (int jj = 0; jj < 5; ++jj)
#pragma unroll
            for (int s2 = 0; s2 < 2; ++s2) {
                u32x4 pw; pw.x = cvt_pk_bf16(pt[jj][8 * s2 + 0], pt[jj][8 * s2 + 1]); pw.y = cvt_pk_bf16(pt[jj][8 * s2 + 2], pt[jj][8 * s2 + 3]);
                pw.z = cvt_pk_bf16(pt[jj][8 * s2 + 4], pt[jj][8 * s2 + 5]); pw.w = cvt_pk_bf16(pt[jj][8 * s2 + 6], pt[jj][8 * s2 + 7]);
                const bf16x8 pf = __builtin_bit_cast(bf16x8, pw);
                const LAS unsigned char* vp = Vt + r32 * ATT_VT + (32 * (w2 + jj) + 16 * s2 + 4 * hi) * 2;
                const u32x2 a0 = *(const LAS u32x2*)vp, a1 = *(const LAS u32x2*)(vp + 16), b0 = *(const LAS u32x2*)(vp + 32 * ATT_VT), b1 = *(const LAS u32x2*)(vp + 32 * ATT_VT + 16);
                const bf16x8 vf0 = __builtin_bit_cast(bf16x8, (u32x4){a0.x, a0.y, a1.x, a1.y}), vf1 = __builtin_bit_cast(bf16x8, (u32x4){b0.x, b0.y, b1.x, b1.y});
                o0 = __builtin_amdgcn_mfma_f32_32x32x16_bf16(vf0, pf, o0, 0, 0, 0); o1 = __builtin_amdgcn_mfma_f32_32x32x16_bf16(vf1, pf, o1, 0, 0, 0);
                __builtin_amdgcn_sched_barrier(0);
            }
        const float inv = 1.f / l;
        bf16_t* op = att + (size_t)(tw + r32) * D + h * HD + 4 * hi;
#pragma unroll
        for (int rg = 0; rg < 4; ++rg) {
            u32x2 w0, w1; w0.x = cvt_pk_bf16(o0[4 * rg] * inv, o0[4 * rg + 1] * inv); w0.y = cvt_pk_bf16(o0[4 * rg + 2] * inv, o0[4 * rg + 3] * inv);
            w1.x = cvt_pk_bf16(o1[4 * rg] * inv, o1[4 * rg + 1] * inv); w1.y = cvt_pk_bf16(o1[4 * rg + 2] * inv, o1[4 * rg + 3] * inv);
            *(u32x2*)(op + 8 * rg) = w0; *(u32x2*)(op + 32 + 8 * rg) = w1; }
    }
#undef ATT_PREFETCH
}


__device__ __forceinline__ void p0_moe_weights(CParams& p, LAS unsigned char* lds, const int wave_s, int it0, int it1, int wk, int nwk) {
    unsigned char* ws = p.ws;
    const int tidx = opaque_tid(wave_s), lane = tidx & 63, wave = tidx >> 6;
    LAS float* scr = (LAS float*)(lds + wave * 16384);
    bf16_t* wt_gu = (bf16_t*)(ws + WS_WT_GU); bf16_t* wt_d = (bf16_t*)(ws + WS_WT_D);
    constexpr int I_GU = (D / 64) * (1024 / 32), I_D = (DFF / 64) * (D / 32);
    for (int it = it0 + wk; it < it1; it += nwk) {
        const int e = it / (I_GU + I_D); int r = it % (I_GU + I_D);
        if (r < I_GU) { const int kb = r >> 5, nb = r & 31, np = 32 * nb, pn = np >> 8, bj = (np >> 7) & 1, o = np & 127;
            const float* W = (bj ? p.w_up : p.w_gate) + (size_t)e * D * DFF;
            p0_transpose_item(W, DFF, 128 * pn + o, 64 * kb, p.g_ffn, wt_gu + (size_t)e * 1024 * D, D, np, scr, lane); }
        else { r -= I_GU; const int kb = r >> 5, nb = r & 31;
            p0_transpose_item(p.w_down + (size_t)e * DFF * D, D, 32 * nb, 64 * kb, nullptr, wt_d + (size_t)e * D * DFF, DFF, 32 * nb, scr, lane); }
    }
}
constexpr int MOE_ITEMS = NE * 768;
constexpr int MOE_ITEMS_P0 = 12288;

constexpr int RT_WAVE = (64 * 36 + 32 * 32 + 32 * 4) * 4;
__device__ __forceinline__ void route_phase_fast(CParams& p, const float* X, const bf16_t* delta, bf16_t* hb, int* toke, int* tokr, int* ltok, float* lrs, float* lw, unsigned* gcount,
                                                 LAS unsigned char* lds, const int wave_s) {
    const int tid = opaque_tid(wave_s), lane = tid & 63, kq = wave_s & 3, tg = wave_s >> 2, r32 = lane & 31, hi = lane >> 5;
    LAS float* tile = (LAS float*)(lds + wave_s * RT_WAVE); LAS float* Wl = tile + 64 * 36; LAS float* Wgl = Wl + 32 * 32;
    LAS unsigned* hist = (LAS unsigned*)(lds + 8 * RT_WAVE);
    for (int task = blockIdx.x; task < T / 128; task += gridDim.x) {
        const int tok0 = task * 128 + tg * 64;
        if (tid < 32) hist[tid] = 0u;
        f32x16 acc0 = {0.f, 0.f, 0.f, 0.f, 0.f, 0.f, 0.f, 0.f, 0.f, 0.f, 0.f, 0.f, 0.f, 0.f, 0.f, 0.f}, acc1 = acc0;
        f32x4 ag = {0.f, 0.f, 0.f, 0.f}; float ss = 0.f;
        f32x4 hr[8], wr[4], wgr = {0.f, 0.f, 0.f, 0.f}; u32x2 dr[8]; float gk[4], ggr = 0.f;
        const int rsub = lane >> 3, c4 = (lane & 7) * 4; const int hoff = (rsub * D + c4) * 4;
        const __amdgpu_buffer_rsrc_t rx = __builtin_amdgcn_make_buffer_rsrc((void*)X, 0, T * D * 4, 0x00020000), rd = __builtin_amdgcn_make_buffer_rsrc((void*)delta, 0, T * D * 2, 0x00020000),
            rwe = __builtin_amdgcn_make_buffer_rsrc((void*)p.w_expert, 0, D * NE * 4, 0x00020000), rwg = __builtin_amdgcn_make_buffer_rsrc((void*)p.w_group, 0, D * NG * 4, 0x00020000),
            rg = __builtin_amdgcn_make_buffer_rsrc((void*)p.g_ffn, 0, D * 4, 0x00020000), rhb = __builtin_amdgcn_make_buffer_rsrc((void*)hb, 0, T * D * 2, 0x00020000);
#define RT_LOAD(ch) do { const int k0_ = kq * 256 + (ch) * 32; const int sx_ = (tok0 * D + k0_) * 4; \
            _Pragma("unroll") for (int i = 0; i < 8; ++i) { hr[i] = __builtin_bit_cast(f32x4, __builtin_amdgcn_raw_buffer_load_b128(rx, hoff, sx_ + i * 8 * D * 4, 0)); \
                                                            dr[i] = __builtin_amdgcn_raw_buffer_load_b64(rd, hoff >> 1, (sx_ >> 1) + i * 8 * D * 2, 0); } \
            _Pragma("unroll") for (int i = 0; i < 4; ++i) { wr[i] = __builtin_bit_cast(f32x4, __builtin_amdgcn_raw_buffer_load_b128(rwe, lane * 16, k0_ * NE * 4 + i * 1024, 0)); \
                                                            gk[i] = __builtin_bit_cast(float, __builtin_amdgcn_raw_buffer_load_b32(rg, rsub * 4, (k0_ + i * 8) * 4, 0)); } \
            if (lane < 32) { wgr = __builtin_bit_cast(f32x4, __builtin_amdgcn_raw_buffer_load_b128(rwg, lane * 16, k0_ * NG * 4, 0)); ggr = __builtin_bit_cast(float, __builtin_amdgcn_raw_buffer_load_b32(rg, lane * 4, k0_ * 4, 0)); } } while (0)
        RT_LOAD(0);
#pragma unroll 1
        for (int ch = 0; ch < 8; ++ch) {
            const int k0 = kq * 256 + ch * 32;
#pragma unroll
            for (int i = 0; i < 8; ++i) { const int row = 8 * i + rsub; hr[i] += (f32x4){bf_lo(dr[i].x), bf_hi(dr[i].x), bf_lo(dr[i].y), bf_hi(dr[i].y)};
                u32x2 w; w.x = cvt_pk_bf16(hr[i][0], hr[i][1]); w.y = cvt_pk_bf16(hr[i][2], hr[i][3]);
                __builtin_amdgcn_raw_buffer_store_b64(w, rhb, hoff >> 1, (tok0 * D + k0) * 2 + i * 8 * D * 2, 0); *(LAS f32x4*)(tile + row * 36 + c4) = hr[i]; }
#pragma unroll
            for (int i = 0; i < 4; ++i) *(LAS f32x4*)(Wl + (i * 64 + lane) * 4) = wr[i] * gk[i];
            if (lane < 32) *(LAS f32x4*)(Wgl + lane * 4) = wgr * ggr;
            if (ch + 1 < 8) RT_LOAD(ch + 1);
            float bv[16];
#pragma unroll
            for (int s2 = 0; s2 < 16; ++s2) bv[s2] = Wl[(16 * hi + s2) * 32 + r32];
#pragma unroll
            for (int tt = 0; tt < 2; ++tt) {
                f32x4 a4[4];
#pragma unroll
                for (int q = 0; q < 4; ++q) a4[q] = *(const LAS f32x4*)(tile + (32 * tt + r32) * 36 + 16 * hi + 4 * q);
#pragma unroll
                for (int s2 = 0; s2 < 16; ++s2) { if (tt == 0) acc0 = __builtin_amdgcn_mfma_f32_32x32x2f32(a4[s2 >> 2][s2 & 3], bv[s2], acc0, 0, 0, 0);
                                                  else acc1 = __builtin_amdgcn_mfma_f32_32x32x2f32(a4[s2 >> 2][s2 & 3], bv[s2], acc1, 0, 0, 0); }
            }
#pragma unroll
            for (int k4 = 0; k4 < 8; ++k4) { const f32x4 hv = *(const LAS f32x4*)(tile + lane * 36 + 4 * k4);
#pragma unroll
                for (int q = 0; q < 4; ++q) { const f32x4 wg = *(const LAS f32x4*)(Wgl + (4 * k4 + q) * 4); ag += wg * hv[q]; ss = fmaf(hv[q], hv[q], ss); } }
        }
#undef RT_LOAD
#pragma unroll
        for (int r = 0; r < 16; ++r) { const int cr = (r & 3) + 8 * (r >> 2) + 4 * hi; tile[cr * 37 + 4 + r32] = acc0[r]; tile[(32 + cr) * 37 + 4 + r32] = acc1[r]; }
        tile[lane * 37 + 0] = ag[0]; tile[lane * 37 + 1] = ag[1]; tile[lane * 37 + 2] = ag[2]; tile[lane * 37 + 3] = ag[3]; tile[lane * 37 + 36] = ss;
        __syncthreads();
        int ea = 0, eb = 0; unsigned ra = 0u, rb = 0u; float w1 = 0.f, w2 = 0.f, rstd = 0.f;
        if (kq == 0) {
            float lg[NG + NE]; float s2 = 0.f;
#pragma unroll
            for (int e = 0; e < NG + NE; ++e) lg[e] = 0.f;
#pragma unroll
            for (int q = 0; q < 4; ++q) { const LAS float* pt = (const LAS float*)(lds + (tg * 4 + q) * RT_WAVE) + lane * 37;
#pragma unroll
                for (int e = 0; e < NG + NE; ++e) lg[e] += pt[e];
                s2 += pt[36]; }
            rstd = rsqrtf(s2 * (1.f / D) + EPS);
            float gl[NG]; float gmax = -INFINITY; int gsel = 0;
#pragma unroll
            for (int g = 0; g < NG; ++g) { gl[g] = lg[g] * rstd + p.b_group[g]; if (gl[g] > gmax) { gmax = gl[g]; gsel = g; } }
            float gden = 0.f;
#pragma unroll
            for (int g = 0; g < NG; ++g) gden += __expf(gl[g] - gmax);
            const float pg = 1.f / gden;
            float v1 = -INFINITY, v2 = -INFINITY; int i1 = 0, i2 = 0;
#pragma unroll
            for (int g = 0; g < NG; ++g) if (g == gsel) {
#pragma unroll
                for (int j = 0; j < EPG; ++j) { const float val = lg[4 + g * EPG + j] * rstd + p.b_expert[g * EPG + j];
                    if (val > v1) { v2 = v1; i2 = i1; v1 = val; i1 = j; } else if (val > v2) { v2 = val; i2 = j; } }
            }
            const float e2 = __expf(v2 - v1); w1 = pg / (1.f + e2); w2 = pg * e2 / (1.f + e2);
            ea = gsel * EPG + i1; eb = gsel * EPG + i2;
            ra = __hip_atomic_fetch_add(hist + ea, 1u, __ATOMIC_RELAXED, __HIP_MEMORY_SCOPE_WORKGROUP);
            rb = __hip_atomic_fetch_add(hist + eb, 1u, __ATOMIC_RELAXED, __HIP_MEMORY_SCOPE_WORKGROUP);
        }
        __syncthreads();
        { const int t2 = opaque_i(tid); if (t2 < 32) hist[32 + t2] = __hip_atomic_fetch_add(gcount + t2, hist[t2], __ATOMIC_RELAXED, __HIP_MEMORY_SCOPE_AGENT); }
        __syncthreads();
        if (kq == 0) {
            const int tok = tok0 + lane; const unsigned pa = hist[32 + ea] + ra, pb = hist[32 + eb] + rb;
            ltok[(size_t)ea * CAP + pa] = tok; lrs[(size_t)ea * CAP + pa] = rstd; lw[(size_t)ea * CAP + pa] = w1;
            ltok[(size_t)eb * CAP + pb] = tok; lrs[(size_t)eb * CAP + pb] = rstd; lw[(size_t)eb * CAP + pb] = w2;
            toke[2 * tok] = ea; toke[2 * tok + 1] = eb; tokr[2 * tok] = (int)pa; tokr[2 * tok + 1] = (int)pb;
        }
        __syncthreads();
    }
}

__device__ __forceinline__ void moe_build_map(const unsigned* gcount, LAS unsigned char* lds, int tid) {
    LAS int* nbp = (LAS int*)(lds + MOE_NBP_OFF); LAS int* cnt = (LAS int*)(lds + MOE_CNT_OFF);
    __syncthreads();
    if (tid < 64) {
        const int c = tid < NE ? (int)__hip_atomic_load(gcount + (tid & 31), __ATOMIC_RELAXED, __HIP_MEMORY_SCOPE_AGENT) : 0;
        int x = (c + 255) >> 8;
#pragma unroll
        for (int o = 1; o < 32; o <<= 1) { const int t = __shfl_up(x, o); if ((tid & 63) >= o) x += t; }
        if (tid < NE) { cnt[tid] = c; nbp[tid + 1] = x; }
        if (tid == 0) nbp[0] = 0;
    }
    __syncthreads();
}
__device__ __forceinline__ void moe_unit_of(int i, int G, int c, int nblk, int& blk, int& pn) {
    const int per = G >> 2;
    if ((G & 31) == 0 && (i + 1) * per <= nblk) { const int w = c >> 3; blk = i * per + (c & 7) * (G >> 5) + (w >> 2); pn = w & 3; }
    else if ((G & 3) == 0) { blk = i * per + (c >> 2); pn = c & 3; }
    else { const int L = i * G + c; blk = L >> 2; pn = L & 3; }
}
__device__ __forceinline__ void moe_build_units(const int* ltok, LAS unsigned char* lds, int G, int c, int tid, bool gather) {
    const LAS int* nbp = (const LAS int*)(lds + MOE_NBP_OFF); const LAS int* cnt = (const LAS int*)(lds + MOE_CNT_OFF);
    LAS int* ut = (LAS int*)(lds + MOE_UT_OFF); LAS unsigned* tbl = (LAS unsigned*)(lds + MOE_TBL_OFF);
    const int nunits = nbp[NE] * 4;
    for (int i = 0; i < MOE_MAXU; ++i) {
        int blk, pnn; moe_unit_of(i, G, c, nunits >> 2, blk, pnn); if (blk * 4 >= nunits) continue;
        int e = 0;
        for (int j = 1; j < NE; ++j) if (blk >= nbp[j]) e = j;
        const int rb = blk - nbp[e];
        if (tid == 0) { ut[4 * i] = e; ut[4 * i + 1] = blk; ut[4 * i + 2] = pnn; ut[4 * i + 3] = rb * 256; }
        if (gather && tid < 256) { const int rank = rb * 256 + tid; tbl[i * 256 + tid] = rank < cnt[e] ? (unsigned)ltok[(size_t)e * CAP + rank] * (unsigned)(D * 2) : 0u; }
    }
    __syncthreads();
}
namespace pg8 {
struct MoeSched {
    const LAS int* ut; const LAS unsigned* tbl; const LAS int* nbp; const char* A; const char* Bt; int G, c, K; bool gather;
    __device__ __forceinline__ bool next(int i, Unit& u) const {
        const int nunits = __builtin_amdgcn_readfirstlane(nbp[NE]) * 4;
        if (i >= MOE_MAXU) return false;
        { int blk_, pn_; moe_unit_of(i, G, c, nunits >> 2, blk_, pn_); if (blk_ * 4 >= nunits) return false; }
        const int e = __builtin_amdgcn_readfirstlane(ut[4 * i]), blk = __builtin_amdgcn_readfirstlane(ut[4 * i + 1]), pn = __builtin_amdgcn_readfirstlane(ut[4 * i + 2]), r0 = __builtin_amdgcn_readfirstlane(ut[4 * i + 3]);
        u.pm = blk; u.pn = pn; u.aux = e; u.rank0 = r0;
        u.a = gather ? A : A + (size_t)blk * 256 * K * 2;
        u.b = Bt + ((size_t)e * 1024 + (size_t)pn * 256) * K * 2;
        return true;
    }
    __device__ __forceinline__ void a_voff(const Unit&, int ui, int tid, int K_, unsigned (&v)[2][2]) const {
#pragma unroll
        for (int i = 0; i < 2; ++i) { int R, C; stage_rc(tid * 16 + i * 8192, R, C);
            if (gather) { v[0][i] = tbl[ui * 256 + R] + (unsigned)C * 2u; v[1][i] = tbl[ui * 256 + HALF + R] + (unsigned)C * 2u; }
            else { v[0][i] = (unsigned)(R * K_ + C) * 2u; v[1][i] = (unsigned)((HALF + R) * K_ + C) * 2u; } }
    }
    __device__ __forceinline__ void a_ready(const Unit&) const {}
    __device__ __forceinline__ void done(const Unit&) const {}
};
struct EpiSwiglu {
    static constexpr bool PERM = true, AFTER_DRAIN = false; static constexpr int MIDK = 0;
    const float* lrs; const LAS int* cnt; bf16_t* hmid;
    __device__ __forceinline__ void operator()(const f32x4 (&acc)[2][2][4][2], const Unit& u, int wr, int wc, int fr, int fq) const {
        const int e = u.aux, n = __builtin_amdgcn_readfirstlane(cnt[e]); const int coff = wc * 32 + 8 * fq;
#pragma unroll
        for (int ai = 0; ai < 2; ++ai)
#pragma unroll
            for (int m = 0; m < 4; ++m) {
                const int ri = ai * HALF + wr * 64 + m * 16 + fr, rank = u.rank0 + ri; const float s = rank < n ? lrs[(size_t)e * CAP + rank] : 0.f;
                const f32x4 a0 = acc[ai][0][m][0] * s, a1 = acc[ai][0][m][1] * s, b0 = acc[ai][1][m][0] * s, b1 = acc[ai][1][m][1] * s;
                *(u32x4*)(hmid + (size_t)(u.pm * 256 + ri) * DFF + 128 * u.pn + coff) = pack8(a0 * sig4(a0) * b0, a1 * sig4(a1) * b1);
            }
    }
};
struct EpiDown {
    static constexpr bool PERM = true, AFTER_DRAIN = false; static constexpr int MIDK = 0;
    const float* lw; const LAS int* cnt; bf16_t* y;
    __device__ __forceinline__ void operator()(const f32x4 (&acc)[2][2][4][2], const Unit& u, int wr, int wc, int fr, int fq) const {
        const int e = u.aux, n = __builtin_amdgcn_readfirstlane(cnt[e]); const int col0 = u.pn * BM + wc * 32 + 8 * fq;
#pragma unroll
        for (int ai = 0; ai < 2; ++ai)
#pragma unroll
            for (int m = 0; m < 4; ++m) {
                const int ri = ai * HALF + wr * 64 + m * 16 + fr, rank = u.rank0 + ri; const float s = rank < n ? lw[(size_t)e * CAP + rank] : 0.f;
                bf16_t* yp = y + (size_t)(u.pm * 256 + ri) * D + col0;
                *(u32x4*)yp = pack8(acc[ai][0][m][0] * s, acc[ai][0][m][1] * s); *(u32x4*)(yp + HALF) = pack8(acc[ai][1][m][0] * s, acc[ai][1][m][1] * s);
            }
    }
};
}

__device__ __forceinline__ void final_phase(CParams& p, const bf16_t* hb, const bf16_t* y, const int* toke, const int* tokr, float* outp, LAS unsigned char* lds, const int wave_s) {
    const int tidx = opaque_tid(wave_s), lane = tidx & 63, gw = blockIdx.x * (NT / 64) + (tidx >> 6), NGW = gridDim.x * (NT / 64);
    const LAS int* nbp = (const LAS int*)(lds + MOE_NBP_OFF);
    for (int m = gw; m < T; m += NGW) {
        const int ea = toke[2 * m], eb = toke[2 * m + 1];
        const size_t sa = (size_t)nbp[ea] * 256 + tokr[2 * m], sb = (size_t)nbp[eb] * 256 + tokr[2 * m + 1];
        const u32x2* xr = (const u32x2*)(hb + (size_t)m * D) + lane; const u32x2* ya = (const u32x2*)(y + sa * D) + lane; const u32x2* yb = (const u32x2*)(y + sb * D) + lane;
        f32x4 v[4]; float s = 0.f;
#pragma unroll
        for (int j = 0; j < 4; ++j) { const u32x2 h2 = xr[64 * j], a = ya[64 * j], b = yb[64 * j];
            v[j] = (f32x4){bf_lo(h2.x), bf_hi(h2.x), bf_lo(h2.y), bf_hi(h2.y)} + (f32x4){bf_lo(a.x), bf_hi(a.x), bf_lo(a.y), bf_hi(a.y)} + (f32x4){bf_lo(b.x), bf_hi(b.x), bf_lo(b.y), bf_hi(b.y)};
            s += (v[j][0] * v[j][0] + v[j][1] * v[j][1]) + (v[j][2] * v[j][2] + v[j][3] * v[j][3]); }
        const float rstd = rsqrtf(wave_sum(s) * (1.f / D) + EPS);
        f32x4* o = (f32x4*)(outp + (size_t)m * D) + lane;
#pragma unroll
        for (int j = 0; j < 4; ++j) o[64 * j] = v[j] * rstd * ((const f32x4*)p.g_final)[lane + 64 * j];
    }
}


__global__ void __launch_bounds__(NT, 2) k_all(Params p_arg) {
    CParams* pp_ = (CParams*)__builtin_amdgcn_kernarg_segment_ptr(); asm volatile("" : "+s"(pp_)); CParams& p = *pp_;
    extern __shared__ __attribute__((aligned(16))) unsigned char lds_raw[];
    LAS unsigned char* lds = (LAS unsigned char*)lds_raw;
    volatile LAS unsigned* MISC = (volatile LAS unsigned*)(lds + MISC_OFF);
    const int wave_s = __builtin_amdgcn_readfirstlane((int)threadIdx.x >> 6);
    if (threadIdx.x < 32) MISC[threadIdx.x] = 0u;
    __syncthreads();
    unsigned char* ws = p.ws;
    unsigned* ctl = (unsigned*)(ws + WS_CTL);
    XcdBarrier bar = xcd_barrier_post(ctl + CW_BAR, MISC, wave_s == 0);
    const int G = gridDim.x;

    bf16_t* wt_in = (bf16_t*)(ws + WS_WT_IN); bf16_t* wt_mix = (bf16_t*)(ws + WS_WT_MIX); bf16_t* wt_out = (bf16_t*)(ws + WS_WT_OUT);
    bf16_t* xb = (bf16_t*)(ws + WS_XB); bf16_t* merged = (bf16_t*)(ws + WS_MERGED); float* rstd1 = (float*)(ws + WS_RSTD1);
    bf16_t* vglu = (bf16_t*)(ws + WS_VGLU); bf16_t* qb = (bf16_t*)(ws + WS_QB); bf16_t* kvb = (bf16_t*)(ws + WS_KVB);
    bf16_t* sgc = (bf16_t*)(ws + WS_SGC); bf16_t* sga = (bf16_t*)(ws + WS_SGA); bf16_t* mix = (bf16_t*)(ws + WS_MIX); bf16_t* cact = mix; bf16_t* att = mix + CC;
    bf16_t* delta = (bf16_t*)(ws + WS_DELTA);

#ifndef ENABLE
#define ENABLE 0xff
#endif
#ifndef REPEAT
#define REPEAT 0
#endif
#define BARX() do { xcd_barrier(bar); if ((REPEAT >> 15) & 1) xcd_barrier(bar); } while (0)
#define REP(k) _Pragma("unroll") for (int rep_ = 0; rep_ < 1 + ((REPEAT >> (k)) & 1); ++rep_)
    asm volatile("; PHASE_MARK 0");
    REP(0) if (ENABLE & 1) { p0_prologue(p, lds, wave_s); p0_moe_weights(p, lds, wave_s, 0, MOE_ITEMS_P0, (int)blockIdx.x * (NT / 64) + wave_s, G * (NT / 64)); }
    BARX();
    asm volatile("; PHASE_MARK 1");
    REP(1) if (ENABLE & 2) {
      const int nfull = (T / 256) * (INC / 256) - 7 * G;
      const bool split = nfull > 0 && nfull < G; const int MID = (MOE_ITEMS_P0 + MOE_ITEMS) / 2;
      if (rep_ == 0 && split && (int)blockIdx.x >= nfull) p0_moe_weights(p, lds, wave_s, MOE_ITEMS_P0, MID, ((int)blockIdx.x - nfull) * (NT / 64) + wave_s, (G - nfull) * (NT / 64));
      __syncthreads();
      pg8::DenseSched S; S.init(xb, wt_in, T, INC, D, G, (int)blockIdx.x);
      pg8::EpiProj E{rstd1, vglu, qb, kvb, sgc, sga, 0.125f * LOG2E};
      pg8::gemm_phase<pg8::EpiProj, pg8::DenseSched, true, true>(lds, D, S, E, wave_s);
      if (rep_ == 0) { if (split) { if ((int)blockIdx.x >= nfull) p0_moe_weights(p, lds, wave_s, MID, MOE_ITEMS, ((int)blockIdx.x - nfull) * (NT / 64) + wave_s, (G - nfull) * (NT / 64)); }
                       else p0_moe_weights(p, lds, wave_s, MOE_ITEMS_P0, MOE_ITEMS, (int)blockIdx.x * (NT / 64) + wave_s, G * (NT / 64)); } }
    BARX();
    asm volatile("; PHASE_MARK 2");
    REP(2) if (ENABLE & 4) conv_phase(p, vglu, cact, lds, wave_s);
    asm volatile("; PHASE_MARK 3");
    REP(3) if (ENABLE & 8) attn_phase(p, qb, kvb, att, lds, wave_s);
    BARX();
    asm volatile("; PHASE_MARK 4");
    REP(4) if (ENABLE & 16) { pg8::DenseSched S; S.init(mix, wt_mix, T, D, D, G, (int)blockIdx.x);
      pg8::EpiMerge E{sgc, sga, merged};
      pg8::gemm_phase<pg8::EpiMerge, pg8::DenseSched, true, true>(lds, D, S, E, wave_s); }
    BARX();
    asm volatile("; PHASE_MARK 6");
    REP(5) if (ENABLE & 32) { pg8::DenseSched S; S.init(merged, wt_out, T, D, D, G, (int)blockIdx.x);
      pg8::EpiDelta E{delta};
      pg8::gemm_phase<pg8::EpiDelta, pg8::DenseSched, true, true>(lds, D, S, E, wave_s); }
    BARX();
    bf16_t* hb = (bf16_t*)(ws + WS_HB); bf16_t* hmid = (bf16_t*)(ws + WS_HMID); bf16_t* y = (bf16_t*)(ws + WS_Y);
    int* toke = (int*)(ws + WS_TOKE); int* tokr = (int*)(ws + WS_TOKR); int* ltok = (int*)(ws + WS_LTOK); float* lrs = (float*)(ws + WS_LRS); float* lw = (float*)(ws + WS_LW);
    unsigned* gcount = ctl + CW_CNT;
    asm volatile("; PHASE_MARK 7");
    if ((REPEAT >> 7) & 1) { unsigned char* sc = ws + WS_VGLU + 64 * MiB;
        route_phase_fast(p, p.x, delta, hb, (int*)(sc), (int*)(sc + 1 * MiB), (int*)(sc + 2 * MiB), (float*)(sc + 6 * MiB), (float*)(sc + 10 * MiB), gcount + 64, lds, wave_s); }
    route_phase_fast(p, p.x, delta, hb, toke, tokr, ltok, lrs, lw, gcount, lds, wave_s);
    BARX();
    asm volatile("; PHASE_MARK 8");
    REP(8) { const int tid = opaque_tid(wave_s);
      moe_build_map(gcount, lds, tid); moe_build_units(ltok, lds, G, (int)blockIdx.x, tid, true);
      pg8::MoeSched S{(const LAS int*)(lds + MOE_UT_OFF), (const LAS unsigned*)(lds + MOE_TBL_OFF), (const LAS int*)(lds + MOE_NBP_OFF), (const char*)hb, (const char*)(ws + WS_WT_GU), G, (int)blockIdx.x, D, true};
      pg8::EpiSwiglu E{lrs, (const LAS int*)(lds + MOE_CNT_OFF), hmid};
      pg8::gemm_phase<pg8::EpiSwiglu, pg8::MoeSched, true, true>(lds, D, S, E, wave_s); }
    BARX();
    asm volatile("; PHASE_MARK 9");
    REP(9) { const int tid = opaque_tid(wave_s);
      moe_build_map(gcount, lds, tid); moe_build_units(ltok, lds, G, (int)blockIdx.x, tid, false);
      pg8::MoeSched S{(const LAS int*)(lds + MOE_UT_OFF), (const LAS unsigned*)(lds + MOE_TBL_OFF), (const LAS int*)(lds + MOE_NBP_OFF), (const char*)hmid, (const char*)(ws + WS_WT_D), G, (int)blockIdx.x, DFF, false};
      pg8::EpiDown E{lw, (const LAS int*)(lds + MOE_CNT_OFF), y};
      pg8::gemm_phase<pg8::EpiDown, pg8::MoeSched, true, true>(lds, DFF, S, E, wave_s); }
    BARX();
    asm volatile("; PHASE_MARK 10");
    { const int tid = opaque_tid(wave_s); moe_build_map(gcount, lds, tid); }
    if ((REPEAT >> 10) & 1) final_phase(p, hb, y, toke, tokr, p.out, lds, wave_s);
    final_phase(p, hb, y, toke, tokr, p.out, lds, wave_s);
}

extern "C" void kernel_launch(void* const* d_in, const int* in_sizes, int n_in, void* d_out, int out_size, void* d_ws, size_t ws_size, hipStream_t stream) {
    static int grid = 0;
    if (grid == 0) {
        if (n_in != 20 || in_sizes[0] != T * D || out_size != T * D || ws_size < WS_END) {
            fprintf(stderr, "kernel_launch: unexpected shapes (n_in %d, in0 %d, out %d, ws %zu); nothing launched\n", n_in, n_in > 0 ? in_sizes[0] : -1, out_size, ws_size); grid = -1; return; }
        int dev = 0, cus = 0, per_cu = 0;
        if (hipGetDevice(&dev) != hipSuccess || hipDeviceGetAttribute(&cus, hipDeviceAttributeMultiprocessorCount, dev) != hipSuccess) { grid = -1; return; }
        if (hipFuncSetAttribute((const void*)k_all, hipFuncAttributeMaxDynamicSharedMemorySize, LDS_BYTES) != hipSuccess) { fprintf(stderr, "kernel_launch: hipFuncSetAttribute failed\n"); grid = -1; return; }
        if (hipOccupancyMaxActiveBlocksPerMultiprocessor(&per_cu, (const void*)k_all, NT, LDS_BYTES) != hipSuccess || per_cu < 1)
            fprintf(stderr, "kernel_launch: note: occupancy query reports %d workgroups per CU\n", per_cu);
        (void)hipGetLastError();
        grid = cus;
    }
    if (grid < 0) return;
    if (hipMemsetAsync((char*)d_ws + WS_CTL, 0, CTL_BYTES, stream) != hipSuccess) return;
    Params p{};
    const float** pp = (const float**)&p;
    for (int i = 0; i < 20; ++i) pp[i] = (const float*)d_in[i];
    p.out = (float*)d_out; p.ws = (unsigned char*)d_ws;
    hipLaunchKernelGGL(k_all, dim3(grid), dim3(NT), LDS_BYTES, stream, p);
}
```
